# Optimizing an MI355X kernel written in HIP

```python
import math
import numpy as np
import jax
import jax.numpy as jnp
from jax import lax

D_MODEL = 1024
BATCH = 8
SEQ = 8192
DEPTH = 2

PLE_DIM = 256
D_FF = 4 * D_MODEL
HEAD_DIM = 64
ROT_DIM = HEAD_DIM // 4
ROPE_THETA = 500000.0
NORM_EPS = 1e-6
NEG_INF = -1e30
MAX_POS_OFFSET = 4096
CONV_WIDTH = 4
FOX_HEADS = (D_MODEL // 2) // HEAD_DIM
FOX_W = FOX_HEADS * HEAD_DIM
FOX_QBLOCK = 128
GDN_HEAD_DIM = 128
GDN_HEADS = (D_MODEL // 2) // GDN_HEAD_DIM
GDN_W = GDN_HEADS * GDN_HEAD_DIM
GDN_CHUNK = 64
NSA_HEADS = (D_MODEL // 2) // HEAD_DIM
NSA_W = NSA_HEADS * HEAD_DIM
NSA_KV_GROUPS = 2
NSA_KV_W = NSA_KV_GROUPS * HEAD_DIM
CMP_BLOCK = 32
CMP_STRIDE = 16
CMP_HIDDEN = 128
SEL_BLOCK = 64
SEL_TOPK = 16
WINDOW = 512
NSA_QBLOCK = 64
LRU_WIDTH = D_MODEL // 2
LRU_BLOCKS = 8
RG_C = 8.0

EVEN_SPLITS = [FOX_W, FOX_W, FOX_W, FOX_HEADS, GDN_W, GDN_W, GDN_W, GDN_W, GDN_HEADS, GDN_HEADS]
ODD_SPLITS = [NSA_W] + [NSA_KV_W] * 6 + [NSA_HEADS * 3, LRU_WIDTH, LRU_WIDTH]
EVEN_IN = sum(EVEN_SPLITS)
ODD_IN = sum(ODD_SPLITS)

kernel_name = "hybrid_fox_gdn_nsa_rglru_trunk"


def rms_norm(x, w):
    xf = x.astype(jnp.float32)
    y = xf * lax.rsqrt(jnp.mean(xf * xf, axis=-1, keepdims=True) + NORM_EPS)
    return (y * w.astype(jnp.float32)).astype(x.dtype)


def split_cols(y, sizes):
    return jnp.split(y, [int(c) for c in np.cumsum(sizes)[:-1]], axis=-1)


def masked_softmax(s, mask):
    p = jax.nn.softmax(jnp.where(mask, s, NEG_INF), axis=-1)
    return jnp.where(mask, p, 0.0)


def rope_tables(positions):
    half = ROT_DIM // 2
    inv_freq = ROPE_THETA ** (-jnp.arange(half, dtype=jnp.float32) * (2.0 / ROT_DIM))
    ang = positions.astype(jnp.float32)[..., None] * inv_freq
    return jnp.cos(ang)[:, :, None, :], jnp.sin(ang)[:, :, None, :]


def apply_partial_rope(x, cos, sin):
    half = ROT_DIM // 2
    x1 = x[..., :half].astype(jnp.float32)
    x2 = x[..., half:ROT_DIM].astype(jnp.float32)
    rot = jnp.concatenate([x1 * cos - x2 * sin, x2 * cos + x1 * sin], axis=-1).astype(x.dtype)
    return jnp.concatenate([rot, x[..., ROT_DIM:]], axis=-1)


def causal_depthwise_conv(x, w):
    K = w.shape[0]
    S = x.shape[1]
    xp = jnp.pad(x, ((0, 0), (K - 1, 0), (0, 0)))
    y = xp[:, 0:S] * w[0]
    for j in range(1, K):
        y = y + xp[:, j:j + S] * w[j]
    return y


def fox_attention(q, k, v, f_logit):
    B, S, H, Dh = q.shape
    nb = S // FOX_QBLOCK
    logf = jax.nn.log_sigmoid(f_logit.astype(jnp.float32))
    F = jnp.cumsum(logf, axis=1).transpose(0, 2, 1)
    q_blocks = q.reshape(B, nb, FOX_QBLOCK, H, Dh).transpose(1, 0, 2, 3, 4)
    F_blocks = F.reshape(B, H, nb, FOX_QBLOCK).transpose(2, 0, 1, 3)
    key_pos = jnp.arange(S)
    scale = Dh ** -0.5

    def one_block(args):
        i, q_i, F_i = args
        t = i * FOX_QBLOCK + jnp.arange(FOX_QBLOCK)
        s = jnp.einsum('bqhd,bkhd->bhqk', q_i, k).astype(jnp.float32) * scale
        s = s + F_i[..., :, None] - F[:, :, None, :]
        p = masked_softmax(s, key_pos[None, :] <= t[:, None])
        return jnp.einsum('bhqk,bkhd->bqhd', p.astype(v.dtype), v)

    out = lax.map(one_block, (jnp.arange(nb), q_blocks, F_blocks))
    return out.transpose(1, 0, 2, 3, 4).reshape(B, S, H, Dh)


def gated_deltanet(q, k, v, z, b_logit, a_logit, a_log, dt_bias, norm_w):
    B, S, H, Dk = q.shape
    Dv = v.shape[-1]
    C = GDN_CHUNK
    N = S // C
    f32 = jnp.float32

    def l2n(t):
        tf = t.astype(f32)
        return tf * lax.rsqrt(jnp.sum(tf * tf, axis=-1, keepdims=True) + 1e-6)

    qf = l2n(q) * (Dk ** -0.5)
    kf = l2n(k)
    vf = v.astype(f32)
    beta = jax.nn.sigmoid(b_logit.astype(f32))
    g = -jnp.exp(a_log.astype(f32)) * jax.nn.softplus(a_logit.astype(f32) + dt_bias.astype(f32))

    def chunks(t):
        return t.reshape(B, N, C, H, -1).transpose(0, 3, 1, 2, 4)

    qc, kc, vc = chunks(qf), chunks(kf), chunks(vf)
    beta_c = chunks(beta[..., None])[..., 0]
    g_cum = jnp.cumsum(chunks(g[..., None])[..., 0], axis=-1)
    idx = jnp.arange(C)
    incl = idx[:, None] >= idx[None, :]
    strict = idx[:, None] > idx[None, :]
    decay = jnp.where(incl, jnp.exp(jnp.where(incl, g_cum[..., :, None] - g_cum[..., None, :], 0.0)), 0.0)
    k_beta = kc * beta_c[..., None]
    L = jnp.where(strict, jnp.einsum('bhnid,bhnjd->bhnij', k_beta, kc) * decay, 0.0)
    lhs = L + jnp.eye(C, dtype=f32)
    rhs = jnp.concatenate([vc * beta_c[..., None], k_beta * jnp.exp(g_cum)[..., None]], axis=-1)
    sol = lax.linalg.triangular_solve(lhs, rhs, left_side=True, lower=True, unit_diagonal=True)
    u, w = sol[..., :Dv], sol[..., Dv:]
    attn_intra = jnp.where(incl, jnp.einsum('bhnid,bhnjd->bhnij', qc, kc) * decay, 0.0)

    def step(state, inp):
        q_i, k_i, u_i, w_i, g_i, a_i = inp
        v_new = u_i - jnp.einsum('bhck,bhkv->bhcv', w_i, state)
        o_i = (jnp.einsum('bhck,bhkv->bhcv', q_i * jnp.exp(g_i)[..., None], state)
               + jnp.einsum('bhij,bhjv->bhiv', a_i, v_new))
        g_last = g_i[..., -1:]
        state = (state * jnp.exp(g_last)[..., None]
                 + jnp.einsum('bhck,bhcv->bhkv', k_i * jnp.exp(g_last - g_i)[..., None], v_new))
        return state, o_i

    xs = tuple(jnp.moveaxis(t, 2, 0) for t in (qc, kc, u, w, g_cum, attn_intra))
    _, o = lax.scan(step, jnp.zeros((B, H, Dk, Dv), f32), xs)
    o = o.transpose(1, 0, 3, 2, 4).reshape(B, S, H, Dv)
    o = o * lax.rsqrt(jnp.mean(o * o, axis=-1, keepdims=True) + NORM_EPS) * norm_w.astype(f32)
    o = o * jax.nn.silu(z.astype(f32))
    return o.astype(q.dtype)


def compress_tokens(x, pe, w1, w2):
    S = x.shape[1]
    n_cmp = (S - CMP_BLOCK) // CMP_STRIDE + 1
    idx = (np.arange(n_cmp) * CMP_STRIDE)[:, None] + np.arange(CMP_BLOCK)[None, :]
    blocks = x[:, idx] + pe[None, None, :, None, :]
    B, n, L, G, Dh = blocks.shape
    flat = blocks.transpose(0, 1, 3, 2, 4).reshape(B, n, G, L * Dh)
    hid = jax.nn.gelu(jnp.einsum('bngf,fh->bngh', flat, w1))
    return jnp.einsum('bngh,hd->bngd', hid, w2)


def nsa_attention(q, k_cmp, v_cmp, k_slc, v_slc, k_win, v_win, gate_logit):
    B, S, H, Dh = q.shape
    G = k_slc.shape[2]
    hpg = H // G
    f32 = jnp.float32
    scale = Dh ** -0.5
    n_cmp = k_cmp.shape[1]
    n_sel = S // SEL_BLOCK
    top_k = min(SEL_TOPK, n_sel)
    QB = NSA_QBLOCK
    nb = S // QB
    cmp_end = jnp.arange(n_cmp) * CMP_STRIDE + CMP_BLOCK - 1
    cs = np.arange(n_cmp) * CMP_STRIDE
    ss = np.arange(n_sel) * SEL_BLOCK
    overlap = jnp.asarray(((cs[:, None] <= ss[None, :] + SEL_BLOCK - 1)
                           & (cs[:, None] + CMP_BLOCK - 1 >= ss[None, :])).astype(np.float32))
    sel_k = k_slc.reshape(B, n_sel, SEL_BLOCK, G, Dh).transpose(0, 3, 1, 2, 4)
    sel_v = v_slc.reshape(B, n_sel, SEL_BLOCK, G, Dh).transpose(0, 3, 1, 2, 4)
    k_win_p = jnp.pad(k_win, ((0, 0), (WINDOW, 0), (0, 0), (0, 0)))
    v_win_p = jnp.pad(v_win, ((0, 0), (WINDOW, 0), (0, 0), (0, 0)))
    gates = jax.nn.sigmoid(gate_logit.astype(f32)).reshape(B, S, H, 3)
    q_blocks = q.reshape(B, nb, QB, G, hpg, Dh).transpose(1, 0, 3, 4, 2, 5)
    gate_blocks = gates.reshape(B, nb, QB, H, 3).transpose(1, 0, 2, 3, 4)
    gather_blocks = jax.vmap(jax.vmap(lambda blk, ix: blk[ix]))
    blk_ids = jnp.arange(n_sel)
    in_blk = jnp.arange(SEL_BLOCK)
    win_off = jnp.arange(WINDOW + QB) - WINDOW

    def one_block(args):
        i, q_i, g_i = args
        t = i * QB + jnp.arange(QB)
        s_c = jnp.einsum('bghqd,bngd->bghqn', q_i, k_cmp).astype(f32) * scale
        p_c = masked_softmax(s_c, cmp_end[None, :] <= t[:, None])
        o_c = jnp.einsum('bghqn,bngd->bghqd', p_c.astype(v_cmp.dtype), v_cmp)
        imp = jnp.einsum('bgqn,nm->bgqm', p_c.sum(axis=2), overlap)
        cur = t // SEL_BLOCK
        forced = ((blk_ids[None, :] == 0) | (blk_ids[None, :] == cur[:, None])
                  | (blk_ids[None, :] == cur[:, None] - 1))
        future = blk_ids[None, :] * SEL_BLOCK > t[:, None]
        imp = jnp.where(future, NEG_INF, jnp.where(forced, -NEG_INF, imp))
        _, sel = lax.top_k(imp, top_k)
        k_sel = gather_blocks(sel_k, sel).reshape(B, G, QB, top_k * SEL_BLOCK, Dh)
        v_sel = gather_blocks(sel_v, sel).reshape(B, G, QB, top_k * SEL_BLOCK, Dh)
        sel_pos = (sel[..., None] * SEL_BLOCK + in_blk).reshape(B, G, QB, top_k * SEL_BLOCK)
        s_s = jnp.einsum('bghqd,bgqmd->bghqm', q_i, k_sel).astype(f32) * scale
        p_s = masked_softmax(s_s, (sel_pos <= t[:, None])[:, :, None])
        o_s = jnp.einsum('bghqm,bgqmd->bghqd', p_s.astype(v_slc.dtype), v_sel)
        kw = lax.dynamic_slice_in_dim(k_win_p, i * QB, WINDOW + QB, axis=1)
        vw = lax.dynamic_slice_in_dim(v_win_p, i * QB, WINDOW + QB, axis=1)
        wpos = i * QB + win_off
        mask_w = ((wpos[None, :] <= t[:, None]) & (t[:, None] - wpos[None, :] < WINDOW)
                  & (wpos[None, :] >= 0))
        s_w = jnp.einsum('bghqd,bkgd->bghqk', q_i, kw).astype(f32) * scale
        p_w = masked_softmax(s_w, mask_w)
        o_w = jnp.einsum('bghqk,bkgd->bghqd', p_w.astype(v_win.dtype), vw)
        gg = g_i.reshape(B, QB, G, hpg, 3).transpose(0, 2, 3, 1, 4)
        o = gg[..., 0:1] * o_c + gg[..., 1:2] * o_s + gg[..., 2:3] * o_w
        return o.astype(q.dtype)

    out = lax.map(one_block, (jnp.arange(nb), q_blocks, gate_blocks))
    return out.transpose(1, 0, 4, 2, 3, 5).reshape(B, S, H, Dh)


def rg_lru_block(gate_in, x_in, conv_w, conv_b, wa, ba, wx, bx, lam):
    f32 = jnp.float32
    x = causal_depthwise_conv(x_in, conv_w) + conv_b
    B, S, W = x.shape
    nblk = wa.shape[0]
    xb = x.reshape(B, S, nblk, W // nblk)
    r = jax.nn.sigmoid((jnp.einsum('bsnk,nkj->bsnj', xb, wa).reshape(B, S, W) + ba).astype(f32))
    ig = jax.nn.sigmoid((jnp.einsum('bsnk,nkj->bsnj', xb, wx).reshape(B, S, W) + bx).astype(f32))
    log_a = -RG_C * jax.nn.softplus(-lam.astype(f32)) * r
    a = jnp.exp(log_a)
    b = jnp.sqrt(-jnp.expm1(2.0 * log_a)) * (ig * x.astype(f32))

    def combine(left, right):
        a_l, b_l = left
        a_r, b_r = right
        return a_l * a_r, a_r * b_l + b_r

    _, h = lax.associative_scan(combine, (a, b), axis=1)
    y = h * jax.nn.gelu(gate_in.astype(f32))
    return y.astype(x_in.dtype)


def even_mixer(h, w_in, fox_bf, gdn_conv_w, gdn_a_log, gdn_dt_bias, gdn_norm_w, w_out):
    B, S, _ = h.shape
    y = h @ w_in
    fq, fk, fv, ff, gq, gk, gv, gz, gb, ga = split_cols(y, EVEN_SPLITS)
    fox = fox_attention(fq.reshape(B, S, FOX_HEADS, HEAD_DIM), fk.reshape(B, S, FOX_HEADS, HEAD_DIM),
                        fv.reshape(B, S, FOX_HEADS, HEAD_DIM), ff + fox_bf)
    qkv = jax.nn.silu(causal_depthwise_conv(jnp.concatenate([gq, gk, gv], axis=-1), gdn_conv_w))
    cq, ck, cv = jnp.split(qkv, 3, axis=-1)
    hd = lambda t: t.reshape(B, S, GDN_HEADS, GDN_HEAD_DIM)
    gdn = gated_deltanet(hd(cq), hd(ck), hd(cv), hd(gz), gb, ga, gdn_a_log, gdn_dt_bias, gdn_norm_w)
    mixed = jnp.concatenate([fox.reshape(B, S, FOX_W), gdn.reshape(B, S, GDN_W)], axis=-1)
    return mixed @ w_out


def odd_mixer(h, cos, sin, w_in, k_pe, k_w1, k_w2, v_pe, v_w1, v_w2,
              conv_w, conv_b, wa, ba, wx, bx, lam, w_out):
    B, S, _ = h.shape
    y = h @ w_in
    nq, kc, vc, ksl, vsl, kwn, vwn, ng, rg, rx = split_cols(y, ODD_SPLITS)
    hd = lambda t, n: t.reshape(B, S, n, HEAD_DIM)
    G = NSA_KV_GROUPS
    q = apply_partial_rope(hd(nq, NSA_HEADS), cos, sin)
    k_c = compress_tokens(apply_partial_rope(hd(kc, G), cos, sin), k_pe, k_w1, k_w2)
    v_c = compress_tokens(hd(vc, G), v_pe, v_w1, v_w2)
    nsa = nsa_attention(q, k_c, v_c, apply_partial_rope(hd(ksl, G), cos, sin), hd(vsl, G),
                        apply_partial_rope(hd(kwn, G), cos, sin), hd(vwn, G), ng)
    lru = rg_lru_block(rg, rx, conv_w, conv_b, wa, ba, wx, bx, lam)
    mixed = jnp.concatenate([nsa.reshape(B, S, NSA_W), lru], axis=-1)
    return mixed @ w_out


def setup_inputs(seed: int = 0) -> dict:
    key = jax.random.key(seed)
    ks = iter(jax.random.split(key, 48))
    f32 = jnp.float32
    nrm = lambda shape, scale: jax.random.normal(next(ks), shape, f32) * scale
    gain = lambda shape: 1.0 + nrm(shape, 0.02)
    ne, no = (DEPTH + 1) // 2, DEPTH // 2
    D = D_MODEL
    x = nrm((BATCH, SEQ, D), 1.0)
    p = nrm((DEPTH, BATCH, SEQ, PLE_DIM), 1.0)
    positions = (jax.random.randint(next(ks), (BATCH, 1), 0, MAX_POS_OFFSET, jnp.int32)
                 + jnp.arange(SEQ, dtype=jnp.int32)[None, :])
    even_norm_mix = gain((ne, D))
    even_w_in = nrm((ne, D, EVEN_IN), D ** -0.5)
    even_fox_bf = 2.0 + nrm((ne, FOX_HEADS), 0.1)
    even_gdn_conv_w = nrm((ne, CONV_WIDTH, 3 * GDN_W), CONV_WIDTH ** -0.5)
    even_gdn_a_log = jnp.log(jax.random.uniform(next(ks), (ne, GDN_HEADS), f32, 1.0, 16.0))
    dt = jnp.exp(jax.random.uniform(next(ks), (ne, GDN_HEADS), f32, math.log(1e-3), math.log(1e-1)))
    even_gdn_dt_bias = dt + jnp.log(-jnp.expm1(-dt))
    even_gdn_norm_w = gain((ne, GDN_HEAD_DIM))
    even_w_out = nrm((ne, FOX_W + GDN_W, D), (FOX_W + GDN_W) ** -0.5)
    odd_norm_mix = gain((no, D))
    odd_w_in = nrm((no, D, ODD_IN), D ** -0.5)
    odd_cmp_k_pe = nrm((no, CMP_BLOCK, HEAD_DIM), 0.02)
    odd_cmp_k_w1 = nrm((no, CMP_BLOCK * HEAD_DIM, CMP_HIDDEN), (CMP_BLOCK * HEAD_DIM) ** -0.5)
    odd_cmp_k_w2 = nrm((no, CMP_HIDDEN, HEAD_DIM), CMP_HIDDEN ** -0.5)
    odd_cmp_v_pe = nrm((no, CMP_BLOCK, HEAD_DIM), 0.02)
    odd_cmp_v_w1 = nrm((no, CMP_BLOCK * HEAD_DIM, CMP_HIDDEN), (CMP_BLOCK * HEAD_DIM) ** -0.5)
    odd_cmp_v_w2 = nrm((no, CMP_HIDDEN, HEAD_DIM), CMP_HIDDEN ** -0.5)
    odd_rg_conv_w = nrm((no, CONV_WIDTH, LRU_WIDTH), CONV_WIDTH ** -0.5)
    odd_rg_conv_b = nrm((no, LRU_WIDTH), 0.01)
    bw = LRU_WIDTH // LRU_BLOCKS
    odd_rg_wa = nrm((no, LRU_BLOCKS, bw, bw), bw ** -0.5)
    odd_rg_ba = nrm((no, LRU_WIDTH), 0.01)
    odd_rg_wx = nrm((no, LRU_BLOCKS, bw, bw), bw ** -0.5)
    odd_rg_bx = nrm((no, LRU_WIDTH), 0.01)
    a_c = jax.random.uniform(next(ks), (no, LRU_WIDTH), f32, 0.9, 0.999)
    a0 = a_c ** (1.0 / RG_C)
    odd_rg_lambda = jnp.log(a0) - jnp.log1p(-a0)
    odd_w_out = nrm((no, NSA_W + LRU_WIDTH, D), (NSA_W + LRU_WIDTH) ** -0.5)
    mlp_norm = gain((DEPTH, D))
    mlp_w_up = nrm((DEPTH, D, D_FF), D ** -0.5)
    mlp_w_down = nrm((DEPTH, D_FF, D), D_FF ** -0.5)
    ple_norm = gain((DEPTH, D))
    ple_w_gate = nrm((DEPTH, D, D), D ** -0.5)
    ple_w_proj = nrm((DEPTH, PLE_DIM, D), PLE_DIM ** -0.5)
    final_norm = gain((D,))
    return {"x": x, "p": p, "positions": positions,
            "even_norm_mix": even_norm_mix, "even_w_in": even_w_in, "even_fox_bf": even_fox_bf,
            "even_gdn_conv_w": even_gdn_conv_w, "even_gdn_a_log": even_gdn_a_log,
            "even_gdn_dt_bias": even_gdn_dt_bias, "even_gdn_norm_w": even_gdn_norm_w,
            "even_w_out": even_w_out,
            "odd_norm_mix": odd_norm_mix, "odd_w_in": odd_w_in,
            "odd_cmp_k_pe": odd_cmp_k_pe, "odd_cmp_k_w1": odd_cmp_k_w1, "odd_cmp_k_w2": odd_cmp_k_w2,
            "odd_cmp_v_pe": odd_cmp_v_pe, "odd_cmp_v_w1": odd_cmp_v_w1, "odd_cmp_v_w2": odd_cmp_v_w2,
            "odd_rg_conv_w": odd_rg_conv_w, "odd_rg_conv_b": odd_rg_conv_b,
            "odd_rg_wa": odd_rg_wa, "odd_rg_ba": odd_rg_ba, "odd_rg_wx": odd_rg_wx, "odd_rg_bx": odd_rg_bx,
            "odd_rg_lambda": odd_rg_lambda, "odd_w_out": odd_w_out,
            "mlp_norm": mlp_norm, "mlp_w_up": mlp_w_up, "mlp_w_down": mlp_w_down,
            "ple_norm": ple_norm, "ple_w_gate": ple_w_gate, "ple_w_proj": ple_w_proj,
            "final_norm": final_norm}


def reference(x, p, positions,
              even_norm_mix, even_w_in, even_fox_bf, even_gdn_conv_w, even_gdn_a_log,
              even_gdn_dt_bias, even_gdn_norm_w, even_w_out,
              odd_norm_mix, odd_w_in, odd_cmp_k_pe, odd_cmp_k_w1, odd_cmp_k_w2,
              odd_cmp_v_pe, odd_cmp_v_w1, odd_cmp_v_w2, odd_rg_conv_w, odd_rg_conv_b,
              odd_rg_wa, odd_rg_ba, odd_rg_wx, odd_rg_bx, odd_rg_lambda, odd_w_out,
              mlp_norm, mlp_w_up, mlp_w_down, ple_norm, ple_w_gate, ple_w_proj, final_norm):
    cos, sin = rope_tables(positions)
    h = x
    for i in range(DEPTH):
        j = i // 2
        if i % 2 == 0:
            hn = rms_norm(h, even_norm_mix[j])
            h = h + even_mixer(hn, even_w_in[j], even_fox_bf[j], even_gdn_conv_w[j], even_gdn_a_log[j],
                               even_gdn_dt_bias[j], even_gdn_norm_w[j], even_w_out[j])
        else:
            hn = rms_norm(h, odd_norm_mix[j])
            h = h + odd_mixer(hn, cos, sin, odd_w_in[j], odd_cmp_k_pe[j], odd_cmp_k_w1[j], odd_cmp_k_w2[j],
                              odd_cmp_v_pe[j], odd_cmp_v_w1[j], odd_cmp_v_w2[j], odd_rg_conv_w[j],
                              odd_rg_conv_b[j], odd_rg_wa[j], odd_rg_ba[j], odd_rg_wx[j], odd_rg_bx[j],
                              odd_rg_lambda[j], odd_w_out[j])
        hn = rms_norm(h, mlp_norm[i])
        u = jax.nn.relu(hn @ mlp_w_up[i])
        h = h + (u * u) @ mlp_w_down[i]
        hn = rms_norm(h, ple_norm[i])
        h = h + jax.nn.sigmoid(hn @ ple_w_gate[i]) * (p[i] @ ple_w_proj[i])
    return rms_norm(h, final_norm)
```

```cpp
#include <hip/hip_runtime.h>
#include <hip/hip_cooperative_groups.h>
#include <stdint.h>
#include <stdio.h>
#include <string.h>
namespace cg = cooperative_groups;

typedef unsigned short bf16_t;
typedef __attribute__((ext_vector_type(8))) short bf16x8;
typedef __attribute__((ext_vector_type(4))) float f32x4;
#define DEVI __device__ __forceinline__

constexpr int S_ = 8192, B_ = 8, M_ = 65536;
constexpr size_t MiB = 1ull << 20;
constexpr size_t OFF_WT = 0, OFF_Y = 64 * MiB, OFF_MIX = 576 * MiB, OFF_SM = 704 * MiB, OFF_MISC = 712 * MiB,
                 OFF_X = 736 * MiB, OFF_HN = 896 * MiB;
constexpr size_t WT_IN_E = 0;
constexpr size_t WT_OUT_E = WT_IN_E + 3712 * 1024;
constexpr size_t WT_IN_O = WT_OUT_E + 1024 * 1024;
constexpr size_t WT_OUT_O = WT_IN_O + 2432 * 1024;
constexpr size_t WT_UP = WT_OUT_O + 1024 * 1024;
constexpr size_t WT_DOWN = WT_UP + 2 * 4096 * 1024;
constexpr size_t WT_GATE = WT_DOWN + 2 * 4096 * 1024;
constexpr size_t WT_PROJ = WT_GATE + 2 * 1024 * 1024;
constexpr size_t WT_CK1 = WT_PROJ + 2 * 1024 * 256;
constexpr size_t WT_CV1 = WT_CK1 + 128 * 2048;
constexpr size_t WT_CK2 = WT_CV1 + 128 * 2048;
constexpr size_t WT_CV2 = WT_CK2 + 64 * 128;
constexpr size_t WT_RGA = WT_CV2 + 64 * 128;
constexpr size_t WT_RGX = WT_RGA + 8 * 64 * 64;
constexpr size_t MS_ROPE = 0;
constexpr size_t MS_FOXF = 4 * MiB;
constexpr size_t MS_EGL = 6 * MiB;
constexpr size_t MS_CTR = 6 * MiB + 65536;
constexpr size_t MS_KCMP = 7 * MiB;
constexpr size_t MS_VCMPT = 8 * MiB;
constexpr size_t MS_RGAGG = 9 * MiB;
constexpr size_t MS_PTAB = 13 * MiB;
constexpr size_t MS_KMAX = 14 * MiB;
constexpr size_t MS_SS = 15 * MiB;
constexpr int YE_LD = 3584, YO_LD = 2304;
constexpr int GDN_CH_BYTES = 73728;
constexpr int LDS_BYTES = 73728;
constexpr float LOG2E = 1.4426950408889634f;
constexpr float NEGF = -1e30f;

struct WDesc { const float* src; bf16_t* dst; const float* scale; int K, N, Nd, kind, nb, tile0; };
constexpr int NWD = 18;
struct Params {
  const float* in[34];
  const int* positions;
  float* out;
  char* ws;
  WDesc wd[NWD];
  int prep_tiles;
  int pad_;
};

template <class T> DEVI T* as_global(T* q) {
  typedef T __attribute__((address_space(1)))* gp_t;
  return (T*)((gp_t)q);
}
typedef unsigned v4u_t_ __attribute__((ext_vector_type(4)));
typedef float v4f_t_ __attribute__((ext_vector_type(4)));
DEVI uint4 gld16_(const void* q) { typedef const v4u_t_ __attribute__((address_space(1))) gv; v4u_t_ v = *(gv*)q; return make_uint4(v.x, v.y, v.z, v.w); }
DEVI float4 gldf4_(const void* q) { typedef const v4f_t_ __attribute__((address_space(1))) gv; v4f_t_ v = *(gv*)q; return make_float4(v.x, v.y, v.z, v.w); }
#define GLD16(ptr) gld16_(ptr)
#define GLDF4(ptr) gldf4_(ptr)
DEVI char* gws(const Params& p) { return as_global(p.ws); }
DEVI const float* gin(const Params& p, int i) { return as_global(p.in[i]); }
DEVI int opaque_tid() { int t = threadIdx.x; asm volatile("" : "+v"(t)); return t; }
DEVI bf16_t f2bf(float f) { unsigned u = __float_as_uint(f); u += 0x7fffu + ((u >> 16) & 1u); return (bf16_t)(u >> 16); }
DEVI float bf2f(bf16_t b) { return __uint_as_float(((unsigned)b) << 16); }
typedef __bf16 bf2_t_ __attribute__((ext_vector_type(2)));
typedef float f2_t_ __attribute__((ext_vector_type(2)));
DEVI unsigned pack2(float a, float b) { f2_t_ f = {a, b}; bf2_t_ hh = __builtin_convertvector(f, bf2_t_); return __builtin_bit_cast(unsigned, hh); }
DEVI float lo2f(unsigned u) { return __uint_as_float(u << 16); }
DEVI float hi2f(unsigned u) { return __uint_as_float(u & 0xffff0000u); }
DEVI f32x4 mfma16(bf16x8 a, bf16x8 b, f32x4 c) { return __builtin_amdgcn_mfma_f32_16x16x32_bf16(a, b, c, 0, 0, 0); }
DEVI float sigmoidf_(float x) { return 1.f / (1.f + __expf(-x)); }
DEVI float softplusf_(float x) { return fmaxf(x, 0.f) + log1pf(__expf(-fabsf(x))); }
DEVI float gelu_tanh(float x) { float u = 0.7978845608028654f * (x + 0.044715f * x * x * x); float e = __expf(-2.f * fabsf(u)); float t = (1.f - e) / (1.f + e); t = u < 0 ? -t : t; return 0.5f * x * (1.f + t); }
DEVI float fexp2(float x) { return __builtin_amdgcn_exp2f(x); }
DEVI bf16x8 mk8(unsigned a, unsigned b, unsigned c, unsigned d) { uint4 v = make_uint4(a, b, c, d); return __builtin_bit_cast(bf16x8, v); }

DEVI int colmap(int kind, int n) {
  if (kind == 0) return n;
  if (kind == 1) {
    if (n < 1536) return n;
    if (n < 3584) return n + 8;
    if (n < 3592) return 1536 + (n - 3584);
    if (n < 3600) return n;
    return -1;
  }
  if (n < 1280) return n;
  if (n < 2304) return n + 24;
  if (n < 2328) return 1280 + (n - 2304);
  return -1;
}

DEVI void phase_prep(const Params& p, char* smem) {
  float (*t)[65] = (float (*)[65])smem;
  int tid = opaque_tid();
  for (int tile = blockIdx.x; tile < p.prep_tiles; tile += gridDim.x) {
    int di = 0;
#pragma unroll 1
    for (int i = 1; i < NWD; i++) if (tile >= p.wd[i].tile0) di = i;
    const WDesc& w = p.wd[di];
    int lt = tile - w.tile0;
    int tk = w.K / 64, tn = w.Nd / 64;
    int bi = lt / (tk * tn); lt -= bi * tk * tn;
    int k0 = (lt / tn) * 64, n0 = (lt % tn) * 64;
    const float* src = w.src + (size_t)bi * w.K * w.N;
    bf16_t* dst = w.dst + (size_t)bi * w.Nd * w.K;
    int nl = tid & 63, kl = tid >> 6;
    int col = colmap(w.kind, n0 + nl);
    if (col >= w.N) col = -1;
#pragma unroll 4
    for (int pp = 0; pp < 16; pp++) {
      int k = kl + pp * 4;
      float scl = w.scale ? w.scale[bi * w.K + k0 + k] : 1.f;
      t[k][nl] = (col >= 0) ? src[(size_t)(k0 + k) * w.N + col] * scl : 0.f;
    }
    __syncthreads();
#pragma unroll 4
    for (int pp = 0; pp < 16; pp++) {
      int n = kl + pp * 4;
      dst[(size_t)(n0 + n) * w.K + k0 + nl] = f2bf(t[nl][n]);
    }
    __syncthreads();
  }
  float* rope = (float*)(gws(p) + OFF_MISC + MS_ROPE);
  int gt = blockIdx.x * 256 + tid, gs = gridDim.x * 256;
  for (int i = gt; i < M_ * 8; i += gs) {
    int m = i >> 3, f = i & 7;
    float invf = powf(500000.f, -(float)f * 0.125f);
    float ang = (float)p.positions[m] * invf;
    double n = rint((double)ang * 0.15915494309189535);
    float r = (float)((double)ang - n * 6.283185307179586);
    rope[m * 16 + f] = cosf(r);
    rope[m * 16 + 8 + f] = sinf(r);
  }
  if (gt < 16) ((int*)(gws(p) + OFF_MISC + MS_CTR))[gt] = 0;
  if (gt < 64) ((unsigned*)(gws(p) + OFF_MISC + MS_KMAX))[gt] = 0u;
  { float* ssz = (float*)(gws(p) + OFF_MISC + MS_SS); for (int i = M_ + gt; i < 6 * M_; i += gs) ssz[i] = 0.f; }
  bf16_t* kc = (bf16_t*)(gws(p) + OFF_MISC + MS_KCMP);
  bf16_t* vc = (bf16_t*)(gws(p) + OFF_MISC + MS_VCMPT);
  for (int i = gt; i < B_ * 128; i += gs) { int b = i >> 7, c = i & 127; kc[((size_t)b * 512 + 511) * 128 + c] = 0; vc[((size_t)b * 128 + c) * 512 + 511] = 0; }
}

DEVI void phase_norm(const float* __restrict__ src, const float* __restrict__ w, bf16_t* __restrict__ dstb, float* __restrict__ dstf) {
  int lane = opaque_tid() & 63;
  int gw = blockIdx.x * 4 + (opaque_tid() >> 6), nw = gridDim.x * 4;
  for (int row = gw; row < M_; row += nw) {
    const float4* s4 = (const float4*)(src + (size_t)row * 1024);
    float4 v[4]; float ss = 0.f;
#pragma unroll
    for (int i = 0; i < 4; i++) { v[i] = s4[lane + i * 64]; ss += v[i].x * v[i].x + v[i].y * v[i].y + v[i].z * v[i].z + v[i].w * v[i].w; }
#pragma unroll
    for (int o = 32; o >= 1; o >>= 1) ss += __shfl_xor(ss, o);
    float rs = rsqrtf(ss * (1.f / 1024.f) + 1e-6f);
#pragma unroll
    for (int i = 0; i < 4; i++) {
      float4 ww = ((const float4*)w)[lane + i * 64];
      float a = v[i].x * rs * ww.x, b = v[i].y * rs * ww.y, c = v[i].z * rs * ww.z, d = v[i].w * rs * ww.w;
      if (dstf) ((float4*)(dstf + (size_t)row * 1024))[lane + i * 64] = make_float4(a, b, c, d);
      else ((uint2*)(dstb + (size_t)row * 1024))[lane + i * 64] = make_uint2(pack2(a, b), pack2(c, d));
    }
  }
}
DEVI void phase_xprep(const float* __restrict__ src, bf16_t* __restrict__ dstb, float* __restrict__ ss) {
  int lane = opaque_tid() & 63;
  int gw = blockIdx.x * 4 + (opaque_tid() >> 6), nw = gridDim.x * 4;
  for (int row = gw; row < M_; row += nw) {
    const float4* s4 = (const float4*)(src + (size_t)row * 1024);
    float acc = 0.f;
#pragma unroll
    for (int i = 0; i < 4; i++) {
      float4 v = s4[lane + i * 64];
      acc += v.x * v.x + v.y * v.y + v.z * v.z + v.w * v.w;
      ((uint2*)(dstb + (size_t)row * 1024))[lane + i * 64] = make_uint2(pack2(v.x, v.y), pack2(v.z, v.w));
    }
#pragma unroll
    for (int o = 32; o >= 1; o >>= 1) acc += __shfl_xor(acc, o);
    if (lane == 0) ss[row] = acc;
  }
}
DEVI void phase_cvt_p(const float* __restrict__ src, bf16_t* __restrict__ dst) {
  size_t n4 = (size_t)M_ * 256 / 4;
  for (size_t i = (size_t)blockIdx.x * 256 + opaque_tid(); i < n4; i += (size_t)gridDim.x * 256) {
    float4 v = ((const float4*)src)[i];
    ((uint2*)dst)[i] = make_uint2(pack2(v.x, v.y), pack2(v.z, v.w));
  }
}

struct GemmSmem { bf16_t a[2][128][72]; bf16_t b[2][128][72]; };

struct ALoadPlain {
  const bf16_t* A; int lda; int toff;
  DEVI void init(int lr, int lc) { toff = lr * lda + lc; }
  DEVI uint4 load(int i, int k) const { const bf16_t* ub = A + ((size_t)(i * 32) * lda + k); return *(const uint4*)(ub + toff); }
};

template <bool SWAP, class AL>
DEVI void gemm_mainloop(const AL& al_in, const bf16_t* __restrict__ Bt, int ldb, int K, char* smem, f32x4 (&acc)[4][4]) {
  GemmSmem& sm = *(GemmSmem*)smem;
  const int tid = opaque_tid(), lane = tid & 63, wid = tid >> 6, wr = wid >> 1, wc = wid & 1;
  const int lr = tid >> 3, lc = (tid & 7) * 8;
  const int fr = lane & 15, fq = lane >> 4;
  uint4 ra0, ra1, ra2, ra3, rb0, rb1, rb2, rb3;
  uint4 qa0, qa1, qa2, qa3, qb0, qb1, qb2, qb3;
  const int btoff = lr * ldb + lc;
  AL al = al_in; al.init(lr, lc);
#define GL_A(k) do { ra0 = al.load(0, (k)); ra1 = al.load(1, (k)); ra2 = al.load(2, (k)); ra3 = al.load(3, (k)); \
    rb0 = *(const uint4*)(Bt + (k) + btoff); rb1 = *(const uint4*)(Bt + ((size_t)32 * ldb + (k)) + btoff); rb2 = *(const uint4*)(Bt + ((size_t)64 * ldb + (k)) + btoff); rb3 = *(const uint4*)(Bt + ((size_t)96 * ldb + (k)) + btoff); } while (0)
#define GL_B(k) do { qa0 = al.load(0, (k)); qa1 = al.load(1, (k)); qa2 = al.load(2, (k)); qa3 = al.load(3, (k)); \
    qb0 = *(const uint4*)(Bt + (k) + btoff); qb1 = *(const uint4*)(Bt + ((size_t)32 * ldb + (k)) + btoff); qb2 = *(const uint4*)(Bt + ((size_t)64 * ldb + (k)) + btoff); qb3 = *(const uint4*)(Bt + ((size_t)96 * ldb + (k)) + btoff); } while (0)
#define ST_A(bf) do { *(uint4*)&sm.a[bf][lr][lc] = ra0; *(uint4*)&sm.a[bf][lr + 32][lc] = ra1; *(uint4*)&sm.a[bf][lr + 64][lc] = ra2; *(uint4*)&sm.a[bf][lr + 96][lc] = ra3; \
    *(uint4*)&sm.b[bf][lr][lc] = rb0; *(uint4*)&sm.b[bf][lr + 32][lc] = rb1; *(uint4*)&sm.b[bf][lr + 64][lc] = rb2; *(uint4*)&sm.b[bf][lr + 96][lc] = rb3; } while (0)
#define ST_B(bf) do { *(uint4*)&sm.a[bf][lr][lc] = qa0; *(uint4*)&sm.a[bf][lr + 32][lc] = qa1; *(uint4*)&sm.a[bf][lr + 64][lc] = qa2; *(uint4*)&sm.a[bf][lr + 96][lc] = qa3; \
    *(uint4*)&sm.b[bf][lr][lc] = qb0; *(uint4*)&sm.b[bf][lr + 32][lc] = qb1; *(uint4*)&sm.b[bf][lr + 64][lc] = qb2; *(uint4*)&sm.b[bf][lr + 96][lc] = qb3; } while (0)
#define COMPUTE(bf) do { _Pragma("unroll") for (int kk = 0; kk < 2; kk++) { \
      bf16x8 af[4], bfr[4]; \
      _Pragma("unroll") for (int i = 0; i < 4; i++) af[i] = *(const bf16x8*)&sm.a[bf][wr * 64 + i * 16 + fr][kk * 32 + fq * 8]; \
      _Pragma("unroll") for (int j = 0; j < 4; j++) bfr[j] = *(const bf16x8*)&sm.b[bf][wc * 64 + j * 16 + fr][kk * 32 + fq * 8]; \
      __builtin_amdgcn_s_setprio(1); \
      _Pragma("unroll") for (int i = 0; i < 4; i++) _Pragma("unroll") for (int j = 0; j < 4; j++) \
          acc[i][j] = SWAP ? mfma16(bfr[j], af[i], acc[i][j]) : mfma16(af[i], bfr[j], acc[i][j]); \
      __builtin_amdgcn_s_setprio(0); } } while (0)
  const int nk = K >> 6;
  GL_A(0);
  ST_A(0);
  GL_A(64);
  __syncthreads();
  for (int kt = 0; kt < nk; kt += 2) {
    if (kt + 2 < nk) GL_B((kt + 2) * 64);
    COMPUTE(0);
    ST_A(1);
    __syncthreads();
    if (kt + 3 < nk) GL_A((kt + 3) * 64);
    COMPUTE(1);
    if (kt + 2 < nk) ST_B(0);
    __syncthreads();
  }
#undef GL_A
#undef GL_B
#undef ST_A
#undef ST_B
#undef COMPUTE
}
template <bool SWAP>
DEVI void gemm_mainloop_dma(const bf16_t* __restrict__ A, int lda, const bf16_t* __restrict__ Bt, int ldb, int K, char* smem, f32x4 (&acc)[8][4]) {
  const int tid = opaque_tid(), lane = tid & 63, wid = tid >> 6, wr = wid >> 1, wc = wid & 1;
  const int fr = lane & 15, fq = lane >> 4;
  const int gc = (tid & 3) ^ ((0x1320 >> (((tid >> 4) & 3) * 4)) & 3);
  const int aoff = (tid >> 2) * lda + gc * 8, boff = (tid >> 2) * ldb + gc * 8;
  char* lds_t = smem + tid * 16;
#define DMA_ISSUE(st, k0) do { \
    _Pragma("unroll") for (int j = 0; j < 4; j++) \
      __builtin_amdgcn_global_load_lds((const unsigned*)(A + ((size_t)(j * 64) * lda + (k0)) + aoff), (unsigned*)(lds_t + (st) * 24576 + j * 4096), 16, 0, 0); \
    _Pragma("unroll") for (int j = 0; j < 2; j++) \
      __builtin_amdgcn_global_load_lds((const unsigned*)(Bt + ((size_t)(j * 64) * ldb + (k0)) + boff), (unsigned*)(lds_t + (st) * 24576 + 16384 + j * 4096), 16, 0, 0); } while (0)
  const int co = (fq ^ ((0x1320 >> (((fr >> 2) & 3) * 4)) & 3)) * 16;
  const int arow = (wr * 128 + fr) * 64 + co, brow = 16384 + (wc * 64 + fr) * 64 + co;
  const int nk = K >> 5;
  DMA_ISSUE(0, 0); DMA_ISSUE(1, 32);
  int stg = 0;
  for (int kt = 0; kt < nk; kt++) {
    if (kt + 1 < nk) asm volatile("s_waitcnt vmcnt(6)" ::: "memory");
    else asm volatile("s_waitcnt vmcnt(0)" ::: "memory");
    __builtin_amdgcn_s_barrier();
    int nst = stg == 0 ? 2 : stg - 1;
    if (kt + 2 < nk) DMA_ISSUE(nst, (kt + 2) * 32);
    const char* st = smem + stg * 24576;
    bf16x8 bfr[4];
#pragma unroll
    for (int j = 0; j < 4; j++) bfr[j] = *(const bf16x8*)(st + brow + j * 1024);
#pragma unroll
    for (int ih = 0; ih < 2; ih++) {
      bf16x8 af[4];
#pragma unroll
      for (int i = 0; i < 4; i++) af[i] = *(const bf16x8*)(st + arow + (ih * 4 + i) * 1024);
      __builtin_amdgcn_s_setprio(1);
#pragma unroll
      for (int i = 0; i < 4; i++)
#pragma unroll
        for (int j = 0; j < 4; j++)
          acc[ih * 4 + i][j] = SWAP ? mfma16(bfr[j], af[i], acc[ih * 4 + i][j]) : mfma16(af[i], bfr[j], acc[ih * 4 + i][j]);
      __builtin_amdgcn_s_setprio(0);
    }
    stg = stg == 2 ? 0 : stg + 1;
  }
  __syncthreads();
#undef DMA_ISSUE
}
DEVI void zero_acc8(f32x4 (&acc)[8][4]) {
#pragma unroll
  for (int i = 0; i < 8; i++)
#pragma unroll
    for (int j = 0; j < 4; j++) acc[i][j] = f32x4{0.f, 0.f, 0.f, 0.f};
}
DEVI int xcd_vid() { int g8 = gridDim.x >> 3; return (blockIdx.x & 7) * g8 + (blockIdx.x >> 3); }
DEVI void zero_acc(f32x4 (&acc)[4][4]) {
#pragma unroll
  for (int i = 0; i < 4; i++)
#pragma unroll
    for (int j = 0; j < 4; j++) acc[i][j] = f32x4{0.f, 0.f, 0.f, 0.f};
}

enum { EP_BF16 = 0, EP_RELU2 = 1, EP_RESID = 2 };
DEVI float row_rstd(const float* ss, size_t m) { return rsqrtf(ss[m] * (1.f / 1024.f) + 1e-6f); }
template <int EP>
DEVI void phase_gemm(const bf16_t* A, int lda, const bf16_t* Bt, int K, int NT, bf16_t* Cb, int ldc,
                     const float* res, float* outf, bf16_t* hb, const float* ss_in, float* ss_out, char* smem) {
  const int tid = opaque_tid(), lane = tid & 63, wid = tid >> 6, wr = wid >> 1, wc = wid & 1, fr = lane & 15, fq = lane >> 4;
  const int ntiles = 256 * NT;
  for (int tile = xcd_vid(); tile < ntiles; tile += gridDim.x) {
    int mt = tile / NT, nt = tile % NT;
    f32x4 acc[8][4]; zero_acc8(acc);
    gemm_mainloop_dma<true>(A + (size_t)mt * 256 * lda, lda, Bt + (size_t)nt * 128 * K, K, K, smem, acc);
#pragma unroll
    for (int i = 0; i < 8; i++) {
      size_t m = (size_t)mt * 256 + wr * 128 + i * 16 + fr;
      float rs = (EP == EP_RELU2) ? row_rstd(ss_in, m) : 1.f;
      float part = 0.f;
#pragma unroll
      for (int j = 0; j < 4; j++) {
        int n = nt * 128 + wc * 64 + j * 16 + fq * 4;
        f32x4 v = acc[i][j];
        if (EP == EP_BF16) {
          *(uint2*)(Cb + m * ldc + n) = make_uint2(pack2(v[0], v[1]), pack2(v[2], v[3]));
        } else if (EP == EP_RELU2) {
          float a = fmaxf(v[0], 0.f) * rs, b = fmaxf(v[1], 0.f) * rs, c = fmaxf(v[2], 0.f) * rs, d = fmaxf(v[3], 0.f) * rs;
          *(uint2*)(Cb + m * ldc + n) = make_uint2(pack2(a * a, b * b), pack2(c * c, d * d));
        } else {
          float4 r = *(const float4*)(res + m * 1024 + n);
          float o0 = r.x + v[0], o1 = r.y + v[1], o2 = r.z + v[2], o3 = r.w + v[3];
          *(float4*)(outf + m * 1024 + n) = make_float4(o0, o1, o2, o3);
          *(uint2*)(hb + m * 1024 + n) = make_uint2(pack2(o0, o1), pack2(o2, o3));
          part += o0 * o0 + o1 * o1 + o2 * o2 + o3 * o3;
        }
      }
      if (EP == EP_RESID) {
        part += __shfl_xor(part, 16); part += __shfl_xor(part, 32);
        if (fq == 0) atomicAdd(&ss_out[m], part);
      }
      __builtin_amdgcn_sched_barrier(0);
    }
  }
}

struct ALoadF32 {
  const float* A; int lda; int lr, lc;
  DEVI void init(int lr_, int lc_) { lr = lr_; lc = lc_; }
  DEVI uint4 load(int i, int k) const {
    const float4* s = (const float4*)(A + (size_t)(lr + i * 32) * lda + k + lc);
    float4 a = s[0], b = s[1];
    return make_uint4(pack2(a.x, a.y), pack2(a.z, a.w), pack2(b.x, b.y), pack2(b.z, b.w));
  }
};
DEVI void phase_pp(const bf16_t* pf, const bf16_t* Wp, bf16_t* pp, char* smem) {
  const int tid = opaque_tid(), lane = tid & 63, wid = tid >> 6, wr = wid >> 1, wc = wid & 1, fr = lane & 15, fq = lane >> 4;
  for (int tile = xcd_vid(); tile < 256 * 8; tile += gridDim.x) {
    int mt = tile >> 3, nt = tile & 7;
    f32x4 acc[8][4]; zero_acc8(acc);
    gemm_mainloop_dma<true>(pf + (size_t)mt * 256 * 256, 256, Wp + (size_t)nt * 128 * 256, 256, 256, smem, acc);
#pragma unroll
    for (int i = 0; i < 8; i++) {
      size_t m = (size_t)mt * 256 + wr * 128 + i * 16 + fr;
#pragma unroll
      for (int j = 0; j < 4; j++) {
        int n = nt * 128 + wc * 64 + j * 16 + fq * 4;
        f32x4 v = acc[i][j];
        *(uint2*)(pp + m * 1024 + n) = make_uint2(pack2(v[0], v[1]), pack2(v[2], v[3]));
      }
    }
  }
}
DEVI void phase_ple(const bf16_t* hbin, const bf16_t* Wg, const bf16_t* pp, float* h, bf16_t* hb, const float* ss_in, float* ss_out, char* smem) {
  const int tid = opaque_tid(), lane = tid & 63, wid = tid >> 6, wr = wid >> 1, wc = wid & 1, fr = lane & 15, fq = lane >> 4;
  for (int tile = xcd_vid(); tile < 256 * 8; tile += gridDim.x) {
    int mt = tile >> 3, nt = tile & 7;
    f32x4 acc[8][4]; zero_acc8(acc);
    gemm_mainloop_dma<true>(hbin + (size_t)mt * 256 * 1024, 1024, Wg + (size_t)nt * 128 * 1024, 1024, 1024, smem, acc);
#pragma unroll
    for (int i = 0; i < 8; i++) {
      size_t m = (size_t)mt * 256 + wr * 128 + i * 16 + fr;
      float rs = row_rstd(ss_in, m);
      float part = 0.f;
#pragma unroll
      for (int j = 0; j < 4; j++) {
        int n = nt * 128 + wc * 64 + j * 16 + fq * 4;
        float4 r = *(const float4*)(h + m * 1024 + n);
        uint2 q = *(const uint2*)(pp + m * 1024 + n);
        f32x4 g = acc[i][j];
        float o0 = r.x + sigmoidf_(g[0] * rs) * lo2f(q.x), o1 = r.y + sigmoidf_(g[1] * rs) * hi2f(q.x);
        float o2 = r.z + sigmoidf_(g[2] * rs) * lo2f(q.y), o3 = r.w + sigmoidf_(g[3] * rs) * hi2f(q.y);
        *(float4*)(h + m * 1024 + n) = make_float4(o0, o1, o2, o3);
        if (hb) {
          *(uint2*)(hb + m * 1024 + n) = make_uint2(pack2(o0, o1), pack2(o2, o3));
          part += o0 * o0 + o1 * o1 + o2 * o2 + o3 * o3;
        }
      }
      if (hb) {
        part += __shfl_xor(part, 16); part += __shfl_xor(part, 32);
        if (fq == 0) atomicAdd(&ss_out[m], part);
      }
      __builtin_amdgcn_sched_barrier(0);
    }
  }
}

struct InTileKind { int kind; int ycol; bf16_t* vt; int vtrows; int nsmall; };
template <bool EVEN>
DEVI InTileKind in_tile_kind(const Params& p, int nt) {
  InTileKind k{0, nt * 128, nullptr, 0, 0};
  char* Y = gws(p) + OFF_Y;
  if (EVEN) {
    if (nt >= 8 && nt < 12) { k.kind = 2; k.vt = (bf16_t*)(Y + 448 * MiB) + (size_t)(nt - 8) * 128 * S_; k.vtrows = 512; }
    else if (nt == 28) { k.kind = 3; k.nsmall = 16; }
  } else {
    if (nt < 5 || nt == 6 || nt == 8) k.kind = 1;
    else if (nt == 7) { k.kind = 2; k.vt = (bf16_t*)(Y + 288 * MiB); k.vtrows = 128; }
    else if (nt == 9) { k.kind = 2; k.vt = (bf16_t*)(Y + 304 * MiB); k.vtrows = 128; }
    else if (nt == 18) { k.kind = 3; k.nsmall = 24; }
  }
  return k;
}
template <bool EVEN>
DEVI void phase_gemm_in(const Params& p, const bf16_t* hn, const float* ss_in, char* smem) {
  const int tid = opaque_tid(), lane = tid & 63, wid = tid >> 6, wr = wid >> 1, wc = wid & 1, fr = lane & 15, fq = lane >> 4;
  constexpr int NT = EVEN ? 29 : 19;
  constexpr int LDY = EVEN ? YE_LD : YO_LD;
  const bf16_t* Wt = (const bf16_t*)(gws(p) + OFF_WT) + (EVEN ? WT_IN_E : WT_IN_O);
  bf16_t* Y = (bf16_t*)(gws(p) + OFF_Y);
  float* ysm = (float*)(gws(p) + OFF_SM);
  const float* rope = (const float*)(gws(p) + OFF_MISC + MS_ROPE);
  for (int tile = xcd_vid(); tile < 256 * NT; tile += gridDim.x) {
    int mt = tile / NT, nt = tile % NT;
    InTileKind tk = in_tile_kind<EVEN>(p, nt);
    f32x4 acc[8][4]; zero_acc8(acc);
    gemm_mainloop_dma<true>(hn + (size_t)mt * 256 * 1024, 1024, Wt + (size_t)nt * 128 * 1024, 1024, 1024, smem, acc);
    if (tk.kind == 2) {
      int b = (mt * 256) / S_, s0 = (mt * 256) % S_;
#pragma unroll
      for (int i = 0; i < 8; i++)
#pragma unroll
        for (int j = 0; j < 4; j++) {
          int n = wc * 64 + j * 16 + fq * 4, s = s0 + wr * 128 + i * 16 + fr;
          f32x4 v = acc[i][j] * row_rstd(ss_in, (size_t)mt * 256 + wr * 128 + i * 16 + fr);
          bf16_t* dst = tk.vt + ((size_t)b * tk.vtrows + n) * S_ + s;
#pragma unroll
          for (int r = 0; r < 4; r++) dst[(size_t)r * S_] = f2bf(v[r]);
        }
    } else {
#pragma unroll
      for (int i = 0; i < 8; i++) {
        size_t m = (size_t)mt * 256 + wr * 128 + i * 16 + fr;
        {
          float rs = row_rstd(ss_in, m);
#pragma unroll
          for (int j = 0; j < 4; j++) acc[i][j] *= rs;
        }
        if (tk.kind == 1) {
          const float* rp = rope + m * 16;
          f32x4 v = acc[i][0];
#pragma unroll
          for (int r = 0; r < 4; r++) {
            float pv = __shfl_xor(v[r], 32);
            int d8 = (fq & 1) * 4 + r;
            float c = rp[d8], s = rp[8 + d8];
            acc[i][0][r] = (fq < 2) ? (v[r] * c - pv * s) : (v[r] * c + pv * s);
          }
        }
#pragma unroll
        for (int j = 0; j < 4; j++) {
          int nl = wc * 64 + j * 16 + fq * 4;
          f32x4 v = acc[i][j];
          if (tk.kind == 3) {
#pragma unroll
            for (int r = 0; r < 4; r++) if (nl + r < tk.nsmall) ysm[m * 32 + nl + r] = v[r];
          } else {
            *(uint2*)(Y + m * LDY + tk.ycol + nl) = make_uint2(pack2(v[0], v[1]), pack2(v[2], v[3]));
          }
        }
      }
    }
  }
}

struct AttnSmem { bf16_t k[2][64][72]; bf16_t vt[2][64][72]; float fk[2][64]; };
constexpr int SM_IMP = 37376;
constexpr int SM_SELM = 71168;
constexpr int SM_BOR = 72192;
constexpr int SM_SLOT = 73712;
typedef unsigned long long u64;

DEVI int next_tile(u64 lo, u64 hi, int after) {
  if (after < 63) { u64 x = lo & (~0ull << (after + 1)); if (x) return __builtin_ctzll(x); }
  int a2 = after < 63 ? -1 : after - 64;
  if (a2 < 63) { u64 y = hi & (~0ull << (a2 + 1)); if (y) return 64 + __builtin_ctzll(y); }
  return -1;
}

DEVI float xq_max(float a) {
  auto r = __builtin_amdgcn_permlane16_swap(__float_as_uint(a), __float_as_uint(a), false, false);
  a = fmaxf(a, fmaxf(__uint_as_float(r[0]), __uint_as_float(r[1])));
  auto q = __builtin_amdgcn_permlane32_swap(__float_as_uint(a), __float_as_uint(a), false, false);
  return fmaxf(a, fmaxf(__uint_as_float(q[0]), __uint_as_float(q[1])));
}
template <int MODE, int NQT, class Pol>
DEVI void attn_compute(Pol& pol, AttnSmem& sm, int buf, int kb, const bf16x8 (&qf)[NQT][2], f32x4 (&o)[4][NQT], float (&m)[NQT], float (&l)[NQT], float* impw, int fr, int fq) {
      pol.begin(kb, sm.fk[buf]);
      const bool msk = pol.masked(kb);
      f32x4 s[4][NQT];
#pragma unroll
      for (int kt = 0; kt < 4; kt++)
#pragma unroll
        for (int qt = 0; qt < NQT; qt++) s[kt][qt] = f32x4{0.f, 0.f, 0.f, 0.f};
#pragma unroll
      for (int kt = 0; kt < 4; kt++)
#pragma unroll
        for (int kk = 0; kk < 2; kk++) {
          bf16x8 kf = *(const bf16x8*)&sm.k[buf][kt * 16 + fr][kk * 32 + fq * 8];
#pragma unroll
          for (int qt = 0; qt < NQT; qt++) s[kt][qt] = mfma16(kf, qf[qt][kk], s[kt][qt]);
        }
      bf16x8 pfr[2][NQT];
      float psum[4][4];
      if (MODE == 2) {
#pragma unroll
        for (int kt = 0; kt < 4; kt++)
#pragma unroll
          for (int r = 0; r < 4; r++) psum[kt][r] = 0.f;
      }
#pragma unroll
      for (int qt = 0; qt < NQT; qt++) {
        float t[4][4];
        if (Pol::UB && MODE != 2 && !msk) {
          const float bl = pol.lane_bias();
          float mxr = fmaxf(fmaxf(s[0][qt][0], s[0][qt][1]), fmaxf(s[0][qt][2], s[0][qt][3]));
#pragma unroll
          for (int kt = 1; kt < 4; kt++) mxr = fmaxf(mxr, fmaxf(fmaxf(s[kt][qt][0], s[kt][qt][1]), fmaxf(s[kt][qt][2], s[kt][qt][3])));
          float mx = xq_max(fmaf(mxr, pol.sc, bl));
          float mnew = fmaxf(m[qt], mx);
          float alpha = fexp2(m[qt] - mnew);
          m[qt] = mnew;
          const float cb = bl - fmaxf(mnew, 0.1f * NEGF);
          float ps = 0.f;
#pragma unroll
          for (int kt = 0; kt < 4; kt++)
#pragma unroll
            for (int r = 0; r < 4; r++) { t[kt][r] = fexp2(fmaf(s[kt][qt][r], pol.sc, cb)); ps += t[kt][r]; }
          l[qt] = l[qt] * alpha + ps;
          if (MODE == 0) {
            if (__any(alpha != 1.f)) {
#pragma unroll
              for (int dt = 0; dt < 4; dt++) o[dt][qt] *= alpha;
            }
          }
        } else {
#pragma unroll
        for (int kt = 0; kt < 4; kt++) {
          f32x4 bb = pol.bias4(kt * 16 + fq * 4);
#pragma unroll
          for (int r = 0; r < 4; r++) t[kt][r] = fmaf(s[kt][qt][r], pol.sc, bb[r]);
        }
        if (msk) {
#pragma unroll
          for (int kt = 0; kt < 4; kt++)
#pragma unroll
            for (int r = 0; r < 4; r++) t[kt][r] = pol.ok(qt, kt * 16 + fq * 4 + r) ? t[kt][r] : NEGF;
        }
        if (MODE == 2) {
#pragma unroll
          for (int kt = 0; kt < 4; kt++)
#pragma unroll
            for (int r = 0; r < 4; r++) {
              t[kt][r] = fexp2(t[kt][r] - fmaxf(m[qt], 0.1f * NEGF)) * l[qt];
              psum[kt][r] += t[kt][r];
            }
        } else {
          float mx = fmaxf(fmaxf(t[0][0], t[0][1]), fmaxf(t[0][2], t[0][3]));
#pragma unroll
          for (int kt = 1; kt < 4; kt++) mx = fmaxf(mx, fmaxf(fmaxf(t[kt][0], t[kt][1]), fmaxf(t[kt][2], t[kt][3])));
          mx = xq_max(mx);
          float mnew = fmaxf(m[qt], mx);
          float alpha = fexp2(m[qt] - mnew);
          m[qt] = mnew;
          float ps = 0.f;
          const float meff = fmaxf(mnew, 0.1f * NEGF);
#pragma unroll
          for (int kt = 0; kt < 4; kt++)
#pragma unroll
            for (int r = 0; r < 4; r++) { t[kt][r] = fexp2(t[kt][r] - meff); ps += t[kt][r]; }
          l[qt] = l[qt] * alpha + ps;
          if (MODE == 0) {
            if (__any(alpha != 1.f)) {
#pragma unroll
              for (int dt = 0; dt < 4; dt++) o[dt][qt] *= alpha;
            }
          }
        }
        }
        if (MODE != 1) {
#pragma unroll
          for (int h2 = 0; h2 < 2; h2++)
            pfr[h2][qt] = mk8(pack2(t[2 * h2][0], t[2 * h2][1]), pack2(t[2 * h2][2], t[2 * h2][3]), pack2(t[2 * h2 + 1][0], t[2 * h2 + 1][1]), pack2(t[2 * h2 + 1][2], t[2 * h2 + 1][3]));
        }
      }
      if (MODE == 2) {
#pragma unroll
        for (int kt = 0; kt < 4; kt++) {
          int c = kb * 16 + kt * 4 + fq;
          atomicAdd(&impw[fr * 132 + c], (psum[kt][0] + psum[kt][1]) + (psum[kt][2] + psum[kt][3]));
          atomicAdd(&impw[fr * 132 + c + 1], psum[kt][3]);
        }
      }
      if (MODE != 1) {
#pragma unroll
        for (int h2 = 0; h2 < 2; h2++)
#pragma unroll
          for (int dt = 0; dt < 4; dt++) {
            const bf16_t* vr = &sm.vt[buf][dt * 16 + fr][h2 * 32 + fq * 4];
            uint2 v0 = *(const uint2*)vr, v1 = *(const uint2*)(vr + 16);
            bf16x8 vf = mk8(v0.x, v0.y, v1.x, v1.y);
#pragma unroll
            for (int qt = 0; qt < NQT; qt++) o[dt][qt] = mfma16(vf, pfr[h2][qt], o[dt][qt]);
          }
      }
    }
template <int MODE, int NQT, class Pol>
DEVI void attn_core(Pol& pol, char* smem, const bf16x8 (&qf)[NQT][2], const bf16_t* __restrict__ Kg, int ldk,
                    const bf16_t* __restrict__ Vtg, int ldv, const float* __restrict__ fkg, u64 mlo, u64 mhi,
                    f32x4 (&o)[4][NQT], float (&m)[NQT], float (&l)[NQT], float* impw) {
  AttnSmem& sm = *(AttnSmem*)smem;
  const int tid = opaque_tid(), lane = tid & 63, fr = lane & 15, fq = lane >> 4;
  const int lrow = tid >> 3, lch = (tid & 7) * 8;
  int kb = next_tile(mlo, mhi, -1);
  if (kb < 0) return;
  uint4 ak0, ak1, av0 = make_uint4(0, 0, 0, 0), av1 = make_uint4(0, 0, 0, 0); float4 af4 = make_float4(0, 0, 0, 0);
  uint4 bk0, bk1, bv0 = make_uint4(0, 0, 0, 0), bv1 = make_uint4(0, 0, 0, 0); float4 bf4 = make_float4(0, 0, 0, 0);
#define GLOADX(P, t) do { \
    P##k0 = GLD16(Kg + (size_t)((t) * 64 + lrow) * ldk + lch); \
    P##k1 = GLD16(Kg + (size_t)((t) * 64 + lrow + 32) * ldk + lch); \
    if (MODE != 1) { P##v0 = GLD16(Vtg + (size_t)(lrow) * ldv + (t) * 64 + lch); \
                     P##v1 = GLD16(Vtg + (size_t)(lrow + 32) * ldv + (t) * 64 + lch); } \
    if (fkg != nullptr && tid < 16) P##f4 = GLDF4(fkg + (t) * 64 + tid * 4); } while (0)
#define SSTOREX(P, b) do { \
    *(uint4*)&sm.k[b][lrow][lch] = P##k0; *(uint4*)&sm.k[b][lrow + 32][lch] = P##k1; \
    if (MODE != 1) { *(uint4*)&sm.vt[b][lrow][lch] = P##v0; *(uint4*)&sm.vt[b][lrow + 32][lch] = P##v1; } \
    if (fkg != nullptr && tid < 16) *(float4*)&sm.fk[b][tid * 4] = P##f4; } while (0)
#define ATTN_STEP(S, L) do { \
    int kb2 = kb1 >= 0 ? next_tile(mlo, mhi, kb1) : -1; \
    if (kb2 >= 0) GLOADX(L, kb2); \
    if (pol.active(kb)) attn_compute<MODE, NQT, Pol>(pol, sm, buf, kb, qf, o, m, l, impw, fr, fq); \
    if (kb1 >= 0) SSTOREX(S, buf ^ 1); \
    __syncthreads(); \
    buf ^= 1; kb = kb1; kb1 = kb2; } while (0)
  int kb1 = next_tile(mlo, mhi, kb);
  GLOADX(a, kb); SSTOREX(a, 0);
  if (kb1 >= 0) GLOADX(a, kb1);
  __syncthreads();
  int buf = 0;
  for (;;) {
    ATTN_STEP(a, b);
    if (kb < 0) break;
    ATTN_STEP(b, a);
    if (kb < 0) break;
  }
#undef GLOADX
#undef SSTOREX
#undef ATTN_STEP
}
template <int NQT>
DEVI void zero_o(f32x4 (&o)[4][NQT]) {
#pragma unroll
  for (int i = 0; i < 4; i++)
#pragma unroll
    for (int j = 0; j < NQT; j++) o[i][j] = f32x4{0.f, 0.f, 0.f, 0.f};
}

DEVI void phase_fox_f(const Params& p, char* smem) {
  const int tid = opaque_tid(), lane = tid & 63, wid = tid >> 6;
  {
    unsigned* kmaxp = (unsigned*)(gws(p) + OFF_MISC + MS_KMAX);
    for (int slab = blockIdx.x; slab < M_ / 128; slab += gridDim.x) {
      int tok = slab * 128 + (tid >> 1), hh0 = (tid & 1) * 4, b = tok / S_;
      const uint4* kr = (const uint4*)((const bf16_t*)(gws(p) + OFF_Y) + (size_t)tok * YE_LD + 512 + hh0 * 64);
#pragma unroll
      for (int hh = 0; hh < 4; hh++) {
        float ss = 0.f;
#pragma unroll
        for (int c = 0; c < 8; c++) {
          uint4 v = kr[hh * 8 + c];
          float a0 = lo2f(v.x), a1 = hi2f(v.x), a2 = lo2f(v.y), a3 = hi2f(v.y), a4 = lo2f(v.z), a5 = hi2f(v.z), a6 = lo2f(v.w), a7 = hi2f(v.w);
          ss += a0 * a0 + a1 * a1 + a2 * a2 + a3 * a3 + a4 * a4 + a5 * a5 + a6 * a6 + a7 * a7;
        }
        ss = fmaxf(ss, __shfl_xor(ss, 2)); ss = fmaxf(ss, __shfl_xor(ss, 4)); ss = fmaxf(ss, __shfl_xor(ss, 8));
        ss = fmaxf(ss, __shfl_xor(ss, 16)); ss = fmaxf(ss, __shfl_xor(ss, 32));
        if (lane < 2) atomicMax(&kmaxp[b * 8 + hh0 + hh], __float_as_uint(ss));
      }
    }
  }
  if (blockIdx.x < 64) {
    int gw = blockIdx.x, b = gw >> 3, h = gw & 7;
    const float* ysm = (const float*)(gws(p) + OFF_SM) + (size_t)b * S_ * 32 + h;
    float bf = gin(p, 5)[h];
    float* F = (float*)(gws(p) + OFF_MISC + MS_FOXF) + (size_t)gw * S_;
    float ls[32];
    float sum = 0.f;
#pragma unroll
    for (int i = 0; i < 32; i++) { float x = ysm[(size_t)(tid * 32 + i) * 32] + bf; ls[i] = -softplusf_(-x); sum += ls[i]; }
    float incl = sum;
#pragma unroll
    for (int o = 1; o < 64; o <<= 1) { float t = __shfl_up(incl, o); if (lane >= o) incl += t; }
    float* wsum = (float*)smem;
    if (lane == 63) wsum[wid] = incl;
    __syncthreads();
    float off = 0.f;
    for (int w = 0; w < wid; w++) off += wsum[w];
    float run = off + incl - sum;
#pragma unroll
    for (int i = 0; i < 32; i++) { run += ls[i]; F[tid * 32 + i] = run * LOG2E; }
    __syncthreads();
  }
}

struct FoxPol {
  static constexpr bool UB = false;
  DEVI float lane_bias() const { return 0.f; }
  int tq0; int qmin, qmax; int kb; const float* fk; float sc;
  DEVI bool active(int kb_) const { return kb_ * 64 <= qmax; }
  DEVI bool masked(int kb_) const { return kb_ * 64 + 63 > qmin; }
  DEVI void begin(int kb_, const float* f) { kb = kb_; fk = f; }
  DEVI bool ok(int qt, int kl) const { return kb * 64 + kl <= tq0 + qt * 16; }
  DEVI f32x4 bias4(int kl0) const { float4 v = *(const float4*)&fk[kl0]; return f32x4{-v.x, -v.y, -v.z, -v.w}; }
};

DEVI void fox_tile(const Params& p, int item, char* smem) {
  const int tid = opaque_tid(), lane = tid & 63, wid = tid >> 6, fr = lane & 15, fq = lane >> 4;
  int qblk = 63 - (item >> 6), bh = item & 63, b = bh >> 3, h = bh & 7;
  int q0 = qblk * 128 + wid * 32;
  const bf16_t* Y = (const bf16_t*)(gws(p) + OFF_Y) + (size_t)b * S_ * YE_LD;
  const float* F = (const float*)(gws(p) + OFF_MISC + MS_FOXF) + (size_t)bh * S_;
  bf16x8 qf[2][2];
  FoxPol pol;
#pragma unroll
  for (int qt = 0; qt < 2; qt++) {
    int t = q0 + qt * 16 + fr;
#pragma unroll
    for (int kk = 0; kk < 2; kk++) qf[qt][kk] = *(const bf16x8*)(Y + (size_t)t * YE_LD + h * 64 + kk * 32 + fq * 8);
  }
  pol.tq0 = q0 + fr; pol.qmin = q0; pol.qmax = q0 + 31; pol.sc = 0.125f * LOG2E; pol.kb = 0; pol.fk = nullptr;
  f32x4 o[4][2]; zero_o<2>(o);
  float m[2] = {NEGF, NEGF}, l[2] = {0.f, 0.f};
  float qn2 = 0.f;
#pragma unroll
  for (int qt = 0; qt < 2; qt++) {
    float ss = 0.f;
#pragma unroll
    for (int kk = 0; kk < 2; kk++)
#pragma unroll
      for (int e = 0; e < 8; e++) { float v = bf2f((bf16_t)qf[qt][kk][e]); ss += v * v; }
    ss += __shfl_xor(ss, 16); ss += __shfl_xor(ss, 32);
    qn2 = fmaxf(qn2, ss);
  }
#pragma unroll
  for (int o = 8; o >= 1; o >>= 1) qn2 = fmaxf(qn2, __shfl_xor(qn2, o));
  float* red = (float*)(smem + SM_BOR);
  if (lane == 0) red[wid] = qn2;
  __syncthreads();
  qn2 = fmaxf(fmaxf(red[0], red[1]), fmaxf(red[2], red[3]));
  float kmax2 = ((const float*)(gws(p) + OFF_MISC + MS_KMAX))[bh];
  float qkmax = sqrtf(qn2 * kmax2) * pol.sc * 1.001f;
  float thr = -(128.f + 2.f * qkmax);
  int nt = qblk * 2 + 2;
  float fq0 = F[qblk * 128];
  u64 mlo, mhi;
  {
    int k0 = lane, k1 = lane + 64;
    bool n0 = (k0 < nt) && (k0 >= nt - 2 || fq0 - F[k0 * 64 + 63] >= thr);
    bool n1 = (k1 < nt) && (k1 >= nt - 2 || fq0 - F[(k1 < 128 ? k1 : 127) * 64 + 63] >= thr);
    mlo = __ballot(n0); mhi = __ballot(n1);
  }
  const bf16_t* vT = (const bf16_t*)(gws(p) + OFF_Y + 448 * MiB) + ((size_t)b * 512 + h * 64) * S_;
  attn_core<0, 2>(pol, smem, qf, Y + 512 + h * 64, YE_LD, vT, S_, F, mlo, mhi, o, m, l, nullptr);
  bf16_t* mix = (bf16_t*)(gws(p) + OFF_MIX) + (size_t)b * S_ * 1024;
#pragma unroll
  for (int qt = 0; qt < 2; qt++) {
    float lt = l[qt]; lt += __shfl_xor(lt, 16); lt += __shfl_xor(lt, 32);
    float inv = 1.f / lt;
#pragma unroll
    for (int dt = 0; dt < 4; dt++) {
      f32x4 v = o[dt][qt];
      *(uint2*)(mix + (size_t)(pol.tq0 + qt * 16) * 1024 + h * 64 + dt * 16 + fq * 4) = make_uint2(pack2(v[0] * inv, v[1] * inv), pack2(v[2] * inv, v[3] * inv));
    }
  }
}

DEVI void emit_afrag(const bf16_t* st, int ld, int nrt, int nkk, char* gdst) {
  for (int c = opaque_tid(); c < nrt * nkk * 64; c += 256) {
    int ln = c & 63, rk = c >> 6, rt = rk / nkk, kk = rk % nkk;
    int row = rt * 16 + (ln & 15), k0 = kk * 32 + (ln >> 4) * 4;
    uint2 a = *(const uint2*)&st[row * ld + k0], b = *(const uint2*)&st[row * ld + k0 + 16];
    *(uint4*)(gdst + (size_t)c * 16) = make_uint4(a.x, a.y, b.x, b.y);
  }
}

DEVI void gdn_pre_tile(const Params& p, int chunk, char* smem) {
  const int tid = opaque_tid(), lane = tid & 63, wid = tid >> 6, fr = lane & 15, fq = lane >> 4;
  int n = chunk & 127, h = (chunk >> 7) & 3, b = chunk >> 9;
  size_t tok0 = (size_t)b * S_ + n * 64;
  bf16_t* qn = (bf16_t*)smem;
  bf16_t* kn = (bf16_t*)(smem + 17408);
  bf16_t* vs = (bf16_t*)(smem + 34816);
  float* L = (float*)(smem + 53248);
  float* sbeta = (float*)(smem + 69632);
  float* sgc = sbeta + 64; float* seg = sbeta + 128; float* sbe = sbeta + 192;
  const bf16_t* Y = (const bf16_t*)(gws(p) + OFF_Y);
  const float* ysm = (const float*)(gws(p) + OFF_SM);
  char* gbase = gws(p) + OFF_X + (size_t)chunk * GDN_CH_BYTES;
  if (tid < 64) {
    float gb = ysm[(tok0 + tid) * 32 + 8 + h], ga = ysm[(tok0 + tid) * 32 + 12 + h];
    float beta = sigmoidf_(gb);
    float g = -expf(gin(p, 7)[h]) * softplusf_(ga + gin(p, 8)[h]);
    float gc = g;
#pragma unroll
    for (int o = 1; o < 64; o <<= 1) { float t = __shfl_up(gc, o); if (lane >= o) gc += t; }
    float eg = expf(gc);
    sbeta[tid] = beta; sgc[tid] = gc; seg[tid] = eg; sbe[tid] = beta * eg;
    if (tid == 63) ((float*)(gws(p) + OFF_MISC + MS_EGL))[chunk] = eg;
  }
  {
    int dc = tid & 15, tg = tid >> 4, d0 = dc * 8;
#pragma unroll 1
    for (int mat = 0; mat < 3; mat++) {
      int col = 1536 + mat * 512 + h * 128 + d0;
      int cch = mat * 512 + h * 128 + d0;
      float w[4][8];
#pragma unroll
      for (int j = 0; j < 4; j++)
#pragma unroll
        for (int e = 0; e < 8; e++) w[j][e] = gin(p, 6)[j * 1536 + cch + e];
      uint4 xr[7];
#pragma unroll
      for (int i = 0; i < 7; i++) {
        int lt = tg * 4 - 3 + i;
        if (n * 64 + lt >= 0) xr[i] = *(const uint4*)(Y + (tok0 + lt) * YE_LD + col); else xr[i] = make_uint4(0, 0, 0, 0);
      }
#pragma unroll
      for (int tt = 0; tt < 4; tt++) {
        float x[8];
#pragma unroll
        for (int e = 0; e < 8; e++) x[e] = 0.f;
#pragma unroll
        for (int j = 0; j < 4; j++) {
          uint4 v = xr[tt + j];
          x[0] += w[j][0] * lo2f(v.x); x[1] += w[j][1] * hi2f(v.x); x[2] += w[j][2] * lo2f(v.y); x[3] += w[j][3] * hi2f(v.y);
          x[4] += w[j][4] * lo2f(v.z); x[5] += w[j][5] * hi2f(v.z); x[6] += w[j][6] * lo2f(v.w); x[7] += w[j][7] * hi2f(v.w);
        }
        float ss = 0.f;
#pragma unroll
        for (int e = 0; e < 8; e++) { x[e] = x[e] * sigmoidf_(x[e]); ss += x[e] * x[e]; }
        float sc = 1.f;
        if (mat < 2) {
          ss += __shfl_xor(ss, 1); ss += __shfl_xor(ss, 2); ss += __shfl_xor(ss, 4); ss += __shfl_xor(ss, 8);
          sc = rsqrtf(ss + 1e-6f) * (mat == 0 ? 0.08838834764831845f : 1.f);
        }
        bf16_t* dst = (mat == 0 ? qn : (mat == 1 ? kn : vs)) + (tg * 4 + tt) * 136 + d0;
        *(uint4*)dst = make_uint4(pack2(x[0] * sc, x[1] * sc), pack2(x[2] * sc, x[3] * sc), pack2(x[4] * sc, x[5] * sc), pack2(x[6] * sc, x[7] * sc));
      }
    }
  }
  __syncthreads();
  {
    bf16x8 ka[4], qa[4];
#pragma unroll
    for (int kk = 0; kk < 4; kk++) {
      ka[kk] = *(const bf16x8*)&kn[(wid * 16 + fr) * 136 + kk * 32 + fq * 8];
      qa[kk] = *(const bf16x8*)&qn[(wid * 16 + fr) * 136 + kk * 32 + fq * 8];
    }
#pragma unroll
    for (int ct = 0; ct < 4; ct++) {
      f32x4 aL = {0.f, 0.f, 0.f, 0.f}, aA = {0.f, 0.f, 0.f, 0.f};
#pragma unroll
      for (int kk = 0; kk < 4; kk++) {
        bf16x8 kb = *(const bf16x8*)&kn[(ct * 16 + fr) * 136 + kk * 32 + fq * 8];
        aL = mfma16(ka[kk], kb, aL);
        aA = mfma16(qa[kk], kb, aA);
      }
      int j = ct * 16 + fr;
      float gj = sgc[j];
#pragma unroll
      for (int r = 0; r < 4; r++) {
        int i = wid * 16 + fq * 4 + r;
        float dec = (i >= j) ? expf(sgc[i] - gj) : 0.f;
        L[i * 64 + j] = (i > j) ? sbeta[i] * aL[r] * dec : 0.f;
        float av = aA[r] * dec;
        int kk2 = j >> 5, within = j & 31, tt = within >> 4, qd = (within & 15) >> 2, jj = within & 3;
        int ln = qd * 16 + (i & 15);
        *(bf16_t*)(gbase + 49152 + ((size_t)((wid * 2 + kk2) * 64 + ln)) * 16 + (tt * 4 + jj) * 2) = f2bf(av);
      }
    }
  }
  __syncthreads();
  float x[64];
  {
    const int c = tid;
    const bf16_t* rsrc = (c < 128) ? (vs + c) : (kn + (c - 128));
    const float* rsc = (c < 128) ? sbeta : sbe;
#pragma unroll
    for (int i = 0; i < 64; i++) {
      float r = bf2f(rsrc[i * 136]) * rsc[i];
#pragma unroll
      for (int j4 = 0; j4 < (i + 3) / 4; j4++) {
        float4 lv = *(const float4*)&L[i * 64 + j4 * 4];
        if (j4 * 4 + 0 < i) r -= lv.x * x[j4 * 4 + 0];
        if (j4 * 4 + 1 < i) r -= lv.y * x[j4 * 4 + 1];
        if (j4 * 4 + 2 < i) r -= lv.z * x[j4 * 4 + 2];
        if (j4 * 4 + 3 < i) r -= lv.w * x[j4 * 4 + 3];
      }
      x[i] = r;
    }
  }
  __syncthreads();
  if (tid >= 128) {
#pragma unroll
    for (int i = 0; i < 64; i++) vs[i * 136 + (tid - 128)] = f2bf(x[i]);
  }
  __syncthreads();
  emit_afrag(vs, 136, 4, 4, gbase);
  __syncthreads();
  if (tid < 128) {
#pragma unroll
    for (int i = 0; i < 64; i++) vs[i * 136 + tid] = f2bf(x[i]);
  }
  __syncthreads();
  for (int c = tid; c < 2048; c += 256) {
    int ln = c & 63, rt = (c >> 6) & 3, ds = c >> 8;
    int row = rt * 16 + (ln >> 4) * 4, col = ds * 16 + (ln & 15);
    unsigned a = (unsigned)vs[row * 136 + col] | ((unsigned)vs[(row + 1) * 136 + col] << 16);
    unsigned bq = (unsigned)vs[(row + 2) * 136 + col] | ((unsigned)vs[(row + 3) * 136 + col] << 16);
    *(uint2*)(gbase + 57344 + (size_t)c * 8) = make_uint2(a, bq);
  }
  __syncthreads();
  for (int e = tid; e < 64 * 128; e += 256) { int i = e >> 7, d = e & 127; vs[i * 136 + d] = f2bf(bf2f(qn[i * 136 + d]) * seg[i]); }
  __syncthreads();
  emit_afrag(vs, 136, 4, 4, gbase + 16384);
  __syncthreads();
  {
    float gl = sgc[63];
    for (int e = tid; e < 64 * 128; e += 256) { int j = e >> 7, d = e & 127; vs[d * 72 + j] = f2bf(bf2f(kn[j * 136 + d]) * expf(gl - sgc[j])); }
  }
  __syncthreads();
  emit_afrag(vs, 72, 8, 2, gbase + 32768);
  __syncthreads();
}

DEVI void gdn_scan_item(const Params& p, int item, char* smem) {
  const int tid = opaque_tid(), lane = tid & 63, wid = tid >> 6, fr = lane & 15, fq = lane >> 4;
  int bh = item >> 1, half = item & 1, ds = half * 4 + wid, b = bh >> 2, h = bh & 3;
  const float* eglp = (const float*)(gws(p) + OFF_MISC + MS_EGL) + bh * 128;
  bf16_t* Yo = (bf16_t*)(gws(p) + OFF_Y) + (size_t)b * S_ * YE_LD + 1536 + h * 128 + ds * 16 + fr;
  char* bufA = smem;
  char* bufB = smem + 32768;
  const char* gbase = gws(p) + OFF_X + (size_t)(bh * 128) * GDN_CH_BYTES;
  uint4 ra0, ra1, ra2, ra3, ra4, ra5, ra6, ra7, rb0, rb1, rb2, rb3, rb4, rb5, rb6, rb7;
#define SCAN_GLOAD(n) do { const char* cb = gbase + (size_t)(n) * GDN_CH_BYTES; \
    ra0 = GLD16(cb + (size_t)(tid + 0) * 16); \
    ra1 = GLD16(cb + (size_t)(tid + 256) * 16); \
    ra2 = GLD16(cb + (size_t)(tid + 512) * 16); \
    ra3 = GLD16(cb + (size_t)(tid + 768) * 16); \
    ra4 = GLD16(cb + (size_t)(tid + 1024) * 16); \
    ra5 = GLD16(cb + (size_t)(tid + 1280) * 16); \
    ra6 = GLD16(cb + (size_t)(tid + 1536) * 16); \
    ra7 = GLD16(cb + (size_t)(tid + 1792) * 16); \
    rb0 = GLD16(cb + 32768 + (size_t)(tid + 0) * 16); \
    rb1 = GLD16(cb + 32768 + (size_t)(tid + 256) * 16); \
    rb2 = GLD16(cb + 32768 + (size_t)(tid + 512) * 16); \
    rb3 = GLD16(cb + 32768 + (size_t)(tid + 768) * 16); \
    rb4 = GLD16(cb + 32768 + (size_t)(tid + 1024) * 16); \
    rb5 = GLD16(cb + 32768 + (size_t)(tid + 1280) * 16); \
    rb6 = GLD16(cb + 57344 + half * 8192 + (size_t)(tid + 0) * 16); \
    rb7 = GLD16(cb + 57344 + half * 8192 + (size_t)(tid + 256) * 16); \
  } while (0)
#define SCAN_SSTORE() do { \
    *(uint4*)(bufA + (tid + 0) * 16) = ra0; *(uint4*)(bufB + (tid + 0) * 16) = rb0; \
    *(uint4*)(bufA + (tid + 256) * 16) = ra1; *(uint4*)(bufB + (tid + 256) * 16) = rb1; \
    *(uint4*)(bufA + (tid + 512) * 16) = ra2; *(uint4*)(bufB + (tid + 512) * 16) = rb2; \
    *(uint4*)(bufA + (tid + 768) * 16) = ra3; *(uint4*)(bufB + (tid + 768) * 16) = rb3; \
    *(uint4*)(bufA + (tid + 1024) * 16) = ra4; *(uint4*)(bufB + (tid + 1024) * 16) = rb4; \
    *(uint4*)(bufA + (tid + 1280) * 16) = ra5; *(uint4*)(bufB + (tid + 1280) * 16) = rb5; \
    *(uint4*)(bufA + (tid + 1536) * 16) = ra6; *(uint4*)(bufB + (tid + 1536) * 16) = rb6; \
    *(uint4*)(bufA + (tid + 1792) * 16) = ra7; *(uint4*)(bufB + (tid + 1792) * 16) = rb7; \
  } while (0)
  SCAN_GLOAD(0);
  SCAN_SSTORE();
  __syncthreads();
  f32x4 S[8];
#pragma unroll
  for (int i = 0; i < 8; i++) S[i] = f32x4{0.f, 0.f, 0.f, 0.f};
#pragma unroll 1
  for (int n = 0; n < 128; n++) {
    if (n + 1 < 128) SCAN_GLOAD(n + 1);
    float egl = eglp[n];
    bf16x8 sb[4];
#pragma unroll
    for (int kk = 0; kk < 4; kk++)
      sb[kk] = mk8(pack2(S[2 * kk][0], S[2 * kk][1]), pack2(S[2 * kk][2], S[2 * kk][3]), pack2(S[2 * kk + 1][0], S[2 * kk + 1][1]), pack2(S[2 * kk + 1][2], S[2 * kk + 1][3]));
    f32x4 vn[4], oo[4];
#pragma unroll
    for (int rt = 0; rt < 4; rt++) {
      f32x4 acc = {0.f, 0.f, 0.f, 0.f};
#pragma unroll
      for (int kk = 0; kk < 4; kk++) acc = mfma16(*(const bf16x8*)(bufA + ((rt * 4 + kk) * 64 + lane) * 16), sb[kk], acc);
      uint2 uu = *(const uint2*)(bufB + 24576 + ((wid * 4 + rt) * 64 + lane) * 8);
      vn[rt] = f32x4{lo2f(uu.x) - acc[0], hi2f(uu.x) - acc[1], lo2f(uu.y) - acc[2], hi2f(uu.y) - acc[3]};
    }
#pragma unroll
    for (int rt = 0; rt < 4; rt++) {
      f32x4 acc = {0.f, 0.f, 0.f, 0.f};
#pragma unroll
      for (int kk = 0; kk < 4; kk++) acc = mfma16(*(const bf16x8*)(bufA + 16384 + ((rt * 4 + kk) * 64 + lane) * 16), sb[kk], acc);
      oo[rt] = acc;
    }
    bf16x8 vb[2];
#pragma unroll
    for (int k2 = 0; k2 < 2; k2++)
      vb[k2] = mk8(pack2(vn[2 * k2][0], vn[2 * k2][1]), pack2(vn[2 * k2][2], vn[2 * k2][3]), pack2(vn[2 * k2 + 1][0], vn[2 * k2 + 1][1]), pack2(vn[2 * k2 + 1][2], vn[2 * k2 + 1][3]));
#pragma unroll
    for (int rt = 0; rt < 4; rt++)
#pragma unroll
      for (int k2 = 0; k2 < 2; k2++) oo[rt] = mfma16(*(const bf16x8*)(bufB + 16384 + ((rt * 2 + k2) * 64 + lane) * 16), vb[k2], oo[rt]);
#pragma unroll
    for (int dk = 0; dk < 8; dk++) {
      f32x4 acc = S[dk] * egl;
#pragma unroll
      for (int k2 = 0; k2 < 2; k2++) acc = mfma16(*(const bf16x8*)(bufB + ((dk * 2 + k2) * 64 + lane) * 16), vb[k2], acc);
      S[dk] = acc;
    }
#pragma unroll
    for (int rt = 0; rt < 4; rt++)
#pragma unroll
      for (int r = 0; r < 4; r++) Yo[(size_t)(n * 64 + rt * 16 + fq * 4 + r) * YE_LD] = f2bf(oo[rt][r]);
    __syncthreads();
    if (n + 1 < 128) SCAN_SSTORE();
    __syncthreads();
  }
#undef SCAN_GLOAD
#undef SCAN_SSTORE
}

DEVI void phase_gdn_post(const Params& p) {
  int lane = opaque_tid() & 63;
  int gw = blockIdx.x * 4 + (opaque_tid() >> 6), nw = gridDim.x * 4;
  const bf16_t* Y = (const bf16_t*)(gws(p) + OFF_Y);
  bf16_t* mix = (bf16_t*)(gws(p) + OFF_MIX);
  int c0 = lane * 8;
  float nwv[8];
#pragma unroll
  for (int e = 0; e < 8; e++) nwv[e] = gin(p, 9)[(c0 & 127) + e];
  for (int row = gw; row < M_; row += nw) {
    uint4 ov = *(const uint4*)(Y + (size_t)row * YE_LD + 1536 + c0);
    uint4 zv = *(const uint4*)(Y + (size_t)row * YE_LD + 3072 + c0);
    float o[8] = {lo2f(ov.x), hi2f(ov.x), lo2f(ov.y), hi2f(ov.y), lo2f(ov.z), hi2f(ov.z), lo2f(ov.w), hi2f(ov.w)};
    float z[8] = {lo2f(zv.x), hi2f(zv.x), lo2f(zv.y), hi2f(zv.y), lo2f(zv.z), hi2f(zv.z), lo2f(zv.w), hi2f(zv.w)};
    float ss = 0.f;
#pragma unroll
    for (int e = 0; e < 8; e++) ss += o[e] * o[e];
    ss += __shfl_xor(ss, 1); ss += __shfl_xor(ss, 2); ss += __shfl_xor(ss, 4); ss += __shfl_xor(ss, 8);
    float rs = rsqrtf(ss * (1.f / 128.f) + 1e-6f);
    float r[8];
#pragma unroll
    for (int e = 0; e < 8; e++) r[e] = o[e] * rs * nwv[e] * (z[e] * sigmoidf_(z[e]));
    *(uint4*)(mix + (size_t)row * 1024 + 512 + c0) = make_uint4(pack2(r[0], r[1]), pack2(r[2], r[3]), pack2(r[4], r[5]), pack2(r[6], r[7]));
  }
}

struct ALoadCmp {
  const bf16_t* Y; const float* pe; int mt; int col0; int lr, lc;
  DEVI void init(int lr_, int lc_) { lr = lr_; lc = lc_; }
  DEVI uint4 load(int i, int kin) const {
    int row = lr + i * 32, k = kin + lc;
    int R = mt * 128 + row; if (R > 8175) R = 8175;
    int bn = R >> 1, g = R & 1, b = bn / 511, n = bn - b * 511;
    int l = k >> 6, d = k & 63;
    uint4 v = *(const uint4*)(Y + ((size_t)b * S_ + 16 * n + l) * YO_LD + col0 + g * 64 + d);
    const float4* pp = (const float4*)(pe + l * 64 + d);
    float4 p0 = pp[0], p1 = pp[1];
    return make_uint4(pack2(lo2f(v.x) + p0.x, hi2f(v.x) + p0.y), pack2(lo2f(v.y) + p0.z, hi2f(v.y) + p0.w),
                      pack2(lo2f(v.z) + p1.x, hi2f(v.z) + p1.y), pack2(lo2f(v.w) + p1.z, hi2f(v.w) + p1.w));
  }
};
DEVI void cmp_tile(const Params& p, int tile, char* smem) {
  const int tid = opaque_tid(), lane = tid & 63, wid = tid >> 6, wr = wid >> 1, wc = wid & 1, fr = lane & 15, fq = lane >> 4;
  int kv = tile >> 6, mt = tile & 63;
  const bf16_t* WT = (const bf16_t*)(gws(p) + OFF_WT);
  ALoadCmp al{(const bf16_t*)(gws(p) + OFF_Y), gin(p, kv ? 16 : 13), mt, kv ? 640 : 512, 0, 0};
  f32x4 acc[4][4]; zero_acc(acc);
  gemm_mainloop<false>(al, WT + (kv ? WT_CV1 : WT_CK1), 2048, 2048, smem, acc);
  bf16_t* hid = (bf16_t*)smem;
  bf16_t* w2 = (bf16_t*)(smem + 34816);
#pragma unroll
  for (int i = 0; i < 4; i++)
#pragma unroll
    for (int j = 0; j < 4; j++)
#pragma unroll
      for (int r = 0; r < 4; r++) hid[(wr * 64 + i * 16 + fq * 4 + r) * 136 + wc * 64 + j * 16 + fr] = f2bf(gelu_tanh(acc[i][j][r]));
  const bf16_t* w2g = WT + (kv ? WT_CV2 : WT_CK2);
  for (int c = tid; c < 1024; c += 256) { int row = c >> 4, ch = (c & 15) * 8; *(uint4*)&w2[row * 136 + ch] = *(const uint4*)(w2g + row * 128 + ch); }
  __syncthreads();
  f32x4 a2[2][4];
#pragma unroll
  for (int i = 0; i < 2; i++)
#pragma unroll
    for (int j = 0; j < 4; j++) a2[i][j] = f32x4{0.f, 0.f, 0.f, 0.f};
#pragma unroll
  for (int kk = 0; kk < 4; kk++) {
    bf16x8 af[2], bfv[4];
#pragma unroll
    for (int i = 0; i < 2; i++) af[i] = *(const bf16x8*)&hid[(wid * 32 + i * 16 + fr) * 136 + kk * 32 + fq * 8];
#pragma unroll
    for (int j = 0; j < 4; j++) bfv[j] = *(const bf16x8*)&w2[(j * 16 + fr) * 136 + kk * 32 + fq * 8];
#pragma unroll
    for (int i = 0; i < 2; i++)
#pragma unroll
      for (int j = 0; j < 4; j++) a2[i][j] = mfma16(af[i], bfv[j], a2[i][j]);
  }
  bf16_t* kc = (bf16_t*)(gws(p) + OFF_MISC + MS_KCMP);
  bf16_t* vc = (bf16_t*)(gws(p) + OFF_MISC + MS_VCMPT);
#pragma unroll
  for (int i = 0; i < 2; i++)
#pragma unroll
    for (int r = 0; r < 4; r++) {
      int R = mt * 128 + wid * 32 + i * 16 + fq * 4 + r;
      if (R < 8176) {
        int bn = R >> 1, g = R & 1, b = bn / 511, n = bn - b * 511;
#pragma unroll
        for (int j = 0; j < 4; j++) {
          int d = j * 16 + fr;
          if (kv == 0) kc[(((size_t)b * 512 + n) * 2 + g) * 64 + d] = f2bf(a2[i][j][r]);
          else vc[(((size_t)b * 2 + g) * 64 + d) * 512 + n] = f2bf(a2[i][j][r]);
        }
      }
    }
  __syncthreads();
}

template <bool OUT>
DEVI void rglru_tile(const Params& p, int tile, char* smem) {
  const int tid = opaque_tid(), lane = tid & 63, wid = tid >> 6, fr = lane & 15, fq = lane >> 4;
  int nb = tile & 7, seg = (tile >> 3) & 127, b = tile >> 10;
  size_t tok0 = (size_t)b * S_ + seg * 64;
  float* xs = (float*)smem;
  bf16_t* xb = (bf16_t*)(smem + 16640);
  float* as = (float*)(smem + 25856);
  float* bs = (float*)(smem + 42496);
  const bf16_t* Y = (const bf16_t*)(gws(p) + OFF_Y);
  float* agg = (float*)(gws(p) + OFF_MISC + MS_RGAGG);
  {
    int t = tid >> 2, c0 = (tid & 3) * 16, ch = nb * 64 + c0;
    float x[16];
#pragma unroll
    for (int e = 0; e < 16; e++) x[e] = gin(p, 20)[ch + e];
#pragma unroll
    for (int j = 0; j < 4; j++) {
      int lt = t - 3 + j;
      if (seg * 64 + lt >= 0) {
        const uint4* src = (const uint4*)(Y + (tok0 + lt) * YO_LD + 1792 + ch);
        uint4 v0 = src[0], v1 = src[1];
        const float* w = gin(p, 19) + j * 512 + ch;
        x[0] += w[0] * lo2f(v0.x); x[1] += w[1] * hi2f(v0.x); x[2] += w[2] * lo2f(v0.y); x[3] += w[3] * hi2f(v0.y);
        x[4] += w[4] * lo2f(v0.z); x[5] += w[5] * hi2f(v0.z); x[6] += w[6] * lo2f(v0.w); x[7] += w[7] * hi2f(v0.w);
        x[8] += w[8] * lo2f(v1.x); x[9] += w[9] * hi2f(v1.x); x[10] += w[10] * lo2f(v1.y); x[11] += w[11] * hi2f(v1.y);
        x[12] += w[12] * lo2f(v1.z); x[13] += w[13] * hi2f(v1.z); x[14] += w[14] * lo2f(v1.w); x[15] += w[15] * hi2f(v1.w);
      }
    }
#pragma unroll
    for (int e = 0; e < 16; e++) { xs[t * 65 + c0 + e] = x[e]; xb[t * 72 + c0 + e] = f2bf(x[e]); }
  }
  __syncthreads();
  {
    const bf16_t* WT = (const bf16_t*)(gws(p) + OFF_WT);
    const bf16_t* wa = WT + WT_RGA + nb * 4096;
    const bf16_t* wx = WT + WT_RGX + nb * 4096;
    bf16x8 af[2];
#pragma unroll
    for (int kk = 0; kk < 2; kk++) af[kk] = *(const bf16x8*)&xb[(wid * 16 + fr) * 72 + kk * 32 + fq * 8];
#pragma unroll
    for (int j = 0; j < 4; j++) {
      f32x4 aA = {0.f, 0.f, 0.f, 0.f}, aX = {0.f, 0.f, 0.f, 0.f};
#pragma unroll
      for (int kk = 0; kk < 2; kk++) {
        aA = mfma16(af[kk], *(const bf16x8*)(wa + (j * 16 + fr) * 64 + kk * 32 + fq * 8), aA);
        aX = mfma16(af[kk], *(const bf16x8*)(wx + (j * 16 + fr) * 64 + kk * 32 + fq * 8), aX);
      }
      int c = j * 16 + fr, chn = nb * 64 + c;
      float ba = gin(p, 22)[chn], bx = gin(p, 24)[chn];
      float spl = softplusf_(-gin(p, 25)[chn]);
#pragma unroll
      for (int r = 0; r < 4; r++) {
        int t = wid * 16 + fq * 4 + r;
        float rr = sigmoidf_(aA[r] + ba), ig = sigmoidf_(aX[r] + bx);
        float la = -8.f * spl * rr;
        as[t * 65 + c] = expf(la);
        bs[t * 65 + c] = sqrtf(-expm1f(2.f * la)) * ig * xs[t * 65 + c];
      }
    }
  }
  __syncthreads();
  if (!OUT) {
    {
      int c = tid & 63, part = tid >> 6;
      float A = 1.f, Bv = 0.f;
#pragma unroll
      for (int t = 0; t < 16; t++) { float a = as[(part * 16 + t) * 65 + c]; Bv = a * Bv + bs[(part * 16 + t) * 65 + c]; A *= a; }
      float2* cw2 = (float2*)(smem + 61184);
      cw2[part * 64 + c] = make_float2(A, Bv);
      __syncthreads();
      if (tid < 64) {
        float At = 1.f, Bt = 0.f;
#pragma unroll
        for (int pp = 0; pp < 4; pp++) { float2 ab = cw2[pp * 64 + tid]; Bt = ab.x * Bt + ab.y; At *= ab.x; }
        float2* dst = (float2*)agg + ((size_t)(b * 128 + seg) * 512 + nb * 64 + tid);
        *dst = make_float2(At, Bt);
      }
    }
  } else {
    {
      int c = tid & 63, part = tid >> 6;
      int per = (seg + 3) >> 2, s_lo = part * per, s_hi = min(seg, s_lo + per);
      const float2* src = (const float2*)agg + ((size_t)(b * 128) * 512 + nb * 64 + c);
      float A = 1.f, Bv = 0.f;
#pragma unroll 8
      for (int s2 = s_lo; s2 < s_hi; s2++) { float2 ab = src[(size_t)s2 * 512]; Bv = ab.x * Bv + ab.y; A *= ab.x; }
      float2* cw = (float2*)(smem + 59136);
      cw[part * 64 + c] = make_float2(A, Bv);
    }
    __syncthreads();
    {
      int c = tid & 63, part = tid >> 6;
      float A = 1.f, Bv = 0.f;
#pragma unroll
      for (int t = 0; t < 16; t++) { float a = as[(part * 16 + t) * 65 + c]; Bv = a * Bv + bs[(part * 16 + t) * 65 + c]; A *= a; }
      float2* cw2 = (float2*)(smem + 61184);
      cw2[part * 64 + c] = make_float2(A, Bv);
      __syncthreads();
      const float2* cw = (const float2*)(smem + 59136);
      float hh = 0.f;
#pragma unroll
      for (int pp = 0; pp < 4; pp++) { float2 ab = cw[pp * 64 + c]; hh = ab.x * hh + ab.y; }
      for (int pp = 0; pp < part; pp++) { float2 ab = cw2[pp * 64 + c]; hh = ab.x * hh + ab.y; }
#pragma unroll
      for (int t = 0; t < 16; t++) { int ti = (part * 16 + t) * 65 + c; hh = as[ti] * hh + bs[ti]; bs[ti] = hh; }
    }
    __syncthreads();
    int t = tid >> 2, c0 = (tid & 3) * 16, ch = nb * 64 + c0;
    const uint4* gsrc = (const uint4*)(Y + (tok0 + t) * YO_LD + 1280 + ch);
    uint4 g0 = gsrc[0], g1 = gsrc[1];
    float gv[16] = {lo2f(g0.x), hi2f(g0.x), lo2f(g0.y), hi2f(g0.y), lo2f(g0.z), hi2f(g0.z), lo2f(g0.w), hi2f(g0.w),
                    lo2f(g1.x), hi2f(g1.x), lo2f(g1.y), hi2f(g1.y), lo2f(g1.z), hi2f(g1.z), lo2f(g1.w), hi2f(g1.w)};
    float yv[16];
#pragma unroll
    for (int e = 0; e < 16; e++) yv[e] = bs[t * 65 + c0 + e] * gelu_tanh(gv[e]);
    uint4* dst = (uint4*)((bf16_t*)(gws(p) + OFF_MIX) + (tok0 + t) * 1024 + 512 + ch);
    dst[0] = make_uint4(pack2(yv[0], yv[1]), pack2(yv[2], yv[3]), pack2(yv[4], yv[5]), pack2(yv[6], yv[7]));
    dst[1] = make_uint4(pack2(yv[8], yv[9]), pack2(yv[10], yv[11]), pack2(yv[12], yv[13]), pack2(yv[14], yv[15]));
  }
  __syncthreads();
}

template <int BR>
struct NsaPol {
  static constexpr bool UB = true;
  int t; int tmin; int kb; const u64* selq; const u64* worq; float sc; bool selbit;
  DEVI float lane_bias() const { return (BR == 1 && !selbit) ? NEGF : 0.f; }
  DEVI bool active(int kb_) const {
    if (BR == 1) return (worq[kb_ >> 6] >> (kb_ & 63)) & 1;
    return true;
  }
  DEVI bool masked(int kb_) const {
    if (BR == 2) return !((kb_ * 64 + 63 <= tmin) && (tmin + 15 - kb_ * 64 < 512));
    if (BR == 1) return kb_ * 64 + 63 > tmin;
    return true;
  }
  DEVI void begin(int kb_, const float*) {
    kb = kb_;
    if (BR == 1) selbit = (selq[kb_ >> 6] >> (kb_ & 63)) & 1;
  }
  DEVI bool ok(int qt, int kl) const {
    int key = kb * 64 + kl;
    if (BR == 0) return (16 * key + 31 <= t) && (key < 511);
    if (BR == 1) return selbit && (key <= t);
    return (key <= t) && (t - key < 512);
  }
  DEVI f32x4 bias4(int) const { return f32x4{0.f, 0.f, 0.f, 0.f}; }
};

DEVI void nsa_tile(const Params& p, int item, char* smem) {
  const int tid = opaque_tid(), lane = tid & 63, wid = tid >> 6, fr = lane & 15, fq = lane >> 4;
  const int qg = wid >> 1, hp = wid & 1;
  int qb = 255 - (item >> 4), bg = item & 15, b = bg >> 1, g = bg & 1;
  int q0 = qb * 32, cur = q0 >> 6;
  int t = q0 + qg * 16 + fr;
  size_t mrow = (size_t)b * S_ + t;
  const bf16_t* Y = (const bf16_t*)(gws(p) + OFF_Y) + (size_t)b * S_ * YO_LD;
  const float* ysm = (const float*)(gws(p) + OFF_SM) + mrow * 32;
  float* impw = (float*)(smem + SM_IMP) + wid * (16 * 132);
  float* otot = impw;
  u64* selm = (u64*)(smem + SM_SELM) + qg * 32;
  u64* bor = (u64*)(smem + SM_BOR);
  bf16x8 qf[2][2];
#pragma unroll
  for (int qt = 0; qt < 2; qt++)
#pragma unroll
    for (int kk = 0; kk < 2; kk++) qf[qt][kk] = *(const bf16x8*)(Y + (size_t)t * YO_LD + (g * 4 + hp * 2 + qt) * 64 + kk * 32 + fq * 8);
  for (int i = lane; i < 16 * 132; i += 64) impw[i] = 0.f;
  f32x4 o[4][2];
  float m[2], l[2];
  const float sc = 0.125f * LOG2E;
  {
    int nkv = (q0 / 16) / 64 + 1; if (nkv > 8) nkv = 8;
    u64 mlo = (1ull << nkv) - 1;
    const bf16_t* Kg = (const bf16_t*)(gws(p) + OFF_MISC + MS_KCMP) + (size_t)b * 512 * 128 + g * 64;
    const bf16_t* Vt = (const bf16_t*)(gws(p) + OFF_MISC + MS_VCMPT) + ((size_t)b * 2 + g) * 64 * 512;
    NsaPol<0> pol; pol.t = t; pol.tmin = q0 + qg * 16; pol.kb = 0; pol.sc = sc; pol.selq = nullptr; pol.worq = nullptr; pol.selbit = false;
#pragma unroll
    for (int qt = 0; qt < 2; qt++) { m[qt] = NEGF; l[qt] = 0.f; }
    zero_o<2>(o);
    attn_core<1, 2>(pol, smem, qf, Kg, 128, Vt, 512, nullptr, mlo, 0ull, o, m, l, nullptr);
#pragma unroll
    for (int qt = 0; qt < 2; qt++) { float lt = l[qt]; lt += __shfl_xor(lt, 16); lt += __shfl_xor(lt, 32); l[qt] = lt > 0.f ? 1.f / lt : 0.f; }
    attn_core<2, 2>(pol, smem, qf, Kg, 128, Vt, 512, nullptr, mlo, 0ull, o, m, l, impw);
  }
  __syncthreads();
  {
    const float* ia = (const float*)(smem + SM_IMP) + (qg * 2) * (16 * 132);
    const float* ib = ia + 16 * 132;
#pragma unroll 1
    for (int qq = 0; qq < 8; qq++) {
      int q = hp * 8 + qq;
      const float* iva = ia + q * 132; const float* ivb = ib + q * 132;
      float v0 = iva[lane] + ivb[lane], v1 = iva[lane + 64] + ivb[lane + 64];
      int c0 = 0, c1 = 0;
      if (cur >= 16) {
        for (int mm = 1; mm <= cur - 2; mm++) {
          float x = iva[mm] + ivb[mm];
          c0 += (x > v0) || (x == v0 && mm < lane);
          c1 += (x > v1) || (x == v1 && mm < lane + 64);
        }
      }
      int m0 = lane, m1 = lane + 64;
      bool s0, s1;
      if (cur < 16) { s0 = m0 <= cur; s1 = false; }
      else {
        s0 = (m0 == 0) || (m0 == cur) || (m0 == cur - 1) || (m0 >= 1 && m0 <= cur - 2 && 3 + c0 < 16);
        s1 = (m1 == cur) || (m1 == cur - 1) || (m1 <= cur - 2 && 3 + c1 < 16);
      }
      u64 lo = __ballot(s0), hi = __ballot(s1);
      if (lane == 0) { selm[q * 2] = lo; selm[q * 2 + 1] = hi; }
    }
  }
  __syncthreads();
  {
    u64 wlo = selm[fr * 2], whi = selm[fr * 2 + 1];
#pragma unroll
    for (int off = 1; off < 16; off <<= 1) { wlo |= __shfl_xor(wlo, off); whi |= __shfl_xor(whi, off); }
    if (lane == 0) { bor[wid * 2] = wlo; bor[wid * 2 + 1] = whi; }
  }
#pragma unroll
  for (int dt = 0; dt < 4; dt++)
#pragma unroll
    for (int qt = 0; qt < 2; qt++) {
      f32x4 v = o[dt][qt]; float gg = sigmoidf_(ysm[(g * 4 + hp * 2 + qt) * 3 + 0]);
      otot[((dt * 2 + qt) * 2 + 0) * 64 + lane] = __uint_as_float(pack2(v[0] * gg, v[1] * gg));
      otot[((dt * 2 + qt) * 2 + 1) * 64 + lane] = __uint_as_float(pack2(v[2] * gg, v[3] * gg));
    }
  __syncthreads();
  u64 blo = bor[0] | bor[2] | bor[4] | bor[6], bhi = bor[1] | bor[3] | bor[5] | bor[7];
  {
    u64 clo = cur >= 63 ? ~0ull : ((1ull << (cur + 1)) - 1);
    u64 chi = cur < 64 ? 0ull : (cur >= 127 ? ~0ull : ((1ull << (cur - 63)) - 1));
    blo &= clo; bhi &= chi;
  }
  {
    NsaPol<1> pol; pol.t = t; pol.tmin = q0 + qg * 16; pol.kb = 0; pol.sc = sc; pol.selq = selm + fr * 2; pol.worq = bor + wid * 2; pol.selbit = false;
#pragma unroll
    for (int qt = 0; qt < 2; qt++) { m[qt] = NEGF; l[qt] = 0.f; }
    zero_o<2>(o);
    const bf16_t* Vt = (const bf16_t*)(gws(p) + OFF_Y + 288 * MiB) + ((size_t)b * 128 + g * 64) * S_;
    attn_core<0, 2>(pol, smem, qf, Y + 768 + g * 64, YO_LD, Vt, S_, nullptr, blo, bhi, o, m, l, nullptr);
#pragma unroll
    for (int qt = 0; qt < 2; qt++) {
      float lt = l[qt]; lt += __shfl_xor(lt, 16); lt += __shfl_xor(lt, 32);
      float sc2 = sigmoidf_(ysm[(g * 4 + hp * 2 + qt) * 3 + 1]) / lt;
#pragma unroll
      for (int dt = 0; dt < 4; dt++) {
        f32x4 v = o[dt][qt];
        unsigned a = __float_as_uint(otot[((dt * 2 + qt) * 2 + 0) * 64 + lane]), bq = __float_as_uint(otot[((dt * 2 + qt) * 2 + 1) * 64 + lane]);
        otot[((dt * 2 + qt) * 2 + 0) * 64 + lane] = __uint_as_float(pack2(lo2f(a) + v[0] * sc2, hi2f(a) + v[1] * sc2));
        otot[((dt * 2 + qt) * 2 + 1) * 64 + lane] = __uint_as_float(pack2(lo2f(bq) + v[2] * sc2, hi2f(bq) + v[3] * sc2));
      }
    }
  }
  {
    NsaPol<2> pol; pol.t = t; pol.tmin = q0 + qg * 16; pol.kb = 0; pol.sc = sc; pol.selq = nullptr; pol.worq = nullptr; pol.selbit = false;
#pragma unroll
    for (int qt = 0; qt < 2; qt++) { m[qt] = NEGF; l[qt] = 0.f; }
    zero_o<2>(o);
    int k0 = (q0 - 511) < 0 ? 0 : ((q0 - 511) >> 6);
    u64 wl = 0, wh = 0;
    for (int k = k0; k <= cur; k++) { if (k < 64) wl |= 1ull << k; else wh |= 1ull << (k - 64); }
    const bf16_t* Vt = (const bf16_t*)(gws(p) + OFF_Y + 304 * MiB) + ((size_t)b * 128 + g * 64) * S_;
    attn_core<0, 2>(pol, smem, qf, Y + 1024 + g * 64, YO_LD, Vt, S_, nullptr, wl, wh, o, m, l, nullptr);
    bf16_t* mix = (bf16_t*)(gws(p) + OFF_MIX) + mrow * 1024;
#pragma unroll
    for (int qt = 0; qt < 2; qt++) {
      float lt = l[qt]; lt += __shfl_xor(lt, 16); lt += __shfl_xor(lt, 32);
      float sc2 = sigmoidf_(ysm[(g * 4 + hp * 2 + qt) * 3 + 2]) / lt;
#pragma unroll
      for (int dt = 0; dt < 4; dt++) {
        f32x4 v = o[dt][qt];
        unsigned a = __float_as_uint(otot[((dt * 2 + qt) * 2 + 0) * 64 + lane]), bq = __float_as_uint(otot[((dt * 2 + qt) * 2 + 1) * 64 + lane]);
        *(uint2*)(mix + (g * 4 + hp * 2 + qt) * 64 + dt * 16 + fq * 4) =
            make_uint2(pack2(lo2f(a) + v[0] * sc2, hi2f(a) + v[1] * sc2), pack2(lo2f(bq) + v[2] * sc2, hi2f(bq) + v[3] * sc2));
      }
    }
  }
  __syncthreads();
}

DEVI int next_item(int* ctr, char* smem) {
  int* slot = (int*)(smem + SM_SLOT);
  __syncthreads();
  if (opaque_tid() == 0) *slot = atomicAdd(ctr, 1);
  __syncthreads();
  return *slot;
}

constexpr int NPHASE = 17;
DEVI void grid_bar(unsigned* ctr, unsigned target) {
  __syncthreads();
  if (threadIdx.x == 0) {
    __threadfence();
    __hip_atomic_fetch_add(ctr, 1u, __ATOMIC_RELAXED, __HIP_MEMORY_SCOPE_AGENT);
    while (__hip_atomic_load(ctr, __ATOMIC_RELAXED, __HIP_MEMORY_SCOPE_AGENT) < target) __builtin_amdgcn_s_sleep(8);
    __threadfence();
  }
  __syncthreads();
}
__global__ void __launch_bounds__(256, 2) mega(Params p, int ph0, int ph1) {
  extern __shared__ __attribute__((aligned(16))) char smem[];
  cg::grid_group grid = cg::this_grid();
  char* ws0 = p.ws;
#define PH(n, ...) if ((n) >= ph0 && (n) <= ph1) { \
    char* ws = ws0; asm volatile("" : "+s"(ws)); ws = as_global(ws); \
    const bf16_t* WT = (const bf16_t*)(ws + OFF_WT); bf16_t* hn = (bf16_t*)(ws + OFF_HN); bf16_t* Yb = (bf16_t*)(ws + OFF_Y); \
    bf16_t* mix = (bf16_t*)(ws + OFF_MIX); bf16_t* pbf = (bf16_t*)(ws + OFF_X); bf16_t* ppb = (bf16_t*)(ws + OFF_X + 32 * MiB); (void)ppb; int* ctr = (int*)(ws + OFF_MISC + MS_CTR); \
    Params* gp = (Params*)(ws + OFF_MISC + MS_PTAB); float* h = as_global(gp->out); \
    float* ss = (float*)(ws + OFF_MISC + MS_SS); bf16_t* hn2 = (bf16_t*)(ws + OFF_MIX); (void)ss; (void)hn2; (void)WT; (void)hn; (void)Yb; (void)mix; (void)pbf; (void)ctr; (void)h; \
    __VA_ARGS__ } if ((n) >= ph0 && (n) < ph1) grid.sync();
  PH(0, if (blockIdx.x == 0 && threadIdx.x < 34) gp->in[threadIdx.x] = p.in[threadIdx.x];
        if (blockIdx.x == 0 && threadIdx.x == 0) { gp->out = p.out; gp->ws = p.ws; gp->positions = p.positions; }
        phase_prep(p, smem); phase_xprep(p.in[0], hn, ss);)
  PH(1, phase_gemm_in<true>(*gp, hn, ss, smem);)
  PH(2, phase_fox_f(*gp, smem); for (int t = blockIdx.x; t < 4096; t += gridDim.x) gdn_pre_tile(*gp, t, smem);)
  PH(3, for (;;) { int it = next_item(ctr + 0, smem); if (it >= 64 + 4096) break; if (it < 64) gdn_scan_item(*gp, it, smem); else fox_tile(*gp, it - 64, smem); })
  PH(4, phase_gdn_post(*gp); phase_cvt_p(as_global(gp->in[1]), pbf);)
  PH(5, phase_gemm<EP_RESID>(mix, 1024, WT + WT_OUT_E, 1024, 8, nullptr, 0, as_global(gp->in[0]), h, hn, nullptr, ss + 1 * M_, smem);)
  PH(6, phase_gemm<EP_RELU2>(hn, 1024, WT + WT_UP, 1024, 32, Yb, 4096, nullptr, nullptr, nullptr, ss + 1 * M_, nullptr, smem); phase_pp(pbf, WT + WT_PROJ, ppb, smem);)
  PH(7, phase_gemm<EP_RESID>(Yb, 4096, WT + WT_DOWN, 4096, 8, nullptr, 0, h, h, hn, nullptr, ss + 2 * M_, smem);)
  PH(8, phase_ple(hn, WT + WT_GATE, ppb, h, hn2, ss + 2 * M_, ss + 3 * M_, smem);)
  PH(9, phase_gemm_in<false>(*gp, hn2, ss + 3 * M_, smem);)
  PH(10, for (int t = blockIdx.x; t < 128; t += gridDim.x) cmp_tile(*gp, t, smem); for (int t = blockIdx.x; t < 8192; t += gridDim.x) rglru_tile<false>(*gp, t, smem); phase_cvt_p(as_global(gp->in[1]) + (size_t)M_ * 256, pbf);)
  PH(11, for (;;) { int it = next_item(ctr + 1, smem); if (it >= 4096 + 8192) break; if (it < 4096) nsa_tile(*gp, it, smem); else rglru_tile<true>(*gp, it - 4096, smem); })
  PH(12, phase_gemm<EP_RESID>(mix, 1024, WT + WT_OUT_O, 1024, 8, nullptr, 0, h, h, hn, nullptr, ss + 4 * M_, smem);)
  PH(13, phase_gemm<EP_RELU2>(hn, 1024, WT + WT_UP + 4096 * 1024, 1024, 32, Yb, 4096, nullptr, nullptr, nullptr, ss + 4 * M_, nullptr, smem); phase_pp(pbf, WT + WT_PROJ + 1024 * 256, ppb, smem);)
  PH(14, phase_gemm<EP_RESID>(Yb, 4096, WT + WT_DOWN + 4096 * 1024, 4096, 8, nullptr, 0, h, h, hn, nullptr, ss + 5 * M_, smem);)
  PH(15, phase_ple(hn, WT + WT_GATE + 1024 * 1024, ppb, h, nullptr, ss + 5 * M_, nullptr, smem);)
  PH(16, phase_norm(h, as_global(gp->in[33]), nullptr, h);)
}

extern "C" void kernel_launch(void* const* d_in, const int* in_sizes, int n_in, void* d_out, int out_size, void* d_ws,
                              size_t ws_size, hipStream_t stream) {
  static int grid_blocks = 0;
  if (!grid_blocks) {
    hipFuncSetAttribute((const void*)mega, hipFuncAttributeMaxDynamicSharedMemorySize, LDS_BYTES);
    int dev = 0, cus = 0, per_cu = 0;
    hipGetDevice(&dev);
    hipDeviceGetAttribute(&cus, hipDeviceAttributeMultiprocessorCount, dev);
    hipOccupancyMaxActiveBlocksPerMultiprocessor(&per_cu, mega, 256, LDS_BYTES);
    if (per_cu > 2) per_cu = 2;
    if (per_cu < 1) per_cu = 1;
    grid_blocks = cus * per_cu;
  }
  Params p;
  memset((void*)&p, 0, sizeof(p));
  for (int i = 0; i < 34; i++) p.in[i] = (const float*)d_in[i];
  p.positions = (const int*)d_in[2];
  p.out = (float*)d_out;
  p.ws = (char*)d_ws;
  bf16_t* WT = (bf16_t*)((char*)d_ws + OFF_WT);
  auto F = [&](int i) { return (const float*)d_in[i]; };
  int nd = 0, t0 = 0;
  auto add = [&](const float* src, bf16_t* dst, int K, int N, int Nd, int kind, int nb, const float* scale) {
    p.wd[nd].src = src; p.wd[nd].dst = dst; p.wd[nd].scale = scale; p.wd[nd].K = K; p.wd[nd].N = N; p.wd[nd].Nd = Nd; p.wd[nd].kind = kind; p.wd[nd].nb = nb; p.wd[nd].tile0 = t0;
    t0 += nb * (K / 64) * (Nd / 64);
    nd++;
  };
  add(F(4), WT + WT_IN_E, 1024, 3600, 3712, 1, 1, F(3));
  add(F(10), WT + WT_OUT_E, 1024, 1024, 1024, 0, 1, nullptr);
  add(F(12), WT + WT_IN_O, 1024, 2328, 2432, 2, 1, F(11));
  add(F(26), WT + WT_OUT_O, 1024, 1024, 1024, 0, 1, nullptr);
  add(F(28), WT + WT_UP, 1024, 4096, 4096, 0, 2, F(27));
  add(F(29), WT + WT_DOWN, 4096, 1024, 1024, 0, 2, nullptr);
  add(F(31), WT + WT_GATE, 1024, 1024, 1024, 0, 2, F(30));
  add(F(32), WT + WT_PROJ, 256, 1024, 1024, 0, 2, nullptr);
  add(F(14), WT + WT_CK1, 2048, 128, 128, 0, 1, nullptr);
  add(F(17), WT + WT_CV1, 2048, 128, 128, 0, 1, nullptr);
  add(F(15), WT + WT_CK2, 128, 64, 64, 0, 1, nullptr);
  add(F(18), WT + WT_CV2, 128, 64, 64, 0, 1, nullptr);
  add(F(21), WT + WT_RGA, 64, 64, 64, 0, 8, nullptr);
  add(F(23), WT + WT_RGX, 64, 64, 64, 0, 8, nullptr);
  while (nd < NWD) { p.wd[nd].K = 64; p.wd[nd].N = 64; p.wd[nd].Nd = 64; p.wd[nd].tile0 = 0x7fffffff; nd++; }
  p.prep_tiles = t0;
  int ph0 = 0, ph1 = NPHASE - 1;
  void* args[] = {&p, &ph0, &ph1};
  hipError_t e = hipLaunchCooperativeKernel((void*)mega, dim3(grid_blocks), dim3(256), args, LDS_BYTES, stream);
  if (e != hipSuccess) fprintf(stderr, "cooperative launch failed: %s (grid %d)\n", hipGetErrorString(e), grid_blocks);
}
```

```cpp
#include <hip/hip_runtime.h>
#include <hip/hip_cooperative_groups.h>
#include <stdint.h>
#include <stdio.h>
#include <string.h>
namespace cg = cooperative_groups;

typedef unsigned short bf16_t;
typedef __attribute__((ext_vector_type(8))) short bf16x8;
typedef __attribute__((ext_vector_type(4))) float f32x4;
#define DEVI __device__ __forceinline__

constexpr int S_ = 8192, B_ = 8, M_ = 65536;
constexpr size_t MiB = 1ull << 20;
constexpr size_t OFF_WT = 0, OFF_Y = 64 * MiB, OFF_MIX = 576 * MiB, OFF_SM = 704 * MiB, OFF_MISC = 712 * MiB,
                 OFF_X = 736 * MiB, OFF_HN = 896 * MiB;
constexpr size_t WT_IN_E = 0;
constexpr size_t WT_OUT_E = WT_IN_E + 3712 * 1024;
constexpr size_t WT_IN_O = WT_OUT_E + 1024 * 1024;
constexpr size_t WT_OUT_O = WT_IN_O + 2432 * 1024;
constexpr size_t WT_UP = WT_OUT_O + 1024 * 1024;
constexpr size_t WT_DOWN = WT_UP + 2 * 4096 * 1024;
constexpr size_t WT_GATE = WT_DOWN + 2 * 4096 * 1024;
constexpr size_t WT_PROJ = WT_GATE + 2 * 1024 * 1024;
constexpr size_t WT_CK1 = WT_PROJ + 2 * 1024 * 256;
constexpr size_t WT_CV1 = WT_CK1 + 128 * 2048;
constexpr size_t WT_CK2 = WT_CV1 + 128 * 2048;
constexpr size_t WT_CV2 = WT_CK2 + 64 * 128;
constexpr size_t WT_RGA = WT_CV2 + 64 * 128;
constexpr size_t WT_RGX = WT_RGA + 8 * 64 * 64;
constexpr size_t MS_ROPE = 0;
constexpr size_t MS_FOXF = 4 * MiB;
constexpr size_t MS_EGL = 6 * MiB;
constexpr size_t MS_CTR = 6 * MiB + 65536;
constexpr size_t MS_KCMP = 7 * MiB;
constexpr size_t MS_VCMPT = 8 * MiB;
constexpr size_t MS_RGAGG = 9 * MiB;
constexpr size_t MS_PTAB = 13 * MiB;
constexpr size_t MS_KMAX = 14 * MiB;
constexpr size_t MS_SS = 15 * MiB;
constexpr int YE_LD = 3584, YO_LD = 2304;
constexpr int GDN_CH_BYTES = 73728;
constexpr int LDS_BYTES = 73728;
constexpr float LOG2E = 1.4426950408889634f;
constexpr float NEGF = -1e30f;

struct WDesc { const float* src; bf16_t* dst; const float* scale; int K, N, Nd, kind, nb, tile0; };
constexpr int NWD = 18;
struct Params {
  const float* in[34];
  const int* positions;
  float* out;
  char* ws;
  WDesc wd[NWD];
  int prep_tiles;
  int pad_;
};

template <class T> DEVI T* as_global(T* q) {
  typedef T __attribute__((address_space(1)))* gp_t;
  return (T*)((gp_t)q);
}
typedef unsigned v4u_t_ __attribute__((ext_vector_type(4)));
typedef float v4f_t_ __attribute__((ext_vector_type(4)));
DEVI uint4 gld16_(const void* q) { typedef const v4u_t_ __attribute__((address_space(1))) gv; v4u_t_ v = *(gv*)q; return make_uint4(v.x, v.y, v.z, v.w); }
DEVI float4 gldf4_(const void* q) { typedef const v4f_t_ __attribute__((address_space(1))) gv; v4f_t_ v = *(gv*)q; return make_float4(v.x, v.y, v.z, v.w); }
#define GLD16(ptr) gld16_(ptr)
#define GLDF4(ptr) gldf4_(ptr)
DEVI char* gws(const Params& p) { return as_global(p.ws); }
DEVI const float* gin(const Params& p, int i) { return as_global(p.in[i]); }
DEVI int opaque_tid() { int t = threadIdx.x; asm volatile("" : "+v"(t)); return t; }
DEVI bf16_t f2bf(float f) { unsigned u = __float_as_uint(f); u += 0x7fffu + ((u >> 16) & 1u); return (bf16_t)(u >> 16); }
DEVI float bf2f(bf16_t b) { return __uint_as_float(((unsigned)b) << 16); }
typedef __bf16 bf2_t_ __attribute__((ext_vector_type(2)));
typedef float f2_t_ __attribute__((ext_vector_type(2)));
DEVI unsigned pack2(float a, float b) { f2_t_ f = {a, b}; bf2_t_ hh = __builtin_convertvector(f, bf2_t_); return __builtin_bit_cast(unsigned, hh); }
DEVI float lo2f(unsigned u) { return __uint_as_float(u << 16); }
DEVI float hi2f(unsigned u) { return __uint_as_float(u & 0xffff0000u); }
DEVI f32x4 mfma16(bf16x8 a, bf16x8 b, f32x4 c) { return __builtin_amdgcn_mfma_f32_16x16x32_bf16(a, b, c, 0, 0, 0); }
DEVI float sigmoidf_(float x) { return 1.f / (1.f + __expf(-x)); }
DEVI float softplusf_(float x) { return fmaxf(x, 0.f) + log1pf(__expf(-fabsf(x))); }
DEVI float gelu_tanh(float x) { float u = 0.7978845608028654f * (x + 0.044715f * x * x * x); float e = __expf(-2.f * fabsf(u)); float t = (1.f - e) / (1.f + e); t = u < 0 ? -t : t; return 0.5f * x * (1.f + t); }
DEVI float fexp2(float x) { return __builtin_amdgcn_exp2f(x); }
DEVI bf16x8 mk8(unsigned a, unsigned b, unsigned c, unsigned d) { uint4 v = make_uint4(a, b, c, d); return __builtin_bit_cast(bf16x8, v); }

DEVI int colmap(int kind, int n) {
  if (kind == 0) return n;
  if (kind == 1) {
    if (n < 1536) return n;
    if (n < 3584) return n + 8;
    if (n < 3592) return 1536 + (n - 3584);
    if (n < 3600) return n;
    return -1;
  }
  if (n < 1280) return n;
  if (n < 2304) return n + 24;
  if (n < 2328) return 1280 + (n - 2304);
  return -1;
}

DEVI void phase_prep(const Params& p, char* smem) {
  float (*t)[65] = (float (*)[65])smem;
  int tid = opaque_tid();
  for (int tile = blockIdx.x; tile < p.prep_tiles; tile += gridDim.x) {
    int di = 0;
#pragma unroll 1
    for (int i = 1; i < NWD; i++) if (tile >= p.wd[i].tile0) di = i;
    const WDesc& w = p.wd[di];
    int lt = tile - w.tile0;
    int tk = w.K / 64, tn = w.Nd / 64;
    int bi = lt / (tk * tn); lt -= bi * tk * tn;
    int k0 = (lt / tn) * 64, n0 = (lt % tn) * 64;
    const float* src = w.src + (size_t)bi * w.K * w.N;
    bf16_t* dst = w.dst + (size_t)bi * w.Nd * w.K;
    int nl = tid & 63, kl = tid >> 6;
    int col = colmap(w.kind, n0 + nl);
    if (col >= w.N) col = -1;
#pragma unroll 4
    for (int pp = 0; pp < 16; pp++) {
      int k = kl + pp * 4;
      float scl = w.scale ? w.scale[bi * w.K + k0 + k] : 1.f;
      t[k][nl] = (col >= 0) ? src[(size_t)(k0 + k) * w.N + col] * scl : 0.f;
    }
    __syncthreads();
#pragma unroll 4
    for (int pp = 0; pp < 16; pp++) {
      int n = kl + pp * 4;
      dst[(size_t)(n0 + n) * w.K + k0 + nl] = f2bf(t[nl][n]);
    }
    __syncthreads();
  }
  float* rope = (float*)(gws(p) + OFF_MISC + MS_ROPE);
  int gt = blockIdx.x * 256 + tid, gs = gridDim.x * 256;
  for (int i = gt; i < M_ * 8; i += gs) {
    int m = i >> 3, f = i & 7;
    float invf = powf(500000.f, -(float)f * 0.125f);
    float ang = (float)p.positions[m] * invf;
    double n = rint((double)ang * 0.15915494309189535);
    float r = (float)((double)ang - n * 6.283185307179586);
    rope[m * 16 + f] = cosf(r);
    rope[m * 16 + 8 + f] = sinf(r);
  }
  if (gt < 16) ((int*)(gws(p) + OFF_MISC + MS_CTR))[gt] = 0;
  if (gt < 64) ((unsigned*)(gws(p) + OFF_MISC + MS_KMAX))[gt] = 0u;
  { float* ssz = (float*)(gws(p) + OFF_MISC + MS_SS); for (int i = M_ + gt; i < 6 * M_; i += gs) ssz[i] = 0.f; }
  bf16_t* kc = (bf16_t*)(gws(p) + OFF_MISC + MS_KCMP);
  bf16_t* vc = (bf16_t*)(gws(p) + OFF_MISC + MS_VCMPT);
  for (int i = gt; i < B_ * 128; i += gs) { int b = i >> 7, c = i & 127; kc[((size_t)b * 512 + 511) * 128 + c] = 0; vc[((size_t)b * 128 + c) * 512 + 511] = 0; }
}

DEVI void phase_norm(const float* __restrict__ src, const float* __restrict__ w, bf16_t* __restrict__ dstb, float* __restrict__ dstf) {
  int lane = opaque_tid() & 63;
  int gw = blockIdx.x * 4 + (opaque_tid() >> 6), nw = gridDim.x * 4;
  for (int row = gw; row < M_; row += nw) {
    const float4* s4 = (const float4*)(src + (size_t)row * 1024);
    float4 v[4]; float ss = 0.f;
#pragma unroll
    for (int i = 0; i < 4; i++) { v[i] = s4[lane + i * 64]; ss += v[i].x * v[i].x + v[i].y * v[i].y + v[i].z * v[i].z + v[i].w * v[i].w; }
#pragma unroll
    for (int o = 32; o >= 1; o >>= 1) ss += __shfl_xor(ss, o);
    float rs = rsqrtf(ss * (1.f / 1024.f) + 1e-6f);
#pragma unroll
    for (int i = 0; i < 4; i++) {
      float4 ww = ((const float4*)w)[lane + i * 64];
      float a = v[i].x * rs * ww.x, b = v[i].y * rs * ww.y, c = v[i].z * rs * ww.z, d = v[i].w * rs * ww.w;
      if (dstf) ((float4*)(dstf + (size_t)row * 1024))[lane + i * 64] = make_float4(a, b, c, d);
      else ((uint2*)(dstb + (size_t)row * 1024))[lane + i * 64] = make_uint2(pack2(a, b), pack2(c, d));
    }
  }
}
DEVI void phase_xprep(const float* __restrict__ src, bf16_t* __restrict__ dstb, float* __restrict__ ss) {
  int lane = opaque_tid() & 63;
  int gw = blockIdx.x * 4 + (opaque_tid() >> 6), nw = gridDim.x * 4;
  for (int row = gw; row < M_; row += nw) {
    const float4* s4 = (const float4*)(src + (size_t)row * 1024);
    float acc = 0.f;
#pragma unroll
    for (int i = 0; i < 4; i++) {
      float4 v = s4[lane + i * 64];
      acc += v.x * v.x + v.y * v.y + v.z * v.z + v.w * v.w;
      ((uint2*)(dstb + (size_t)row * 1024))[lane + i * 64] = make_uint2(pack2(v.x, v.y), pack2(v.z, v.w));
    }
#pragma unroll
    for (int o = 32; o >= 1; o >>= 1) acc += __shfl_xor(acc, o);
    if (lane == 0) ss[row] = acc;
  }
}
DEVI void phase_cvt_p(const float* __restrict__ src, bf16_t* __restrict__ dst) {
  size_t n4 = (size_t)M_ * 256 / 4;
  for (size_t i = (size_t)blockIdx.x * 256 + opaque_tid(); i < n4; i += (size_t)gridDim.x * 256) {
    float4 v = ((const float4*)src)[i];
    ((uint2*)dst)[i] = make_uint2(pack2(v.x, v.y), pack2(v.z, v.w));
  }
}

struct GemmSmem { bf16_t a[2][128][72]; bf16_t b[2][128][72]; };

struct ALoadPlain {
  const bf16_t* A; int lda; int toff;
  DEVI void init(int lr, int lc) { toff = lr * lda + lc; }
  DEVI uint4 load(int i, int k) const { const bf16_t* ub = A + ((size_t)(i * 32) * lda + k); return *(const uint4*)(ub + toff); }
};

template <bool SWAP, class AL>
DEVI void gemm_mainloop(const AL& al_in, const bf16_t* __restrict__ Bt, int ldb, int K, char* smem, f32x4 (&acc)[4][4]) {
  GemmSmem& sm = *(GemmSmem*)smem;
  const int tid = opaque_tid(), lane = tid & 63, wid = tid >> 6, wr = wid >> 1, wc = wid & 1;
  const int lr = tid >> 3, lc = (tid & 7) * 8;
  const int fr = lane & 15, fq = lane >> 4;
  uint4 ra0, ra1, ra2, ra3, rb0, rb1, rb2, rb3;
  uint4 qa0, qa1, qa2, qa3, qb0, qb1, qb2, qb3;
  const int btoff = lr * ldb + lc;
  AL al = al_in; al.init(lr, lc);
#define GL_A(k) do { ra0 = al.load(0, (k)); ra1 = al.load(1, (k)); ra2 = al.load(2, (k)); ra3 = al.load(3, (k)); \
    rb0 = *(const uint4*)(Bt + (k) + btoff); rb1 = *(const uint4*)(Bt + ((size_t)32 * ldb + (k)) + btoff); rb2 = *(const uint4*)(Bt + ((size_t)64 * ldb + (k)) + btoff); rb3 = *(const uint4*)(Bt + ((size_t)96 * ldb + (k)) + btoff); } while (0)
#define GL_B(k) do { qa0 = al.load(0, (k)); qa1 = al.load(1, (k)); qa2 = al.load(2, (k)); qa3 = al.load(3, (k)); \
    qb0 = *(const uint4*)(Bt + (k) + btoff); qb1 = *(const uint4*)(Bt + ((size_t)32 * ldb + (k)) + btoff); qb2 = *(const uint4*)(Bt + ((size_t)64 * ldb + (k)) + btoff); qb3 = *(const uint4*)(Bt + ((size_t)96 * ldb + (k)) + btoff); } while (0)
#define ST_A(bf) do { *(uint4*)&sm.a[bf][lr][lc] = ra0; *(uint4*)&sm.a[bf][lr + 32][lc] = ra1; *(uint4*)&sm.a[bf][lr + 64][lc] = ra2; *(uint4*)&sm.a[bf][lr + 96][lc] = ra3; \
    *(uint4*)&sm.b[bf][lr][lc] = rb0; *(uint4*)&sm.b[bf][lr + 32][lc] = rb1; *(uint4*)&sm.b[bf][lr + 64][lc] = rb2; *(uint4*)&sm.b[bf][lr + 96][lc] = rb3; } while (0)
#define ST_B(bf) do { *(uint4*)&sm.a[bf][lr][lc] = qa0; *(uint4*)&sm.a[bf][lr + 32][lc] = qa1; *(uint4*)&sm.a[bf][lr + 64][lc] = qa2; *(uint4*)&sm.a[bf][lr + 96][lc] = qa3; \
    *(uint4*)&sm.b[bf][lr][lc] = qb0; *(uint4*)&sm.b[bf][lr + 32][lc] = qb1; *(uint4*)&sm.b[bf][lr + 64][lc] = qb2; *(uint4*)&sm.b[bf][lr + 96][lc] = qb3; } while (0)
#define COMPUTE(bf) do { _Pragma("unroll") for (int kk = 0; kk < 2; kk++) { \
      bf16x8 af[4], bfr[4]; \
      _Pragma("unroll") for (int i = 0; i < 4; i++) af[i] = *(const bf16x8*)&sm.a[bf][wr * 64 + i * 16 + fr][kk * 32 + fq * 8]; \
      _Pragma("unroll") for (int j = 0; j < 4; j++) bfr[j] = *(const bf16x8*)&sm.b[bf][wc * 64 + j * 16 + fr][kk * 32 + fq * 8]; \
      __builtin_amdgcn_s_setprio(1); \
      _Pragma("unroll") for (int i = 0; i < 4; i++) _Pragma("unroll") for (int j = 0; j < 4; j++) \
          acc[i][j] = SWAP ? mfma16(bfr[j], af[i], acc[i][j]) : mfma16(af[i], bfr[j], acc[i][j]); \
      __builtin_amdgcn_s_setprio(0); } } while (0)
  const int nk = K >> 6;
  GL_A(0);
  ST_A(0);
  GL_A(64);
  __syncthreads();
  for (int kt = 0; kt < nk; kt += 2) {
    if (kt + 2 < nk) GL_B((kt + 2) * 64);
    COMPUTE(0);
    ST_A(1);
    __syncthreads();
    if (kt + 3 < nk) GL_A((kt + 3) * 64);
    COMPUTE(1);
    if (kt + 2 < nk) ST_B(0);
    __syncthreads();
  }
#undef GL_A
#undef GL_B
#undef ST_A
#undef ST_B
#undef COMPUTE
}
template <bool SWAP>
DEVI void gemm_mainloop_dma(const bf16_t* __restrict__ A, int lda, const bf16_t* __restrict__ Bt, int ldb, int K, char* smem, f32x4 (&acc)[8][4]) {
  const int tid = opaque_tid(), lane = tid & 63, wid = tid >> 6, wr = wid >> 1, wc = wid & 1;
  const int fr = lane & 15, fq = lane >> 4;
  const int gc = (tid & 3) ^ ((0x1320 >> (((tid >> 4) & 3) * 4)) & 3);
  const int aoff = (tid >> 2) * lda + gc * 8, boff = (tid >> 2) * ldb + gc * 8;
  char* lds_t = smem + tid * 16;
#define DMA_ISSUE(st, k0) do { \
    _Pragma("unroll") for (int j = 0; j < 4; j++) \
      __builtin_amdgcn_global_load_lds((const unsigned*)(A + ((size_t)(j * 64) * lda + (k0)) + aoff), (unsigned*)(lds_t + (st) * 24576 + j * 4096), 16, 0, 0); \
    _Pragma("unroll") for (int j = 0; j < 2; j++) \
      __builtin_amdgcn_global_load_lds((const unsigned*)(Bt + ((size_t)(j * 64) * ldb + (k0)) + boff), (unsigned*)(lds_t + (st) * 24576 + 16384 + j * 4096), 16, 0, 0); } while (0)
  const int co = (fq ^ ((0x1320 >> (((fr >> 2) & 3) * 4)) & 3)) * 16;
  const int arow = (wr * 128 + fr) * 64 + co, brow = 16384 + (wc * 64 + fr) * 64 + co;
  const int nk = K >> 5;
  DMA_ISSUE(0, 0); DMA_ISSUE(1, 32);
  int stg = 0;
  for (int kt = 0; kt < nk; kt++) {
    if (kt + 1 < nk) asm volatile("s_waitcnt vmcnt(6)" ::: "memory");
    else asm volatile("s_waitcnt vmcnt(0)" ::: "memory");
    __builtin_amdgcn_s_barrier();
    int nst = stg == 0 ? 2 : stg - 1;
    if (kt + 2 < nk) DMA_ISSUE(nst, (kt + 2) * 32);
    const char* st = smem + stg * 24576;
    bf16x8 bfr[4];
#pragma unroll
    for (int j = 0; j < 4; j++) bfr[j] = *(const bf16x8*)(st + brow + j * 1024);
#pragma unroll
    for (int ih = 0; ih < 2; ih++) {
      bf16x8 af[4];
#pragma unroll
      for (int i = 0; i < 4; i++) af[i] = *(const bf16x8*)(st + arow + (ih * 4 + i) * 1024);
      __builtin_amdgcn_s_setprio(1);
#pragma unroll
      for (int i = 0; i < 4; i++)
#pragma unroll
        for (int j = 0; j < 4; j++)
          acc[ih * 4 + i][j] = SWAP ? mfma16(bfr[j], af[i], acc[ih * 4 + i][j]) : mfma16(af[i], bfr[j], acc[ih * 4 + i][j]);
      __builtin_amdgcn_s_setprio(0);
    }
    stg = stg == 2 ? 0 : stg + 1;
  }
  __syncthreads();
#undef DMA_ISSUE
}
DEVI void zero_acc8(f32x4 (&acc)[8][4]) {
#pragma unroll
  for (int i = 0; i < 8; i++)
#pragma unroll
    for (int j = 0; j < 4; j++) acc[i][j] = f32x4{0.f, 0.f, 0.f, 0.f};
}
DEVI int xcd_vid() { int g8 = gridDim.x >> 3; return (blockIdx.x & 7) * g8 + (blockIdx.x >> 3); }
DEVI void zero_acc(f32x4 (&acc)[4][4]) {
#pragma unroll
  for (int i = 0; i < 4; i++)
#pragma unroll
    for (int j = 0; j < 4; j++) acc[i][j] = f32x4{0.f, 0.f, 0.f, 0.f};
}

enum { EP_BF16 = 0, EP_RELU2 = 1, EP_RESID = 2 };
DEVI float row_rstd(const float* ss, size_t m) { return rsqrtf(ss[m] * (1.f / 1024.f) + 1e-6f); }
template <int EP>
DEVI void phase_gemm(const bf16_t* A, int lda, const bf16_t* Bt, int K, int NT, bf16_t* Cb, int ldc,
                     const float* res, float* outf, bf16_t* hb, const float* ss_in, float* ss_out, char* smem) {
  const int tid = opaque_tid(), lane = tid & 63, wid = tid >> 6, wr = wid >> 1, wc = wid & 1, fr = lane & 15, fq = lane >> 4;
  const int ntiles = 256 * NT;
  for (int tile = xcd_vid(); tile < ntiles; tile += gridDim.x) {
    int mt = tile / NT, nt = tile % NT;
    f32x4 acc[8][4]; zero_acc8(acc);
    gemm_mainloop_dma<true>(A + (size_t)mt * 256 * lda, lda, Bt + (size_t)nt * 128 * K, K, K, smem, acc);
#pragma unroll
    for (int i = 0; i < 8; i++) {
      size_t m = (size_t)mt * 256 + wr * 128 + i * 16 + fr;
      float rs = (EP == EP_RELU2) ? row_rstd(ss_in, m) : 1.f;
      float part = 0.f;
#pragma unroll
      for (int j = 0; j < 4; j++) {
        int n = nt * 128 + wc * 64 + j * 16 + fq * 4;
        f32x4 v = acc[i][j];
        if (EP == EP_BF16) {
          *(uint2*)(Cb + m * ldc + n) = make_uint2(pack2(v[0], v[1]), pack2(v[2], v[3]));
        } else if (EP == EP_RELU2) {
          float a = fmaxf(v[0], 0.f) * rs, b = fmaxf(v[1], 0.f) * rs, c = fmaxf(v[2], 0.f) * rs, d = fmaxf(v[3], 0.f) * rs;
          *(uint2*)(Cb + m * ldc + n) = make_uint2(pack2(a * a, b * b), pack2(c * c, d * d));
        } else {
          float4 r = *(const float4*)(res + m * 1024 + n);
          float o0 = r.x + v[0], o1 = r.y + v[1], o2 = r.z + v[2], o3 = r.w + v[3];
          *(float4*)(outf + m * 1024 + n) = make_float4(o0, o1, o2, o3);
          *(uint2*)(hb + m * 1024 + n) = make_uint2(pack2(o0, o1), pack2(o2, o3));
          part += o0 * o0 + o1 * o1 + o2 * o2 + o3 * o3;
        }
      }
      if (EP == EP_RESID) {
        part += __shfl_xor(part, 16); part += __shfl_xor(part, 32);
        if (fq == 0) atomicAdd(&ss_out[m], part);
      }
      __builtin_amdgcn_sched_barrier(0);
    }
  }
}

struct ALoadF32 {
  const float* A; int lda; int lr, lc;
  DEVI void init(int lr_, int lc_) { lr = lr_; lc = lc_; }
  DEVI uint4 load(int i, int k) const {
    const float4* s = (const float4*)(A + (size_t)(lr + i * 32) * lda + k + lc);
    float4 a = s[0], b = s[1];
    return make_uint4(pack2(a.x, a.y), pack2(a.z, a.w), pack2(b.x, b.y), pack2(b.z, b.w));
  }
};
DEVI void phase_pp(const bf16_t* pf, const bf16_t* Wp, bf16_t* pp, char* smem) {
  const int tid = opaque_tid(), lane = tid & 63, wid = tid >> 6, wr = wid >> 1, wc = wid & 1, fr = lane & 15, fq = lane >> 4;
  for (int tile = xcd_vid(); tile < 256 * 8; tile += gridDim.x) {
    int mt = tile >> 3, nt = tile & 7;
    f32x4 acc[8][4]; zero_acc8(acc);
    gemm_mainloop_dma<true>(pf + (size_t)mt * 256 * 256, 256, Wp + (size_t)nt * 128 * 256, 256, 256, smem, acc);
#pragma unroll
    for (int i = 0; i < 8; i++) {
      size_t m = (size_t)mt * 256 + wr * 128 + i * 16 + fr;
#pragma unroll
      for (int j = 0; j < 4; j++) {
        int n = nt * 128 + wc * 64 + j * 16 + fq * 4;
        f32x4 v = acc[i][j];
        *(uint2*)(pp + m * 1024 + n) = make_uint2(pack2(v[0], v[1]), pack2(v[2], v[3]));
      }
    }
  }
}
DEVI void phase_ple(const bf16_t* hbin, const bf16_t* Wg, const bf16_t* pp, float* h, bf16_t* hb, const float* ss_in, float* ss_out, char* smem) {
  const int tid = opaque_tid(), lane = tid & 63, wid = tid >> 6, wr = wid >> 1, wc = wid & 1, fr = lane & 15, fq = lane >> 4;
  for (int tile = xcd_vid(); tile < 256 * 8; tile += gridDim.x) {
    int mt = tile >> 3, nt = tile & 7;
    f32x4 acc[8][4]; zero_acc8(acc);
    gemm_mainloop_dma<true>(hbin + (size_t)mt * 256 * 1024, 1024, Wg + (size_t)nt * 128 * 1024, 1024, 1024, smem, acc);
#pragma unroll
    for (int i = 0; i < 8; i++) {
      size_t m = (size_t)mt * 256 + wr * 128 + i * 16 + fr;
      float rs = row_rstd(ss_in, m);
      float part = 0.f;
#pragma unroll
      for (int j = 0; j < 4; j++) {
        int n = nt * 128 + wc * 64 + j * 16 + fq * 4;
        float4 r = *(const float4*)(h + m * 1024 + n);
        uint2 q = *(const uint2*)(pp + m * 1024 + n);
        f32x4 g = acc[i][j];
        float o0 = r.x + sigmoidf_(g[0] * rs) * lo2f(q.x), o1 = r.y + sigmoidf_(g[1] * rs) * hi2f(q.x);
        float o2 = r.z + sigmoidf_(g[2] * rs) * lo2f(q.y), o3 = r.w + sigmoidf_(g[3] * rs) * hi2f(q.y);
        *(float4*)(h + m * 1024 + n) = make_float4(o0, o1, o2, o3);
        if (hb) {
          *(uint2*)(hb + m * 1024 + n) = make_uint2(pack2(o0, o1), pack2(o2, o3));
          part += o0 * o0 + o1 * o1 + o2 * o2 + o3 * o3;
        }
      }
      if (hb) {
        part += __shfl_xor(part, 16); part += __shfl_xor(part, 32);
        if (fq == 0) atomicAdd(&ss_out[m], part);
      }
      __builtin_amdgcn_sched_barrier(0);
    }
  }
}

struct InTileKind { int kind; int ycol; bf16_t* vt; int vtrows; int nsmall; };
template <bool EVEN>
DEVI InTileKind in_tile_kind(const Params& p, int nt) {
  InTileKind k{0, nt * 128, nullptr, 0, 0};
  char* Y = gws(p) + OFF_Y;
  if (EVEN) {
    if (nt >= 8 && nt < 12) { k.kind = 2; k.vt = (bf16_t*)(Y + 448 * MiB) + (size_t)(nt - 8) * 128 * S_; k.vtrows = 512; }
    else if (nt == 28) { k.kind = 3; k.nsmall = 16; }
  } else {
    if (nt < 5 || nt == 6 || nt == 8) k.kind = 1;
    else if (nt == 7) { k.kind = 2; k.vt = (bf16_t*)(Y + 288 * MiB); k.vtrows = 128; }
    else if (nt == 9) { k.kind = 2; k.vt = (bf16_t*)(Y + 304 * MiB); k.vtrows = 128; }
    else if (nt == 18) { k.kind = 3; k.nsmall = 24; }
  }
  return k;
}
template <bool EVEN>
DEVI void phase_gemm_in(const Params& p, const bf16_t* hn, const float* ss_in, char* smem) {
  const int tid = opaque_tid(), lane = tid & 63, wid = tid >> 6, wr = wid >> 1, wc = wid & 1, fr = lane & 15, fq = lane >> 4;
  constexpr int NT = EVEN ? 29 : 19;
  constexpr int LDY = EVEN ? YE_LD : YO_LD;
  const bf16_t* Wt = (const bf16_t*)(gws(p) + OFF_WT) + (EVEN ? WT_IN_E : WT_IN_O);
  bf16_t* Y = (bf16_t*)(gws(p) + OFF_Y);
  float* ysm = (float*)(gws(p) + OFF_SM);
  const float* rope = (const float*)(gws(p) + OFF_MISC + MS_ROPE);
  for (int tile = xcd_vid(); tile < 256 * NT; tile += gridDim.x) {
    int mt = tile / NT, nt = tile % NT;
    InTileKind tk = in_tile_kind<EVEN>(p, nt);
    f32x4 acc[8][4]; zero_acc8(acc);
    gemm_mainloop_dma<true>(hn + (size_t)mt * 256 * 1024, 1024, Wt + (size_t)nt * 128 * 1024, 1024, 1024, smem, acc);
    if (tk.kind == 2) {
      int b = (mt * 256) / S_, s0 = (mt * 256) % S_;
#pragma unroll
      for (int i = 0; i < 8; i++)
#pragma unroll
        for (int j = 0; j < 4; j++) {
          int n = wc * 64 + j * 16 + fq * 4, s = s0 + wr * 128 + i * 16 + fr;
          f32x4 v = acc[i][j] * row_rstd(ss_in, (size_t)mt * 256 + wr * 128 + i * 16 + fr);
          bf16_t* dst = tk.vt + ((size_t)b * tk.vtrows + n) * S_ + s;
#pragma unroll
          for (int r = 0; r < 4; r++) dst[(size_t)r * S_] = f2bf(v[r]);
        }
    } else {
#pragma unroll
      for (int i = 0; i < 8; i++) {
        size_t m = (size_t)mt * 256 + wr * 128 + i * 16 + fr;
        {
          float rs = row_rstd(ss_in, m);
#pragma unroll
          for (int j = 0; j < 4; j++) acc[i][j] *= rs;
        }
        if (tk.kind == 1) {
          const float* rp = rope + m * 16;
          f32x4 v = acc[i][0];
#pragma unroll
          for (int r = 0; r < 4; r++) {
            float pv = __shfl_xor(v[r], 32);
            int d8 = (fq & 1) * 4 + r;
            float c = rp[d8], s = rp[8 + d8];
            acc[i][0][r] = (fq < 2) ? (v[r] * c - pv * s) : (v[r] * c + pv * s);
          }
        }
#pragma unroll
        for (int j = 0; j < 4; j++) {
          int nl = wc * 64 + j * 16 + fq * 4;
          f32x4 v = acc[i][j];
          if (tk.kind == 3) {
#pragma unroll
            for (int r = 0; r < 4; r++) if (nl + r < tk.nsmall) ysm[m * 32 + nl + r] = v[r];
          } else {
            *(uint2*)(Y + m * LDY + tk.ycol + nl) = make_uint2(pack2(v[0], v[1]), pack2(v[2], v[3]));
          }
        }
      }
    }
  }
}

struct AttnSmem { bf16_t k[2][64][72]; bf16_t vt[2][64][72]; float fk[2][64]; };
constexpr int SM_IMP = 37376;
constexpr int SM_SELM = 71168;
constexpr int SM_BOR = 72192;
constexpr int SM_SLOT = 73712;
typedef unsigned long long u64;

DEVI int next_tile(u64 lo, u64 hi, int after) {
  if (after < 63) { u64 x = lo & (~0ull << (after + 1)); if (x) return __builtin_ctzll(x); }
  int a2 = after < 63 ? -1 : after - 64;
  if (a2 < 63) { u64 y = hi & (~0ull << (a2 + 1)); if (y) return 64 + __builtin_ctzll(y); }
  return -1;
}

DEVI float xq_max(float a) {
  auto r = __builtin_amdgcn_permlane16_swap(__float_as_uint(a), __float_as_uint(a), false, false);
  a = fmaxf(a, fmaxf(__uint_as_float(r[0]), __uint_as_float(r[1])));
  auto q = __builtin_amdgcn_permlane32_swap(__float_as_uint(a), __float_as_uint(a), false, false);
  return fmaxf(a, fmaxf(__uint_as_float(q[0]), __uint_as_float(q[1])));
}
template <int MODE, int NQT, class Pol>
DEVI void attn_compute(Pol& pol, AttnSmem& sm, int buf, int kb, const bf16x8 (&qf)[NQT][2], f32x4 (&o)[4][NQT], float (&m)[NQT], float (&l)[NQT], float* impw, int fr, int fq) {
      pol.begin(kb, sm.fk[buf]);
      const bool msk = pol.masked(kb);
      f32x4 s[4][NQT];
#pragma unroll
      for (int kt = 0; kt < 4; kt++)
#pragma unroll
        for (int qt = 0; qt < NQT; qt++) s[kt][qt] = f32x4{0.f, 0.f, 0.f, 0.f};
#pragma unroll
      for (int kt = 0; kt < 4; kt++)
#pragma unroll
        for (int kk = 0; kk < 2; kk++) {
          bf16x8 kf = *(const bf16x8*)&sm.k[buf][kt * 16 + fr][kk * 32 + fq * 8];
#pragma unroll
          for (int qt = 0; qt < NQT; qt++) s[kt][qt] = mfma16(kf, qf[qt][kk], s[kt][qt]);
        }
      bf16x8 pfr[2][NQT];
      float psum[4][4];
      if (MODE == 2) {
#pragma unroll
        for (int kt = 0; kt < 4; kt++)
#pragma unroll
          for (int r = 0; r < 4; r++) psum[kt][r] = 0.f;
      }
#pragma unroll
      for (int qt = 0; qt < NQT; qt++) {
        float t[4][4];
        if (Pol::UB && MODE != 2 && !msk) {
          const float bl = pol.lane_bias();
          float mxr = fmaxf(fmaxf(s[0][qt][0], s[0][qt][1]), fmaxf(s[0][qt][2], s[0][qt][3]));
#pragma unroll
          for (int kt = 1; kt < 4; kt++) mxr = fmaxf(mxr, fmaxf(fmaxf(s[kt][qt][0], s[kt][qt][1]), fmaxf(s[kt][qt][2], s[kt][qt][3])));
          float mx = xq_max(fmaf(mxr, pol.sc, bl));
          float mnew = fmaxf(m[qt], mx);
          float alpha = fexp2(m[qt] - mnew);
          m[qt] = mnew;
          const float cb = bl - fmaxf(mnew, 0.1f * NEGF);
          float ps = 0.f;
#pragma unroll
          for (int kt = 0; kt < 4; kt++)
#pragma unroll
            for (int r = 0; r < 4; r++) { t[kt][r] = fexp2(fmaf(s[kt][qt][r], pol.sc, cb)); ps += t[kt][r]; }
          l[qt] = l[qt] * alpha + ps;
          if (MODE == 0) {
            if (__any(alpha != 1.f)) {
#pragma unroll
              for (int dt = 0; dt < 4; dt++) o[dt][qt] *= alpha;
            }
          }
        } else {
#pragma unroll
        for (int kt = 0; kt < 4; kt++) {
          f32x4 bb = pol.bias4(kt * 16 + fq * 4);
#pragma unroll
          for (int r = 0; r < 4; r++) t[kt][r] = fmaf(s[kt][qt][r], pol.sc, bb[r]);
        }
        if (msk) {
#pragma unroll
          for (int kt = 0; kt < 4; kt++)
#pragma unroll
            for (int r = 0; r < 4; r++) t[kt][r] = pol.ok(qt, kt * 16 + fq * 4 + r) ? t[kt][r] : NEGF;
        }
        if (MODE == 2) {
#pragma unroll
          for (int kt = 0; kt < 4; kt++)
#pragma unroll
            for (int r = 0; r < 4; r++) {
              t[kt][r] = fexp2(t[kt][r] - fmaxf(m[qt], 0.1f * NEGF)) * l[qt];
              psum[kt][r] += t[kt][r];
            }
        } else {
          float mx = fmaxf(fmaxf(t[0][0], t[0][1]), fmaxf(t[0][2], t[0][3]));
#pragma unroll
          for (int kt = 1; kt < 4; kt++) mx = fmaxf(mx, fmaxf(fmaxf(t[kt][0], t[kt][1]), fmaxf(t[kt][2], t[kt][3])));
          mx = xq_max(mx);
          float mnew = fmaxf(m[qt], mx);
          float alpha = fexp2(m[qt] - mnew);
          m[qt] = mnew;
          float ps = 0.f;
          const float meff = fmaxf(mnew, 0.1f * NEGF);
#pragma unroll
          for (int kt = 0; kt < 4; kt++)
#pragma unroll
            for (int r = 0; r < 4; r++) { t[kt][r] = fexp2(t[kt][r] - meff); ps += t[kt][r]; }
          l[qt] = l[qt] * alpha + ps;
          if (MODE == 0) {
            if (__any(alpha != 1.f)) {
#pragma unroll
              for (int dt = 0; dt < 4; dt++) o[dt][qt] *= alpha;
            }
          }
        }
        }
        if (MODE != 1) {
#pragma unroll
          for (int h2 = 0; h2 < 2; h2++)
            pfr[h2][qt] = mk8(pack2(t[2 * h2][0], t[2 * h2][1]), pack2(t[2 * h2][2], t[2 * h2][3]), pack2(t[2 * h2 + 1][0], t[2 * h2 + 1][1]), pack2(t[2 * h2 + 1][2], t[2 * h2 + 1][3]));
        }
      }
      if (MODE == 2) {
#pragma unroll
        for (int kt = 0; kt < 4; kt++) {
          int c = kb * 16 + kt * 4 + fq;
          atomicAdd(&impw[fr * 132 + c], (psum[kt][0] + psum[kt][1]) + (psum[kt][2] + psum[kt][3]));
          atomicAdd(&impw[fr * 132 + c + 1], psum[kt][3]);
        }
      }
      if (MODE != 1) {
#pragma unroll
        for (int h2 = 0; h2 < 2; h2++)
#pragma unroll
          for (int dt = 0; dt < 4; dt++) {
            const bf16_t* vr = &sm.vt[buf][dt * 16 + fr][h2 * 32 + fq * 4];
            uint2 v0 = *(const uint2*)vr, v1 = *(const uint2*)(vr + 16);
            bf16x8 vf = mk8(v0.x, v0.y, v1.x, v1.y);
#pragma unroll
            for (int qt = 0; qt < NQT; qt++) o[dt][qt] = mfma16(vf, pfr[h2][qt], o[dt][qt]);
          }
      }
    }
template <int MODE, int NQT, class Pol>
DEVI void attn_core(Pol& pol, char* smem, const bf16x8 (&qf)[NQT][2], const bf16_t* __restrict__ Kg, int ldk,
                    const bf16_t* __restrict__ Vtg, int ldv, const float* __restrict__ fkg, u64 mlo, u64 mhi,
                    f32x4 (&o)[4][NQT], float (&m)[NQT], float (&l)[NQT], float* impw) {
  AttnSmem& sm = *(AttnSmem*)smem;
  const int tid = opaque_tid(), lane = tid & 63, fr = lane & 15, fq = lane >> 4;
  const int lrow = tid >> 3, lch = (tid & 7) * 8;
  int kb = next_tile(mlo, mhi, -1);
  if (kb < 0) return;
  uint4 ak0, ak1, av0 = make_uint4(0, 0, 0, 0), av1 = make_uint4(0, 0, 0, 0); float4 af4 = make_float4(0, 0, 0, 0);
  uint4 bk0, bk1, bv0 = make_uint4(0, 0, 0, 0), bv1 = make_uint4(0, 0, 0, 0); float4 bf4 = make_float4(0, 0, 0, 0);
#define GLOADX(P, t) do { \
    P##k0 = GLD16(Kg + (size_t)((t) * 64 + lrow) * ldk + lch); \
    P##k1 = GLD16(Kg + (size_t)((t) * 64 + lrow + 32) * ldk + lch); \
    if (MODE != 1) { P##v0 = GLD16(Vtg + (size_t)(lrow) * ldv + (t) * 64 + lch); \
                     P##v1 = GLD16(Vtg + (size_t)(lrow + 32) * ldv + (t) * 64 + lch); } \
    if (fkg != nullptr && tid < 16) P##f4 = GLDF4(fkg + (t) * 64 + tid * 4); } while (0)
#define SSTOREX(P, b) do { \
    *(uint4*)&sm.k[b][lrow][lch] = P##k0; *(uint4*)&sm.k[b][lrow + 32][lch] = P##k1; \
    if (MODE != 1) { *(uint4*)&sm.vt[b][lrow][lch] = P##v0; *(uint4*)&sm.vt[b][lrow + 32][lch] = P##v1; } \
    if (fkg != nullptr && tid < 16) *(float4*)&sm.fk[b][tid * 4] = P##f4; } while (0)
#define ATTN_STEP(S, L) do { \
    int kb2 = kb1 >= 0 ? next_tile(mlo, mhi, kb1) : -1; \
    if (kb2 >= 0) GLOADX(L, kb2); \
    if (pol.active(kb)) attn_compute<MODE, NQT, Pol>(pol, sm, buf, kb, qf, o, m, l, impw, fr, fq); \
    if (kb1 >= 0) SSTOREX(S, buf ^ 1); \
    __syncthreads(); \
    buf ^= 1; kb = kb1; kb1 = kb2; } while (0)
  int kb1 = next_tile(mlo, mhi, kb);
  GLOADX(a, kb); SSTOREX(a, 0);
  if (kb1 >= 0) GLOADX(a, kb1);
  __syncthreads();
  int buf = 0;
  for (;;) {
    ATTN_STEP(a, b);
    if (kb < 0) break;
    ATTN_STEP(b, a);
    if (kb < 0) break;
  }
#undef GLOADX
#undef SSTOREX
#undef ATTN_STEP
}
template <int NQT>
DEVI void zero_o(f32x4 (&o)[4][NQT]) {
#pragma unroll
  for (int i = 0; i < 4; i++)
#pragma unroll
    for (int j = 0; j < NQT; j++) o[i][j] = f32x4{0.f, 0.f, 0.f, 0.f};
}

DEVI void phase_fox_f(const Params& p, char* smem) {
  const int tid = opaque_tid(), lane = tid & 63, wid = tid >> 6;
  {
    unsigned* kmaxp = (unsigned*)(gws(p) + OFF_MISC + MS_KMAX);
    for (int slab = blockIdx.x; slab < M_ / 128; slab += gridDim.x) {
      int tok = slab * 128 + (tid >> 1), hh0 = (tid & 1) * 4, b = tok / S_;
      const uint4* kr = (const uint4*)((const bf16_t*)(gws(p) + OFF_Y) + (size_t)tok * YE_LD + 512 + hh0 * 64);
#pragma unroll
      for (int hh = 0; hh < 4; hh++) {
        float ss = 0.f;
#pragma unroll
        for (int c = 0; c < 8; c++) {
          uint4 v = kr[hh * 8 + c];
          float a0 = lo2f(v.x), a1 = hi2f(v.x), a2 = lo2f(v.y), a3 = hi2f(v.y), a4 = lo2f(v.z), a5 = hi2f(v.z), a6 = lo2f(v.w), a7 = hi2f(v.w);
          ss += a0 * a0 + a1 * a1 + a2 * a2 + a3 * a3 + a4 * a4 + a5 * a5 + a6 * a6 + a7 * a7;
        }
        ss = fmaxf(ss, __shfl_xor(ss, 2)); ss = fmaxf(ss, __shfl_xor(ss, 4)); ss = fmaxf(ss, __shfl_xor(ss, 8));
        ss = fmaxf(ss, __shfl_xor(ss, 16)); ss = fmaxf(ss, __shfl_xor(ss, 32));
        if (lane < 2) atomicMax(&kmaxp[b * 8 + hh0 + hh], __float_as_uint(ss));
      }
    }
  }
  if (blockIdx.x < 64) {
    int gw = blockIdx.x, b = gw >> 3, h = gw & 7;
    const float* ysm = (const float*)(gws(p) + OFF_SM) + (size_t)b * S_ * 32 + h;
    float bf = gin(p, 5)[h];
    float* F = (float*)(gws(p) + OFF_MISC + MS_FOXF) + (size_t)gw * S_;
    float ls[32];
    float sum = 0.f;
#pragma unroll
    for (int i = 0; i < 32; i++) { float x = ysm[(size_t)(tid * 32 + i) * 32] + bf; ls[i] = -softplusf_(-x); sum += ls[i]; }
    float incl = sum;
#pragma unroll
    for (int o = 1; o < 64; o <<= 1) { float t = __shfl_up(incl, o); if (lane >= o) incl += t; }
    float* wsum = (float*)smem;
    if (lane == 63) wsum[wid] = incl;
    __syncthreads();
    float off = 0.f;
    for (int w = 0; w < wid; w++) off += wsum[w];
    float run = off + incl - sum;
#pragma unroll
    for (int i = 0; i < 32; i++) { run += ls[i]; F[tid * 32 + i] = run * LOG2E; }
    __syncthreads();
  }
}

struct FoxPol {
  static constexpr bool UB = false;
  DEVI float lane_bias() const { return 0.f; }
  int tq0; int qmin, qmax; int kb; const float* fk; float sc;
  DEVI bool active(int kb_) const { return kb_ * 64 <= qmax; }
  DEVI bool masked(int kb_) const { return kb_ * 64 + 63 > qmin; }
  DEVI void begin(int kb_, const float* f) { kb = kb_; fk = f; }
  DEVI bool ok(int qt, int kl) const { return kb * 64 + kl <= tq0 + qt * 16; }
  DEVI f32x4 bias4(int kl0) const { float4 v = *(const float4*)&fk[kl0]; return f32x4{-v.x, -v.y, -v.z, -v.w}; }
};

DEVI void fox_tile(const Params& p, int item, char* smem) {
  const int tid = opaque_tid(), lane = tid & 63, wid = tid >> 6, fr = lane & 15, fq = lane >> 4;
  int qblk = 63 - (item >> 6), bh = item & 63, b = bh >> 3, h = bh & 7;
  int q0 = qblk * 128 + wid * 32;
  const bf16_t* Y = (const bf16_t*)(gws(p) + OFF_Y) + (size_t)b * S_ * YE_LD;
  const float* F = (const float*)(gws(p) + OFF_MISC + MS_FOXF) + (size_t)bh * S_;
  bf16x8 qf[2][2];
  FoxPol pol;
#pragma unroll
  for (int qt = 0; qt < 2; qt++) {
    int t = q0 + qt * 16 + fr;
#pragma unroll
    for (int kk = 0; kk < 2; kk++) qf[qt][kk] = *(const bf16x8*)(Y + (size_t)t * YE_LD + h * 64 + kk * 32 + fq * 8);
  }
  pol.tq0 = q0 + fr; pol.qmin = q0; pol.qmax = q0 + 31; pol.sc = 0.125f * LOG2E; pol.kb = 0; pol.fk = nullptr;
  f32x4 o[4][2]; zero_o<2>(o);
  float m[2] = {NEGF, NEGF}, l[2] = {0.f, 0.f};
  float qn2 = 0.f;
#pragma unroll
  for (int qt = 0; qt < 2; qt++) {
    float ss = 0.f;
#pragma unroll
    for (int kk = 0; kk < 2; kk++)
#pragma unroll
      for (int e = 0; e < 8; e++) { float v = bf2f((bf16_t)qf[qt][kk][e]); ss += v * v; }
    ss += __shfl_xor(ss, 16); ss += __shfl_xor(ss, 32);
    qn2 = fmaxf(qn2, ss);
  }
#pragma unroll
  for (int o = 8; o >= 1; o >>= 1) qn2 = fmaxf(qn2, __shfl_xor(qn2, o));
  float* red = (float*)(smem + SM_BOR);
  if (lane == 0) red[wid] = qn2;
  __syncthreads();
  qn2 = fmaxf(fmaxf(red[0], red[1]), fmaxf(red[2], red[3]));
  float kmax2 = ((const float*)(gws(p) + OFF_MISC + MS_KMAX))[bh];
  float qkmax = sqrtf(qn2 * kmax2) * pol.sc * 1.001f;
  float thr = -(128.f + 2.f * qkmax);
  int nt = qblk * 2 + 2;
  float fq0 = F[qblk * 128];
  u64 mlo, mhi;
  {
    int k0 = lane, k1 = lane + 64;
    bool n0 = (k0 < nt) && (k0 >= nt - 2 || fq0 - F[k0 * 64 + 63] >= thr);
    bool n1 = (k1 < nt) && (k1 >= nt - 2 || fq0 - F[(k1 < 128 ? k1 : 127) * 64 + 63] >= thr);
    mlo = __ballot(n0); mhi = __ballot(n1);
  }
  const bf16_t* vT = (const bf16_t*)(gws(p) + OFF_Y + 448 * MiB) + ((size_t)b * 512 + h * 64) * S_;
  attn_core<0, 2>(pol, smem, qf, Y + 512 + h * 64, YE_LD, vT, S_, F, mlo, mhi, o, m, l, nullptr);
  bf16_t* mix = (bf16_t*)(gws(p) + OFF_MIX) + (size_t)b * S_ * 1024;
#pragma unroll
  for (int qt = 0; qt < 2; qt++) {
    float lt = l[qt]; lt += __shfl_xor(lt, 16); lt += __shfl_xor(lt, 32);
    float inv = 1.f / lt;
#pragma unroll
    for (int dt = 0; dt < 4; dt++) {
      f32x4 v = o[dt][qt];
      *(uint2*)(mix + (size_t)(pol.tq0 + qt * 16) * 1024 + h * 64 + dt * 16 + fq * 4) = make_uint2(pack2(v[0] * inv, v[1] * inv), pack2(v[2] * inv, v[3] * inv));
    }
  }
}

DEVI void emit_afrag(const bf16_t* st, int ld, int nrt, int nkk, char* gdst) {
  for (int c = opaque_tid(); c < nrt * nkk * 64; c += 256) {
    int ln = c & 63, rk = c >> 6, rt = rk / nkk, kk = rk % nkk;
    int row = rt * 16 + (ln & 15), k0 = kk * 32 + (ln >> 4) * 4;
    uint2 a = *(const uint2*)&st[row * ld + k0], b = *(const uint2*)&st[row * ld + k0 + 16];
    *(uint4*)(gdst + (size_t)c * 16) = make_uint4(a.x, a.y, b.x, b.y);
  }
}

DEVI void gdn_pre_tile(const Params& p, int chunk, char* smem) {
  const int tid = opaque_tid(), lane = tid & 63, wid = tid >> 6, fr = lane & 15, fq = lane >> 4;
  int n = chunk & 127, h = (chunk >> 7) & 3, b = chunk >> 9;
  size_t tok0 = (size_t)b * S_ + n * 64;
  bf16_t* qn = (bf16_t*)smem;
  bf16_t* kn = (bf16_t*)(smem + 17408);
  bf16_t* vs = (bf16_t*)(smem + 34816);
  float* L = (float*)(smem + 53248);
  float* sbeta = (float*)(smem + 69632);
  float* sgc = sbeta + 64; float* seg = sbeta + 128; float* sbe = sbeta + 192;
  const bf16_t* Y = (const bf16_t*)(gws(p) + OFF_Y);
  const float* ysm = (const float*)(gws(p) + OFF_SM);
  char* gbase = gws(p) + OFF_X + (size_t)chunk * GDN_CH_BYTES;
  if (tid < 64) {
    float gb = ysm[(tok0 + tid) * 32 + 8 + h], ga = ysm[(tok0 + tid) * 32 + 12 + h];
    float beta = sigmoidf_(gb);
    float g = -expf(gin(p, 7)[h]) * softplusf_(ga + gin(p, 8)[h]);
    float gc = g;
#pragma unroll
    for (int o = 1; o < 64; o <<= 1) { float t = __shfl_up(gc, o); if (lane >= o) gc += t; }
    float eg = expf(gc);
    sbeta[tid] = beta; sgc[tid] = gc; seg[tid] = eg; sbe[tid] = beta * eg;
    if (tid == 63) ((float*)(gws(p) + OFF_MISC + MS_EGL))[chunk] = eg;
  }
  {
    int dc = tid & 15, tg = tid >> 4, d0 = dc * 8;
#pragma unroll 1
    for (int mat = 0; mat < 3; mat++) {
      int col = 1536 + mat * 512 + h * 128 + d0;
      int cch = mat * 512 + h * 128 + d0;
      float w[4][8];
#pragma unroll
      for (int j = 0; j < 4; j++)
#pragma unroll
        for (int e = 0; e < 8; e++) w[j][e] = gin(p, 6)[j * 1536 + cch + e];
      uint4 xr[7];
#pragma unroll
      for (int i = 0; i < 7; i++) {
        int lt = tg * 4 - 3 + i;
        if (n * 64 + lt >= 0) xr[i] = *(const uint4*)(Y + (tok0 + lt) * YE_LD + col); else xr[i] = make_uint4(0, 0, 0, 0);
      }
#pragma unroll
      for (int tt = 0; tt < 4; tt++) {
        float x[8];
#pragma unroll
        for (int e = 0; e < 8; e++) x[e] = 0.f;
#pragma unroll
        for (int j = 0; j < 4; j++) {
          uint4 v = xr[tt + j];
          x[0] += w[j][0] * lo2f(v.x); x[1] += w[j][1] * hi2f(v.x); x[2] += w[j][2] * lo2f(v.y); x[3] += w[j][3] * hi2f(v.y);
          x[4] += w[j][4] * lo2f(v.z); x[5] += w[j][5] * hi2f(v.z); x[6] += w[j][6] * lo2f(v.w); x[7] += w[j][7] * hi2f(v.w);
        }
        float ss = 0.f;
#pragma unroll
        for (int e = 0; e < 8; e++) { x[e] = x[e] * sigmoidf_(x[e]); ss += x[e] * x[e]; }
        float sc = 1.f;
        if (mat < 2) {
          ss += __shfl_xor(ss, 1); ss += __shfl_xor(ss, 2); ss += __shfl_xor(ss, 4); ss += __shfl_xor(ss, 8);
          sc = rsqrtf(ss + 1e-6f) * (mat == 0 ? 0.08838834764831845f : 1.f);
        }
        bf16_t* dst = (mat == 0 ? qn : (mat == 1 ? kn : vs)) + (tg * 4 + tt) * 136 + d0;
        *(uint4*)dst = make_uint4(pack2(x[0] * sc, x[1] * sc), pack2(x[2] * sc, x[3] * sc), pack2(x[4] * sc, x[5] * sc), pack2(x[6] * sc, x[7] * sc));
      }
    }
  }
  __syncthreads();
  {
    bf16x8 ka[4], qa[4];
#pragma unroll
    for (int kk = 0; kk < 4; kk++) {
      ka[kk] = *(const bf16x8*)&kn[(wid * 16 + fr) * 136 + kk * 32 + fq * 8];
      qa[kk] = *(const bf16x8*)&qn[(wid * 16 + fr) * 136 + kk * 32 + fq * 8];
    }
#pragma unroll
    for (int ct = 0; ct < 4; ct++) {
      f32x4 aL = {0.f, 0.f, 0.f, 0.f}, aA = {0.f, 0.f, 0.f, 0.f};
#pragma unroll
      for (int kk = 0; kk < 4; kk++) {
        bf16x8 kb = *(const bf16x8*)&kn[(ct * 16 + fr) * 136 + kk * 32 + fq * 8];
        aL = mfma16(ka[kk], kb, aL);
        aA = mfma16(qa[kk], kb, aA);
      }
      int j = ct * 16 + fr;
      float gj = sgc[j];
#pragma unroll
      for (int r = 0; r < 4; r++) {
        int i = wid * 16 + fq * 4 + r;
        float dec = (i >= j) ? expf(sgc[i] - gj) : 0.f;
        L[i * 64 + j] = (i > j) ? sbeta[i] * aL[r] * dec : 0.f;
        float av = aA[r] * dec;
        int kk2 = j >> 5, within = j & 31, tt = within >> 4, qd = (within & 15) >> 2, jj = within & 3;
        int ln = qd * 16 + (i & 15);
        *(bf16_t*)(gbase + 49152 + ((size_t)((wid * 2 + kk2) * 64 + ln)) * 16 + (tt * 4 + jj) * 2) = f2bf(av);
      }
    }
  }
  __syncthreads();
  float x[64];
  {
    const int c = tid;
    const bf16_t* rsrc = (c < 128) ? (vs + c) : (kn + (c - 128));
    const float* rsc = (c < 128) ? sbeta : sbe;
#pragma unroll
    for (int i = 0; i < 64; i++) {
      float r = bf2f(rsrc[i * 136]) * rsc[i];
#pragma unroll
      for (int j4 = 0; j4 < (i + 3) / 4; j4++) {
        float4 lv = *(const float4*)&L[i * 64 + j4 * 4];
        if (j4 * 4 + 0 < i) r -= lv.x * x[j4 * 4 + 0];
        if (j4 * 4 + 1 < i) r -= lv.y * x[j4 * 4 + 1];
        if (j4 * 4 + 2 < i) r -= lv.z * x[j4 * 4 + 2];
        if (j4 * 4 + 3 < i) r -= lv.w * x[j4 * 4 + 3];
      }
      x[i] = r;
    }
  }
  __syncthreads();
  if (tid >= 128) {
#pragma unroll
    for (int i = 0; i < 64; i++) vs[i * 136 + (tid - 128)] = f2bf(x[i]);
  }
  __syncthreads();
  emit_afrag(vs, 136, 4, 4, gbase);
  __syncthreads();
  if (tid < 128) {
#pragma unroll
    for (int i = 0; i < 64; i++) vs[i * 136 + tid] = f2bf(x[i]);
  }
  __syncthreads();
  for (int c = tid; c < 2048; c += 256) {
    int ln = c & 63, rt = (c >> 6) & 3, ds = c >> 8;
    int row = rt * 16 + (ln >> 4) * 4, col = ds * 16 + (ln & 15);
    unsigned a = (unsigned)vs[row * 136 + col] | ((unsigned)vs[(row + 1) * 136 + col] << 16);
    unsigned bq = (unsigned)vs[(row + 2) * 136 + col] | ((unsigned)vs[(row + 3) * 136 + col] << 16);
    *(uint2*)(gbase + 57344 + (size_t)c * 8) = make_uint2(a, bq);
  }
  __syncthreads();
  for (int e = tid; e < 64 * 128; e += 256) { int i = e >> 7, d = e & 127; vs[i * 136 + d] = f2bf(bf2f(qn[i * 136 + d]) * seg[i]); }
  __syncthreads();
  emit_afrag(vs, 136, 4, 4, gbase + 16384);
  __syncthreads();
  {
    float gl = sgc[63];
    for (int e = tid; e < 64 * 128; e += 256) { int j = e >> 7, d = e & 127; vs[d * 72 + j] = f2bf(bf2f(kn[j * 136 + d]) * expf(gl - sgc[j])); }
  }
  __syncthreads();
  emit_afrag(vs, 72, 8, 2, gbase + 32768);
  __syncthreads();
}

DEVI void gdn_scan_item(const Params& p, int item, char* smem) {
  const int tid = opaque_tid(), lane = tid & 63, wid = tid >> 6, fr = lane & 15, fq = lane >> 4;
  int bh = item >> 1, half = item & 1, ds = half * 4 + wid, b = bh >> 2, h = bh & 3;
  const float* eglp = (const float*)(gws(p) + OFF_MISC + MS_EGL) + bh * 128;
  bf16_t* Yo = (bf16_t*)(gws(p) + OFF_Y) + (size_t)b * S_ * YE_LD + 1536 + h * 128 + ds * 16 + fr;
  char* bufA = smem;
  char* bufB = smem + 32768;
  const char* gbase = gws(p) + OFF_X + (size_t)(bh * 128) * GDN_CH_BYTES;
  uint4 ra0, ra1, ra2, ra3, ra4, ra5, ra6, ra7, rb0, rb1, rb2, rb3, rb4, rb5, rb6, rb7;
#define SCAN_GLOAD(n) do { const char* cb = gbase + (size_t)(n) * GDN_CH_BYTES; \
    ra0 = GLD16(cb + (size_t)(tid + 0) * 16); \
    ra1 = GLD16(cb + (size_t)(tid + 256) * 16); \
    ra2 = GLD16(cb + (size_t)(tid + 512) * 16); \
    ra3 = GLD16(cb + (size_t)(tid + 768) * 16); \
    ra4 = GLD16(cb + (size_t)(tid + 1024) * 16); \
    ra5 = GLD16(cb + (size_t)(tid + 1280) * 16); \
    ra6 = GLD16(cb + (size_t)(tid + 1536) * 16); \
    ra7 = GLD16(cb + (size_t)(tid + 1792) * 16); \
    rb0 = GLD16(cb + 32768 + (size_t)(tid + 0) * 16); \
    rb1 = GLD16(cb + 32768 + (size_t)(tid + 256) * 16); \
    rb2 = GLD16(cb + 32768 + (size_t)(tid + 512) * 16); \
    rb3 = GLD16(cb + 32768 + (size_t)(tid + 768) * 16); \
    rb4 = GLD16(cb + 32768 + (size_t)(tid + 1024) * 16); \
    rb5 = GLD16(cb + 32768 + (size_t)(tid + 1280) * 16); \
    rb6 = GLD16(cb + 57344 + half * 8192 + (size_t)(tid + 0) * 16); \
    rb7 = GLD16(cb + 57344 + half * 8192 + (size_t)(tid + 256) * 16); \
  } while (0)
#define SCAN_SSTORE() do { \
    *(uint4*)(bufA + (tid + 0) * 16) = ra0; *(uint4*)(bufB + (tid + 0) * 16) = rb0; \
    *(uint4*)(bufA + (tid + 256) * 16) = ra1; *(uint4*)(bufB + (tid + 256) * 16) = rb1; \
    *(uint4*)(bufA + (tid + 512) * 16) = ra2; *(uint4*)(bufB + (tid + 512) * 16) = rb2; \
    *(uint4*)(bufA + (tid + 768) * 16) = ra3; *(uint4*)(bufB + (tid + 768) * 16) = rb3; \
    *(uint4*)(bufA + (tid + 1024) * 16) = ra4; *(uint4*)(bufB + (tid + 1024) * 16) = rb4; \
    *(uint4*)(bufA + (tid + 1280) * 16) = ra5; *(uint4*)(bufB + (tid + 1280) * 16) = rb5; \
    *(uint4*)(bufA + (tid + 1536) * 16) = ra6; *(uint4*)(bufB + (tid + 1536) * 16) = rb6; \
    *(uint4*)(bufA + (tid + 1792) * 16) = ra7; *(uint4*)(bufB + (tid + 1792) * 16) = rb7; \
  } while (0)
  SCAN_GLOAD(0);
  SCAN_SSTORE();
  __syncthreads();
  f32x4 S[8];
#pragma unroll
  for (int i = 0; i < 8; i++) S[i] = f32x4{0.f, 0.f, 0.f, 0.f};
#pragma unroll 1
  for (int n = 0; n < 128; n++) {
    if (n + 1 < 128) SCAN_GLOAD(n + 1);
    float egl = eglp[n];
    bf16x8 sb[4];
#pragma unroll
    for (int kk = 0; kk < 4; kk++)
      sb[kk] = mk8(pack2(S[2 * kk][0], S[2 * kk][1]), pack2(S[2 * kk][2], S[2 * kk][3]), pack2(S[2 * kk + 1][0], S[2 * kk + 1][1]), pack2(S[2 * kk + 1][2], S[2 * kk + 1][3]));
    f32x4 vn[4], oo[4];
#pragma unroll
    for (int rt = 0; rt < 4; rt++) {
      f32x4 acc = {0.f, 0.f, 0.f, 0.f};
#pragma unroll
      for (int kk = 0; kk < 4; kk++) acc = mfma16(*(const bf16x8*)(bufA + ((rt * 4 + kk) * 64 + lane) * 16), sb[kk], acc);
      uint2 uu = *(const uint2*)(bufB + 24576 + ((wid * 4 + rt) * 64 + lane) * 8);
      vn[rt] = f32x4{lo2f(uu.x) - acc[0], hi2f(uu.x) - acc[1], lo2f(uu.y) - acc[2], hi2f(uu.y) - acc[3]};
    }
#pragma unroll
    for (int rt = 0; rt < 4; rt++) {
      f32x4 acc = {0.f, 0.f, 0.f, 0.f};
#pragma unroll
      for (int kk = 0; kk < 4; kk++) acc = mfma16(*(const bf16x8*)(bufA + 16384 + ((rt * 4 + kk) * 64 + lane) * 16), sb[kk], acc);
      oo[rt] = acc;
    }
    bf16x8 vb[2];
#pragma unroll
    for (int k2 = 0; k2 < 2; k2++)
      vb[k2] = mk8(pack2(vn[2 * k2][0], vn[2 * k2][1]), pack2(vn[2 * k2][2], vn[2 * k2][3]), pack2(vn[2 * k2 + 1][0], vn[2 * k2 + 1][1]), pack2(vn[2 * k2 + 1][2], vn[2 * k2 + 1][3]));
#pragma unroll
    for (int rt = 0; rt < 4; rt++)
#pragma unroll
      for (int k2 = 0; k2 < 2; k2++) oo[rt] = mfma16(*(const bf16x8*)(bufB + 16384 + ((rt * 2 + k2) * 64 + lane) * 16), vb[k2], oo[rt]);
#pragma unroll
    for (int dk = 0; dk < 8; dk++) {
      f32x4 acc = S[dk] * egl;
#pragma unroll
      for (int k2 = 0; k2 < 2; k2++) acc = mfma16(*(const bf16x8*)(bufB + ((dk * 2 + k2) * 64 + lane) * 16), vb[k2], acc);
      S[dk] = acc;
    }
#pragma unroll
    for (int rt = 0; rt < 4; rt++)
#pragma unroll
      for (int r = 0; r < 4; r++) Yo[(size_t)(n * 64 + rt * 16 + fq * 4 + r) * YE_LD] = f2bf(oo[rt][r]);
    __syncthreads();
    if (n + 1 < 128) SCAN_SSTORE();
    __syncthreads();
  }
#undef SCAN_GLOAD
#undef SCAN_SSTORE
}

DEVI void phase_gdn_post(const Params& p) {
  int lane = opaque_tid() & 63;
  int gw = blockIdx.x * 4 + (opaque_tid() >> 6), nw = gridDim.x * 4;
  const bf16_t* Y = (const bf16_t*)(gws(p) + OFF_Y);
  bf16_t* mix = (bf16_t*)(gws(p) + OFF_MIX);
  int c0 = lane * 8;
  float nwv[8];
#pragma unroll
  for (int e = 0; e < 8; e++) nwv[e] = gin(p, 9)[(c0 & 127) + e];
  for (int row = gw; row < M_; row += nw) {
    uint4 ov = *(const uint4*)(Y + (size_t)row * YE_LD + 1536 + c0);
    uint4 zv = *(const uint4*)(Y + (size_t)row * YE_LD + 3072 + c0);
    float o[8] = {lo2f(ov.x), hi2f(ov.x), lo2f(ov.y), hi2f(ov.y), lo2f(ov.z), hi2f(ov.z), lo2f(ov.w), hi2f(ov.w)};
    float z[8] = {lo2f(zv.x), hi2f(zv.x), lo2f(zv.y), hi2f(zv.y), lo2f(zv.z), hi2f(zv.z), lo2f(zv.w), hi2f(zv.w)};
    float ss = 0.f;
#pragma unroll
    for (int e = 0; e < 8; e++) ss += o[e] * o[e];
    ss += __shfl_xor(ss, 1); ss += __shfl_xor(ss, 2); ss += __shfl_xor(ss, 4); ss += __shfl_xor(ss, 8);
    float rs = rsqrtf(ss * (1.f / 128.f) + 1e-6f);
    float r[8];
#pragma unroll
    for (int e = 0; e < 8; e++) r[e] = o[e] * rs * nwv[e] * (z[e] * sigmoidf_(z[e]));
    *(uint4*)(mix + (size_t)row * 1024 + 512 + c0) = make_uint4(pack2(r[0], r[1]), pack2(r[2], r[3]), pack2(r[4], r[5]), pack2(r[6], r[7]));
  }
}

struct ALoadCmp {
  const bf16_t* Y; const float* pe; int mt; int col0; int lr, lc;
  DEVI void init(int lr_, int lc_) { lr = lr_; lc = lc_; }
  DEVI uint4 load(int i, int kin) const {
    int row = lr + i * 32, k = kin + lc;
    int R = mt * 128 + row; if (R > 8175) R = 8175;
    int bn = R >> 1, g = R & 1, b = bn / 511, n = bn - b * 511;
    int l = k >> 6, d = k & 63;
    uint4 v = *(const uint4*)(Y + ((size_t)b * S_ + 16 * n + l) * YO_LD + col0 + g * 64 + d);
    const float4* pp = (const float4*)(pe + l * 64 + d);
    float4 p0 = pp[0], p1 = pp[1];
    return make_uint4(pack2(lo2f(v.x) + p0.x, hi2f(v.x) + p0.y), pack2(lo2f(v.y) + p0.z, hi2f(v.y) + p0.w),
                      pack2(lo2f(v.z) + p1.x, hi2f(v.z) + p1.y), pack2(lo2f(v.w) + p1.z, hi2f(v.w) + p1.w));
  }
};
DEVI void cmp_tile(const Params& p, int tile, char* smem) {
  const int tid = opaque_tid(), lane = tid & 63, wid = tid >> 6, wr = wid >> 1, wc = wid & 1, fr = lane & 15, fq = lane >> 4;
  int kv = tile >> 6, mt = tile & 63;
  const bf16_t* WT = (const bf16_t*)(gws(p) + OFF_WT);
  ALoadCmp al{(const bf16_t*)(gws(p) + OFF_Y), gin(p, kv ? 16 : 13), mt, kv ? 640 : 512, 0, 0};
  f32x4 acc[4][4]; zero_acc(acc);
  gemm_mainloop<false>(al, WT + (kv ? WT_CV1 : WT_CK1), 2048, 2048, smem, acc);
  bf16_t* hid = (bf16_t*)smem;
  bf16_t* w2 = (bf16_t*)(smem + 34816);
#pragma unroll
  for (int i = 0; i < 4; i++)
#pragma unroll
    for (int j = 0; j < 4; j++)
#pragma unroll
      for (int r = 0; r < 4; r++) hid[(wr * 64 + i * 16 + fq * 4 + r) * 136 + wc * 64 + j * 16 + fr] = f2bf(gelu_tanh(acc[i][j][r]));
  const bf16_t* w2g = WT + (kv ? WT_CV2 : WT_CK2);
  for (int c = tid; c < 1024; c += 256) { int row = c >> 4, ch = (c & 15) * 8; *(uint4*)&w2[row * 136 + ch] = *(const uint4*)(w2g + row * 128 + ch); }
  __syncthreads();
  f32x4 a2[2][4];
#pragma unroll
  for (int i = 0; i < 2; i++)
#pragma unroll
    for (int j = 0; j < 4; j++) a2[i][j] = f32x4{0.f, 0.f, 0.f, 0.f};
#pragma unroll
  for (int kk = 0; kk < 4; kk++) {
    bf16x8 af[2], bfv[4];
#pragma unroll
    for (int i = 0; i < 2; i++) af[i] = *(const bf16x8*)&hid[(wid * 32 + i * 16 + fr) * 136 + kk * 32 + fq * 8];
#pragma unroll
    for (int j = 0; j < 4; j++) bfv[j] = *(const bf16x8*)&w2[(j * 16 + fr) * 136 + kk * 32 + fq * 8];
#pragma unroll
    for (int i = 0; i < 2; i++)
#pragma unroll
      for (int j = 0; j < 4; j++) a2[i][j] = mfma16(af[i], bfv[j], a2[i][j]);
  }
  bf16_t* kc = (bf16_t*)(gws(p) + OFF_MISC + MS_KCMP);
  bf16_t* vc = (bf16_t*)(gws(p) + OFF_MISC + MS_VCMPT);
#pragma unroll
  for (int i = 0; i < 2; i++)
#pragma unroll
    for (int r = 0; r < 4; r++) {
      int R = mt * 128 + wid * 32 + i * 16 + fq * 4 + r;
      if (R < 8176) {
        int bn = R >> 1, g = R & 1, b = bn / 511, n = bn - b * 511;
#pragma unroll
        for (int j = 0; j < 4; j++) {
          int d = j * 16 + fr;
          if (kv == 0) kc[(((size_t)b * 512 + n) * 2 + g) * 64 + d] = f2bf(a2[i][j][r]);
          else vc[(((size_t)b * 2 + g) * 64 + d) * 512 + n] = f2bf(a2[i][j][r]);
        }
      }
    }
  __syncthreads();
}

template <bool OUT>
DEVI void rglru_tile(const Params& p, int tile, char* smem) {
  const int tid = opaque_tid(), lane = tid & 63, wid = tid >> 6, fr = lane & 15, fq = lane >> 4;
  int nb = tile & 7, seg = (tile >> 3) & 127, b = tile >> 10;
  size_t tok0 = (size_t)b * S_ + seg * 64;
  float* xs = (float*)smem;
  bf16_t* xb = (bf16_t*)(smem + 16640);
  float* as = (float*)(smem + 25856);
  float* bs = (float*)(smem + 42496);
  const bf16_t* Y = (const bf16_t*)(gws(p) + OFF_Y);
  float* agg = (float*)(gws(p) + OFF_MISC + MS_RGAGG);
  {
    int t = tid >> 2, c0 = (tid & 3) * 16, ch = nb * 64 + c0;
    float x[16];
#pragma unroll
    for (int e = 0; e < 16; e++) x[e] = gin(p, 20)[ch + e];
#pragma unroll
    for (int j = 0; j < 4; j++) {
      int lt = t - 3 + j;
      if (seg * 64 + lt >= 0) {
        const uint4* src = (const uint4*)(Y + (tok0 + lt) * YO_LD + 1792 + ch);
        uint4 v0 = src[0], v1 = src[1];
        const float* w = gin(p, 19) + j * 512 + ch;
        x[0] += w[0] * lo2f(v0.x); x[1] += w[1] * hi2f(v0.x); x[2] += w[2] * lo2f(v0.y); x[3] += w[3] * hi2f(v0.y);
        x[4] += w[4] * lo2f(v0.z); x[5] += w[5] * hi2f(v0.z); x[6] += w[6] * lo2f(v0.w); x[7] += w[7] * hi2f(v0.w);
        x[8] += w[8] * lo2f(v1.x); x[9] += w[9] * hi2f(v1.x); x[10] += w[10] * lo2f(v1.y); x[11] += w[11] * hi2f(v1.y);
        x[12] += w[12] * lo2f(v1.z); x[13] += w[13] * hi2f(v1.z); x[14] += w[14] * lo2f(v1.w); x[15] += w[15] * hi2f(v1.w);
      }
    }
#pragma unroll
    for (int e = 0; e < 16; e++) { xs[t * 65 + c0 + e] = x[e]; xb[t * 72 + c0 + e] = f2bf(x[e]); }
  }
  __syncthreads();
  {
    const bf16_t* WT = (const bf16_t*)(gws(p) + OFF_WT);
    const bf16_t* wa = WT + WT_RGA + nb * 4096;
    const bf16_t* wx = WT + WT_RGX + nb * 4096;
    bf16x8 af[2];
#pragma unroll
    for (int kk = 0; kk < 2; kk++) af[kk] = *(const bf16x8*)&xb[(wid * 16 + fr) * 72 + kk * 32 + fq * 8];
#pragma unroll
    for (int j = 0; j < 4; j++) {
      f32x4 aA = {0.f, 0.f, 0.f, 0.f}, aX = {0.f, 0.f, 0.f, 0.f};
#pragma unroll
      for (int kk = 0; kk < 2; kk++) {
        aA = mfma16(af[kk], *(const bf16x8*)(wa + (j * 16 + fr) * 64 + kk * 32 + fq * 8), aA);
        aX = mfma16(af[kk], *(const bf16x8*)(wx + (j * 16 + fr) * 64 + kk * 32 + fq * 8), aX);
      }
      int c = j * 16 + fr, chn = nb * 64 + c;
      float ba = gin(p, 22)[chn], bx = gin(p, 24)[chn];
      float spl = softplusf_(-gin(p, 25)[chn]);
#pragma unroll
      for (int r = 0; r < 4; r++) {
        int t = wid * 16 + fq * 4 + r;
        float rr = sigmoidf_(aA[r] + ba), ig = sigmoidf_(aX[r] + bx);
        float la = -8.f * spl * rr;
        as[t * 65 + c] = expf(la);
        bs[t * 65 + c] = sqrtf(-expm1f(2.f * la)) * ig * xs[t * 65 + c];
      }
    }
  }
  __syncthreads();
  if (!OUT) {
    {
      int c = tid & 63, part = tid >> 6;
      float A = 1.f, Bv = 0.f;
#pragma unroll
      for (int t = 0; t < 16; t++) { float a = as[(part * 16 + t) * 65 + c]; Bv = a * Bv + bs[(part * 16 + t) * 65 + c]; A *= a; }
      float2* cw2 = (float2*)(smem + 61184);
      cw2[part * 64 + c] = make_float2(A, Bv);
      __syncthreads();
      if (tid < 64) {
        float At = 1.f, Bt = 0.f;
#pragma unroll
        for (int pp = 0; pp < 4; pp++) { float2 ab = cw2[pp * 64 + tid]; Bt = ab.x * Bt + ab.y; At *= ab.x; }
        float2* dst = (float2*)agg + ((size_t)(b * 128 + seg) * 512 + nb * 64 + tid);
        *dst = make_float2(At, Bt);
      }
    }
  } else {
    {
      int c = tid & 63, part = tid >> 6;
      int per = (seg + 3) >> 2, s_lo = part * per, s_hi = min(seg, s_lo + per);
      const float2* src = (const float2*)agg + ((size_t)(b * 128) * 512 + nb * 64 + c);
      float A = 1.f, Bv = 0.f;
#pragma unroll 8
      for (int s2 = s_lo; s2 < s_hi; s2++) { float2 ab = src[(size_t)s2 * 512]; Bv = ab.x * Bv + ab.y; A *= ab.x; }
      float2* cw = (float2*)(smem + 59136);
      cw[part * 64 + c] = make_float2(A, Bv);
    }
    __syncthreads();
    {
      int c = tid & 63, part = tid >> 6;
      float A = 1.f, Bv = 0.f;
#pragma unroll
      for (int t = 0; t < 16; t++) { float a = as[(part * 16 + t) * 65 + c]; Bv = a * Bv + bs[(part * 16 + t) * 65 + c]; A *= a; }
      float2* cw2 = (float2*)(smem + 61184);
      cw2[part * 64 + c] = make_float2(A, Bv);
      __syncthreads();
      const float2* cw = (const float2*)(smem + 59136);
      float hh = 0.f;
#pragma unroll
      for (int pp = 0; pp < 4; pp++) { float2 ab = cw[pp * 64 + c]; hh = ab.x * hh + ab.y; }
      for (int pp = 0; pp < part; pp++) { float2 ab = cw2[pp * 64 + c]; hh = ab.x * hh + ab.y; }
#pragma unroll
      for (int t = 0; t < 16; t++) { int ti = (part * 16 + t) * 65 + c; hh = as[ti] * hh + bs[ti]; bs[ti] = hh; }
    }
    __syncthreads();
    int t = tid >> 2, c0 = (tid & 3) * 16, ch = nb * 64 + c0;
    const uint4* gsrc = (const uint4*)(Y + (tok0 + t) * YO_LD + 1280 + ch);
    uint4 g0 = gsrc[0], g1 = gsrc[1];
    float gv[16] = {lo2f(g0.x), hi2f(g0.x), lo2f(g0.y), hi2f(g0.y), lo2f(g0.z), hi2f(g0.z), lo2f(g0.w), hi2f(g0.w),
                    lo2f(g1.x), hi2f(g1.x), lo2f(g1.y), hi2f(g1.y), lo2f(g1.z), hi2f(g1.z), lo2f(g1.w), hi2f(g1.w)};
    float yv[16];
#pragma unroll
    for (int e = 0; e < 16; e++) yv[e] = bs[t * 65 + c0 + e] * gelu_tanh(gv[e]);
    uint4* dst = (uint4*)((bf16_t*)(gws(p) + OFF_MIX) + (tok0 + t) * 1024 + 512 + ch);
    dst[0] = make_uint4(pack2(yv[0], yv[1]), pack2(yv[2], yv[3]), pack2(yv[4], yv[5]), pack2(yv[6], yv[7]));
    dst[1] = make_uint4(pack2(yv[8], yv[9]), pack2(yv[10], yv[11]), pack2(yv[12], yv[13]), pack2(yv[14], yv[15]));
  }
  __syncthreads();
}

template <int BR>
struct NsaPol {
  static constexpr bool UB = true;
  int t; int tmin; int kb; const u64* selq; const u64* worq; float sc; bool selbit;
  DEVI float lane_bias() const { return (BR == 1 && !selbit) ? NEGF : 0.f; }
  DEVI bool active(int kb_) const {
    if (BR == 1) return (worq[kb_ >> 6] >> (kb_ & 63)) & 1;
    return true;
  }
  DEVI bool masked(int kb_) const {
    if (BR == 2) return !((kb_ * 64 + 63 <= tmin) && (tmin + 15 - kb_ * 64 < 512));
    if (BR == 1) return kb_ * 64 + 63 > tmin;
    return true;
  }
  DEVI void begin(int kb_, const float*) {
    kb = kb_;
    if (BR == 1) selbit = (selq[kb_ >> 6] >> (kb_ & 63)) & 1;
  }
  DEVI bool ok(int qt, int kl) const {
    int key = kb * 64 + kl;
    if (BR == 0) return (16 * key + 31 <= t) && (key < 511);
    if (BR == 1) return selbit && (key <= t);
    return (key <= t) && (t - key < 512);
  }
  DEVI f32x4 bias4(int) const { return f32x4{0.f, 0.f, 0.f, 0.f}; }
};

DEVI void nsa_tile(const Params& p, int item, char* smem) {
  const int tid = opaque_tid(), lane = tid & 63, wid = tid >> 6, fr = lane & 15, fq = lane >> 4;
  const int qg = wid >> 1, hp = wid & 1;
  int qb = 255 - (item >> 4), bg = item & 15, b = bg >> 1, g = bg & 1;
  int q0 = qb * 32, cur = q0 >> 6;
  int t = q0 + qg * 16 + fr;
  size_t mrow = (size_t)b * S_ + t;
  const bf16_t* Y = (const bf16_t*)(gws(p) + OFF_Y) + (size_t)b * S_ * YO_LD;
  const float* ysm = (const float*)(gws(p) + OFF_SM) + mrow * 32;
  float* impw = (float*)(smem + SM_IMP) + wid * (16 * 132);
  float* otot = impw;
  u64* selm = (u64*)(smem + SM_SELM) + qg * 32;
  u64* bor = (u64*)(smem + SM_BOR);
  bf16x8 qf[2][2];
#pragma unroll
  for (int qt = 0; qt < 2; qt++)
#pragma unroll
    for (int kk = 0; kk < 2; kk++) qf[qt][kk] = *(const bf16x8*)(Y + (size_t)t * YO_LD + (g * 4 + hp * 2 + qt) * 64 + kk * 32 + fq * 8);
  for (int i = lane; i < 16 * 132; i += 64) impw[i] = 0.f;
  f32x4 o[4][2];
  float m[2], l[2];
  const float sc = 0.125f * LOG2E;
  {
    int nkv = (q0 / 16) / 64 + 1; if (nkv > 8) nkv = 8;
    u64 mlo = (1ull << nkv) - 1;
    const bf16_t* Kg = (const bf16_t*)(gws(p) + OFF_MISC + MS_KCMP) + (size_t)b * 512 * 128 + g * 64;
    const bf16_t* Vt = (const bf16_t*)(gws(p) + OFF_MISC + MS_VCMPT) + ((size_t)b * 2 + g) * 64 * 512;
    NsaPol<0> pol; pol.t = t; pol.tmin = q0 + qg * 16; pol.kb = 0; pol.sc = sc; pol.selq = nullptr; pol.worq = nullptr; pol.selbit = false;
#pragma unroll
    for (int qt = 0; qt < 2; qt++) { m[qt] = NEGF; l[qt] = 0.f; }
    zero_o<2>(o);
    attn_core<1, 2>(pol, smem, qf, Kg, 128, Vt, 512, nullptr, mlo, 0ull, o, m, l, nullptr);
#pragma unroll
    for (int qt = 0; qt < 2; qt++) { float lt = l[qt]; lt += __shfl_xor(lt, 16); lt += __shfl_xor(lt, 32); l[qt] = lt > 0.f ? 1.f / lt : 0.f; }
    attn_core<2, 2>(pol, smem, qf, Kg, 128, Vt, 512, nullptr, mlo, 0ull, o, m, l, impw);
  }
  __syncthreads();
  {
    float* ia = (float*)(smem + SM_IMP) + (qg * 2) * (16 * 132);
    const float* ib = ia + 16 * 132;
#pragma unroll 1
    for (int qq = 0; qq < 8; qq++) {
      int q = hp * 8 + qq;
      float* iv = ia + q * 132;
      const float* ivb = ib + q * 132;
      float v0 = iv[lane] + ivb[lane], v1 = iv[lane + 64] + ivb[lane + 64];
      int c0 = 0, c1 = 0;
      if (cur >= 16) {
        iv[lane] = (lane >= 1 && lane <= cur - 2) ? v0 : -1.f;
        iv[lane + 64] = (lane + 64 <= cur - 2) ? v1 : -1.f;
        if (lane < 4) iv[128 + lane] = -1.f;
        const int n4 = (cur + 2) >> 2;
        for (int m4 = 0; m4 < n4; m4++) {
          float4 x = *(const float4*)&iv[m4 * 4];
          int mb = m4 * 4;
          c0 += (x.x > v0) || (x.x == v0 && mb + 0 < lane);
          c0 += (x.y > v0) || (x.y == v0 && mb + 1 < lane);
          c0 += (x.z > v0) || (x.z == v0 && mb + 2 < lane);
          c0 += (x.w > v0) || (x.w == v0 && mb + 3 < lane);
          c1 += (x.x > v1) || (x.x == v1 && mb + 0 < lane + 64);
          c1 += (x.y > v1) || (x.y == v1 && mb + 1 < lane + 64);
          c1 += (x.z > v1) || (x.z == v1 && mb + 2 < lane + 64);
          c1 += (x.w > v1) || (x.w == v1 && mb + 3 < lane + 64);
        }
      }
      int m0 = lane, m1 = lane + 64;
      bool s0, s1;
      if (cur < 16) { s0 = m0 <= cur; s1 = false; }
      else {
        s0 = (m0 == 0) || (m0 == cur) || (m0 == cur - 1) || (m0 >= 1 && m0 <= cur - 2 && 3 + c0 < 16);
        s1 = (m1 == cur) || (m1 == cur - 1) || (m1 <= cur - 2 && 3 + c1 < 16);
      }
      u64 lo = __ballot(s0), hi = __ballot(s1);
      if (lane == 0) { selm[q * 2] = lo; selm[q * 2 + 1] = hi; }
    }
  }
  __syncthreads();
  {
    u64 wlo = selm[fr * 2], whi = selm[fr * 2 + 1];
#pragma unroll
    for (int off = 1; off < 16; off <<= 1) { wlo |= __shfl_xor(wlo, off); whi |= __shfl_xor(whi, off); }
    if (lane == 0) { bor[wid * 2] = wlo; bor[wid * 2 + 1] = whi; }
  }
#pragma unroll
  for (int dt = 0; dt < 4; dt++)
#pragma unroll
    for (int qt = 0; qt < 2; qt++) {
      f32x4 v = o[dt][qt]; float gg = sigmoidf_(ysm[(g * 4 + hp * 2 + qt) * 3 + 0]);
      otot[((dt * 2 + qt) * 2 + 0) * 64 + lane] = __uint_as_float(pack2(v[0] * gg, v[1] * gg));
      otot[((dt * 2 + qt) * 2 + 1) * 64 + lane] = __uint_as_float(pack2(v[2] * gg, v[3] * gg));
    }
  __syncthreads();
  u64 blo = bor[0] | bor[2] | bor[4] | bor[6], bhi = bor[1] | bor[3] | bor[5] | bor[7];
  {
    u64 clo = cur >= 63 ? ~0ull : ((1ull << (cur + 1)) - 1);
    u64 chi = cur < 64 ? 0ull : (cur >= 127 ? ~0ull : ((1ull << (cur - 63)) - 1));
    blo &= clo; bhi &= chi;
  }
  {
    NsaPol<1> pol; pol.t = t; pol.tmin = q0 + qg * 16; pol.kb = 0; pol.sc = sc; pol.selq = selm + fr * 2; pol.worq = bor + wid * 2; pol.selbit = false;
#pragma unroll
    for (int qt = 0; qt < 2; qt++) { m[qt] = NEGF; l[qt] = 0.f; }
    zero_o<2>(o);
    const bf16_t* Vt = (const bf16_t*)(gws(p) + OFF_Y + 288 * MiB) + ((size_t)b * 128 + g * 64) * S_;
    attn_core<0, 2>(pol, smem, qf, Y + 768 + g * 64, YO_LD, Vt, S_, nullptr, blo, bhi, o, m, l, nullptr);
#pragma unroll
    for (int qt = 0; qt < 2; qt++) {
      float lt = l[qt]; lt += __shfl_xor(lt, 16); lt += __shfl_xor(lt, 32);
      float sc2 = sigmoidf_(ysm[(g * 4 + hp * 2 + qt) * 3 + 1]) / lt;
#pragma unroll
      for (int dt = 0; dt < 4; dt++) {
        f32x4 v = o[dt][qt];
        unsigned a = __float_as_uint(otot[((dt * 2 + qt) * 2 + 0) * 64 + lane]), bq = __float_as_uint(otot[((dt * 2 + qt) * 2 + 1) * 64 + lane]);
        otot[((dt * 2 + qt) * 2 + 0) * 64 + lane] = __uint_as_float(pack2(lo2f(a) + v[0] * sc2, hi2f(a) + v[1] * sc2));
        otot[((dt * 2 + qt) * 2 + 1) * 64 + lane] = __uint_as_float(pack2(lo2f(bq) + v[2] * sc2, hi2f(bq) + v[3] * sc2));
      }
    }
  }
  {
    NsaPol<2> pol; pol.t = t; pol.tmin = q0 + qg * 16; pol.kb = 0; pol.sc = sc; pol.selq = nullptr; pol.worq = nullptr; pol.selbit = false;
#pragma unroll
    for (int qt = 0; qt < 2; qt++) { m[qt] = NEGF; l[qt] = 0.f; }
    zero_o<2>(o);
    int k0 = (q0 - 511) < 0 ? 0 : ((q0 - 511) >> 6);
    u64 wl = 0, wh = 0;
    for (int k = k0; k <= cur; k++) { if (k < 64) wl |= 1ull << k; else wh |= 1ull << (k - 64); }
    const bf16_t* Vt = (const bf16_t*)(gws(p) + OFF_Y + 304 * MiB) + ((size_t)b * 128 + g * 64) * S_;
    attn_core<0, 2>(pol, smem, qf, Y + 1024 + g * 64, YO_LD, Vt, S_, nullptr, wl, wh, o, m, l, nullptr);
    bf16_t* mix = (bf16_t*)(gws(p) + OFF_MIX) + mrow * 1024;
#pragma unroll
    for (int qt = 0; qt < 2; qt++) {
      float lt = l[qt]; lt += __shfl_xor(lt, 16); lt += __shfl_xor(lt, 32);
      float sc2 = sigmoidf_(ysm[(g * 4 + hp * 2 + qt) * 3 + 2]) / lt;
#pragma unroll
      for (int dt = 0; dt < 4; dt++) {
        f32x4 v = o[dt][qt];
        unsigned a = __float_as_uint(otot[((dt * 2 + qt) * 2 + 0) * 64 + lane]), bq = __float_as_uint(otot[((dt * 2 + qt) * 2 + 1) * 64 + lane]);
        *(uint2*)(mix + (g * 4 + hp * 2 + qt) * 64 + dt * 16 + fq * 4) =
            make_uint2(pack2(lo2f(a) + v[0] * sc2, hi2f(a) + v[1] * sc2), pack2(lo2f(bq) + v[2] * sc2, hi2f(bq) + v[3] * sc2));
      }
    }
  }
  __syncthreads();
}

DEVI int next_item(int* ctr, char* smem) {
  int* slot = (int*)(smem + SM_SLOT);
  __syncthreads();
  if (opaque_tid() == 0) *slot = atomicAdd(ctr, 1);
  __syncthreads();
  return *slot;
}

constexpr int NPHASE = 17;
DEVI void grid_bar(unsigned* ctr, unsigned target) {
  __syncthreads();
  if (threadIdx.x == 0) {
    __threadfence();
    __hip_atomic_fetch_add(ctr, 1u, __ATOMIC_RELAXED, __HIP_MEMORY_SCOPE_AGENT);
    while (__hip_atomic_load(ctr, __ATOMIC_RELAXED, __HIP_MEMORY_SCOPE_AGENT) < target) __builtin_amdgcn_s_sleep(8);
    __threadfence();
  }
  __syncthreads();
}
__global__ void __launch_bounds__(256, 2) mega(Params p, int ph0, int ph1) {
  extern __shared__ __attribute__((aligned(16))) char smem[];
  cg::grid_group grid = cg::this_grid();
  char* ws0 = p.ws;
#define PH(n, ...) if ((n) >= ph0 && (n) <= ph1) { \
    char* ws = ws0; asm volatile("" : "+s"(ws)); ws = as_global(ws); \
    const bf16_t* WT = (const bf16_t*)(ws + OFF_WT); bf16_t* hn = (bf16_t*)(ws + OFF_HN); bf16_t* Yb = (bf16_t*)(ws + OFF_Y); \
    bf16_t* mix = (bf16_t*)(ws + OFF_MIX); bf16_t* pbf = (bf16_t*)(ws + OFF_X); bf16_t* ppb = (bf16_t*)(ws + OFF_X + 32 * MiB); (void)ppb; int* ctr = (int*)(ws + OFF_MISC + MS_CTR); \
    Params* gp = (Params*)(ws + OFF_MISC + MS_PTAB); float* h = as_global(gp->out); \
    float* ss = (float*)(ws + OFF_MISC + MS_SS); bf16_t* hn2 = (bf16_t*)(ws + OFF_MIX); (void)ss; (void)hn2; (void)WT; (void)hn; (void)Yb; (void)mix; (void)pbf; (void)ctr; (void)h; \
    __VA_ARGS__ } if ((n) >= ph0 && (n) < ph1) grid.sync();
  PH(0, if (blockIdx.x == 0 && threadIdx.x < 34) gp->in[threadIdx.x] = p.in[threadIdx.x];
        if (blockIdx.x == 0 && threadIdx.x == 0) { gp->out = p.out; gp->ws = p.ws; gp->positions = p.positions; }
        phase_prep(p, smem); phase_xprep(p.in[0], hn, ss);)
  PH(1, phase_gemm_in<true>(*gp, hn, ss, smem);)
  PH(2, phase_fox_f(*gp, smem); for (int t = blockIdx.x; t < 4096; t += gridDim.x) gdn_pre_tile(*gp, t, smem);)
  PH(3, for (;;) { int it = next_item(ctr + 0, smem); if (it >= 64 + 4096) break; if (it < 64) gdn_scan_item(*gp, it, smem); else fox_tile(*gp, it - 64, smem); })
  PH(4, phase_gdn_post(*gp); phase_cvt_p(as_global(gp->in[1]), pbf);)
  PH(5, phase_gemm<EP_RESID>(mix, 1024, WT + WT_OUT_E, 1024, 8, nullptr, 0, as_global(gp->in[0]), h, hn, nullptr, ss + 1 * M_, smem);)
  PH(6, phase_gemm<EP_RELU2>(hn, 1024, WT + WT_UP, 1024, 32, Yb, 4096, nullptr, nullptr, nullptr, ss + 1 * M_, nullptr, smem); phase_pp(pbf, WT + WT_PROJ, ppb, smem);)
  PH(7, phase_gemm<EP_RESID>(Yb, 4096, WT + WT_DOWN, 4096, 8, nullptr, 0, h, h, hn, nullptr, ss + 2 * M_, smem);)
  PH(8, phase_ple(hn, WT + WT_GATE, ppb, h, hn2, ss + 2 * M_, ss + 3 * M_, smem);)
  PH(9, phase_gemm_in<false>(*gp, hn2, ss + 3 * M_, smem);)
  PH(10, for (int t = blockIdx.x; t < 128; t += gridDim.x) cmp_tile(*gp, t, smem); for (int t = blockIdx.x; t < 8192; t += gridDim.x) rglru_tile<false>(*gp, t, smem); phase_cvt_p(as_global(gp->in[1]) + (size_t)M_ * 256, pbf);)
  PH(11, for (;;) { int it = next_item(ctr + 1, smem); if (it >= 4096 + 8192) break; if (it < 4096) nsa_tile(*gp, it, smem); else rglru_tile<true>(*gp, it - 4096, smem); })
  PH(12, phase_gemm<EP_RESID>(mix, 1024, WT + WT_OUT_O, 1024, 8, nullptr, 0, h, h, hn, nullptr, ss + 4 * M_, smem);)
  PH(13, phase_gemm<EP_RELU2>(hn, 1024, WT + WT_UP + 4096 * 1024, 1024, 32, Yb, 4096, nullptr, nullptr, nullptr, ss + 4 * M_, nullptr, smem); phase_pp(pbf, WT + WT_PROJ + 1024 * 256, ppb, smem);)
  PH(14, phase_gemm<EP_RESID>(Yb, 4096, WT + WT_DOWN + 4096 * 1024, 4096, 8, nullptr, 0, h, h, hn, nullptr, ss + 5 * M_, smem);)
  PH(15, phase_ple(hn, WT + WT_GATE + 1024 * 1024, ppb, h, nullptr, ss + 5 * M_, nullptr, smem);)
  PH(16, phase_norm(h, as_global(gp->in[33]), nullptr, h);)
}

extern "C" void kernel_launch(void* const* d_in, const int* in_sizes, int n_in, void* d_out, int out_size, void* d_ws,
                              size_t ws_size, hipStream_t stream) {
  static int grid_blocks = 0;
  if (!grid_blocks) {
    hipFuncSetAttribute((const void*)mega, hipFuncAttributeMaxDynamicSharedMemorySize, LDS_BYTES);
    int dev = 0, cus = 0, per_cu = 0;
    hipGetDevice(&dev);
    hipDeviceGetAttribute(&cus, hipDeviceAttributeMultiprocessorCount, dev);
    hipOccupancyMaxActiveBlocksPerMultiprocessor(&per_cu, mega, 256, LDS_BYTES);
    if (per_cu > 2) per_cu = 2;
    if (per_cu < 1) per_cu = 1;
    grid_blocks = cus * per_cu;
  }
  Params p;
  memset((void*)&p, 0, sizeof(p));
  for (int i = 0; i < 34; i++) p.in[i] = (const float*)d_in[i];
  p.positions = (const int*)d_in[2];
  p.out = (float*)d_out;
  p.ws = (char*)d_ws;
  bf16_t* WT = (bf16_t*)((char*)d_ws + OFF_WT);
  auto F = [&](int i) { return (const float*)d_in[i]; };
  int nd = 0, t0 = 0;
  auto add = [&](const float* src, bf16_t* dst, int K, int N, int Nd, int kind, int nb, const float* scale) {
    p.wd[nd].src = src; p.wd[nd].dst = dst; p.wd[nd].scale = scale; p.wd[nd].K = K; p.wd[nd].N = N; p.wd[nd].Nd = Nd; p.wd[nd].kind = kind; p.wd[nd].nb = nb; p.wd[nd].tile0 = t0;
    t0 += nb * (K / 64) * (Nd / 64);
    nd++;
  };
  add(F(4), WT + WT_IN_E, 1024, 3600, 3712, 1, 1, F(3));
  add(F(10), WT + WT_OUT_E, 1024, 1024, 1024, 0, 1, nullptr);
  add(F(12), WT + WT_IN_O, 1024, 2328, 2432, 2, 1, F(11));
  add(F(26), WT + WT_OUT_O, 1024, 1024, 1024, 0, 1, nullptr);
  add(F(28), WT + WT_UP, 1024, 4096, 4096, 0, 2, F(27));
  add(F(29), WT + WT_DOWN, 4096, 1024, 1024, 0, 2, nullptr);
  add(F(31), WT + WT_GATE, 1024, 1024, 1024, 0, 2, F(30));
  add(F(32), WT + WT_PROJ, 256, 1024, 1024, 0, 2, nullptr);
  add(F(14), WT + WT_CK1, 2048, 128, 128, 0, 1, nullptr);
  add(F(17), WT + WT_CV1, 2048, 128, 128, 0, 1, nullptr);
  add(F(15), WT + WT_CK2, 128, 64, 64, 0, 1, nullptr);
  add(F(18), WT + WT_CV2, 128, 64, 64, 0, 1, nullptr);
  add(F(21), WT + WT_RGA, 64, 64, 64, 0, 8, nullptr);
  add(F(23), WT + WT_RGX, 64, 64, 64, 0, 8, nullptr);
  while (nd < NWD) { p.wd[nd].K = 64; p.wd[nd].N = 64; p.wd[nd].Nd = 64; p.wd[nd].tile0 = 0x7fffffff; nd++; }
  p.prep_tiles = t0;
  int ph0 = 0, ph1 = NPHASE - 1;
  void* args[] = {&p, &ph0, &ph1};
  hipError_t e = hipLaunchCooperativeKernel((void*)mega, dim3(grid_blocks), dim3(256), args, LDS_BYTES, stream);
  if (e != hipSuccess) fprintf(stderr, "cooperative launch failed: %s (grid %d)\n", hipGetErrorString(e), grid_blocks);
}
```

```cpp
#include <hip/hip_runtime.h>
#include <hip/hip_cooperative_groups.h>
#include <stdint.h>
#include <stdio.h>
#include <string.h>
namespace cg = cooperative_groups;

typedef unsigned short bf16_t;
typedef __attribute__((ext_vector_type(8))) short bf16x8;
typedef __attribute__((ext_vector_type(4))) float f32x4;
#define DEVI __device__ __forceinline__

constexpr int S_ = 8192, B_ = 8, M_ = 65536;
constexpr size_t MiB = 1ull << 20;
constexpr size_t OFF_WT = 0, OFF_Y = 64 * MiB, OFF_MIX = 576 * MiB, OFF_SM = 704 * MiB, OFF_MISC = 712 * MiB,
                 OFF_X = 736 * MiB, OFF_HN = 896 * MiB;
constexpr size_t WT_IN_E = 0;
constexpr size_t WT_OUT_E = WT_IN_E + 3712 * 1024;
constexpr size_t WT_IN_O = WT_OUT_E + 1024 * 1024;
constexpr size_t WT_OUT_O = WT_IN_O + 2432 * 1024;
constexpr size_t WT_UP = WT_OUT_O + 1024 * 1024;
constexpr size_t WT_DOWN = WT_UP + 2 * 4096 * 1024;
constexpr size_t WT_GATE = WT_DOWN + 2 * 4096 * 1024;
constexpr size_t WT_PROJ = WT_GATE + 2 * 1024 * 1024;
constexpr size_t WT_CK1 = WT_PROJ + 2 * 1024 * 256;
constexpr size_t WT_CV1 = WT_CK1 + 128 * 2048;
constexpr size_t WT_CK2 = WT_CV1 + 128 * 2048;
constexpr size_t WT_CV2 = WT_CK2 + 64 * 128;
constexpr size_t WT_RGA = WT_CV2 + 64 * 128;
constexpr size_t WT_RGX = WT_RGA + 8 * 64 * 64;
constexpr size_t MS_ROPE = 0;
constexpr size_t MS_FOXF = 4 * MiB;
constexpr size_t MS_EGL = 6 * MiB;
constexpr size_t MS_CTR = 6 * MiB + 65536;
constexpr size_t MS_KCMP = 7 * MiB;
constexpr size_t MS_VCMPT = 8 * MiB;
constexpr size_t MS_RGAGG = 9 * MiB;
constexpr size_t MS_PTAB = 13 * MiB;
constexpr size_t MS_KMAX = 14 * MiB;
constexpr size_t MS_SS = 15 * MiB;
constexpr int YE_LD = 3584, YO_LD = 2304;
constexpr int GDN_CH_BYTES = 73728;
constexpr int LDS_BYTES = 73728;
constexpr float LOG2E = 1.4426950408889634f;
constexpr float NEGF = -1e30f;

struct WDesc { const float* src; bf16_t* dst; const float* scale; int K, N, Nd, kind, nb, tile0; };
constexpr int NWD = 18;
struct Params {
  const float* in[34];
  const int* positions;
  float* out;
  char* ws;
  WDesc wd[NWD];
  int prep_tiles;
  int pad_;
};

template <class T> DEVI T* as_global(T* q) {
  typedef T __attribute__((address_space(1)))* gp_t;
  return (T*)((gp_t)q);
}
typedef unsigned v4u_t_ __attribute__((ext_vector_type(4)));
typedef float v4f_t_ __attribute__((ext_vector_type(4)));
DEVI uint4 gld16_(const void* q) { typedef const v4u_t_ __attribute__((address_space(1))) gv; v4u_t_ v = *(gv*)q; return make_uint4(v.x, v.y, v.z, v.w); }
DEVI float4 gldf4_(const void* q) { typedef const v4f_t_ __attribute__((address_space(1))) gv; v4f_t_ v = *(gv*)q; return make_float4(v.x, v.y, v.z, v.w); }
#define GLD16(ptr) gld16_(ptr)
#define GLDF4(ptr) gldf4_(ptr)
DEVI char* gws(const Params& p) { return as_global(p.ws); }
DEVI const float* gin(const Params& p, int i) { return as_global(p.in[i]); }
DEVI int opaque_tid() { int t = threadIdx.x; asm volatile("" : "+v"(t)); return t; }
DEVI bf16_t f2bf(float f) { unsigned u = __float_as_uint(f); u += 0x7fffu + ((u >> 16) & 1u); return (bf16_t)(u >> 16); }
DEVI float bf2f(bf16_t b) { return __uint_as_float(((unsigned)b) << 16); }
typedef __bf16 bf2_t_ __attribute__((ext_vector_type(2)));
typedef float f2_t_ __attribute__((ext_vector_type(2)));
DEVI unsigned pack2(float a, float b) { f2_t_ f = {a, b}; bf2_t_ hh = __builtin_convertvector(f, bf2_t_); return __builtin_bit_cast(unsigned, hh); }
DEVI float lo2f(unsigned u) { return __uint_as_float(u << 16); }
DEVI float hi2f(unsigned u) { return __uint_as_float(u & 0xffff0000u); }
DEVI f32x4 mfma16(bf16x8 a, bf16x8 b, f32x4 c) { return __builtin_amdgcn_mfma_f32_16x16x32_bf16(a, b, c, 0, 0, 0); }
DEVI float sigmoidf_(float x) { return 1.f / (1.f + __expf(-x)); }
DEVI float softplusf_(float x) { return fmaxf(x, 0.f) + log1pf(__expf(-fabsf(x))); }
DEVI float gelu_tanh(float x) { float u = 0.7978845608028654f * (x + 0.044715f * x * x * x); float e = __expf(-2.f * fabsf(u)); float t = (1.f - e) / (1.f + e); t = u < 0 ? -t : t; return 0.5f * x * (1.f + t); }
DEVI float fexp2(float x) { return __builtin_amdgcn_exp2f(x); }
DEVI bf16x8 mk8(unsigned a, unsigned b, unsigned c, unsigned d) { uint4 v = make_uint4(a, b, c, d); return __builtin_bit_cast(bf16x8, v); }

DEVI int colmap(int kind, int n) {
  if (kind == 0) return n;
  if (kind == 1) {
    if (n < 1536) return n;
    if (n < 3584) return n + 8;
    if (n < 3592) return 1536 + (n - 3584);
    if (n < 3600) return n;
    return -1;
  }
  if (n < 1280) return n;
  if (n < 2304) return n + 24;
  if (n < 2328) return 1280 + (n - 2304);
  return -1;
}

DEVI void phase_prep(const Params& p, char* smem) {
  float (*t)[65] = (float (*)[65])smem;
  int tid = opaque_tid();
  for (int tile = blockIdx.x; tile < p.prep_tiles; tile += gridDim.x) {
    int di = 0;
#pragma unroll 1
    for (int i = 1; i < NWD; i++) if (tile >= p.wd[i].tile0) di = i;
    const WDesc& w = p.wd[di];
    int lt = tile - w.tile0;
    int tk = w.K / 64, tn = w.Nd / 64;
    int bi = lt / (tk * tn); lt -= bi * tk * tn;
    int k0 = (lt / tn) * 64, n0 = (lt % tn) * 64;
    const float* src = w.src + (size_t)bi * w.K * w.N;
    bf16_t* dst = w.dst + (size_t)bi * w.Nd * w.K;
    int nl = tid & 63, kl = tid >> 6;
    int col = colmap(w.kind, n0 + nl);
    if (col >= w.N) col = -1;
#pragma unroll 4
    for (int pp = 0; pp < 16; pp++) {
      int k = kl + pp * 4;
      float scl = w.scale ? w.scale[bi * w.K + k0 + k] : 1.f;
      t[k][nl] = (col >= 0) ? src[(size_t)(k0 + k) * w.N + col] * scl : 0.f;
    }
    __syncthreads();
#pragma unroll 4
    for (int pp = 0; pp < 16; pp++) {
      int n = kl + pp * 4;
      dst[(size_t)(n0 + n) * w.K + k0 + nl] = f2bf(t[nl][n]);
    }
    __syncthreads();
  }
  float* rope = (float*)(gws(p) + OFF_MISC + MS_ROPE);
  int gt = blockIdx.x * 256 + tid, gs = gridDim.x * 256;
  for (int i = gt; i < M_ * 8; i += gs) {
    int m = i >> 3, f = i & 7;
    float invf = powf(500000.f, -(float)f * 0.125f);
    float ang = (float)p.positions[m] * invf;
    double n = rint((double)ang * 0.15915494309189535);
    float r = (float)((double)ang - n * 6.283185307179586);
    rope[m * 16 + f] = cosf(r);
    rope[m * 16 + 8 + f] = sinf(r);
  }
  if (gt < 16) ((int*)(gws(p) + OFF_MISC + MS_CTR))[gt] = 0;
  if (gt < 64) ((unsigned*)(gws(p) + OFF_MISC + MS_KMAX))[gt] = 0u;
  { float* ssz = (float*)(gws(p) + OFF_MISC + MS_SS); for (int i = M_ + gt; i < 6 * M_; i += gs) ssz[i] = 0.f; }
  bf16_t* kc = (bf16_t*)(gws(p) + OFF_MISC + MS_KCMP);
  bf16_t* vc = (bf16_t*)(gws(p) + OFF_MISC + MS_VCMPT);
  for (int i = gt; i < B_ * 128; i += gs) { int b = i >> 7, c = i & 127; kc[((size_t)b * 512 + 511) * 128 + c] = 0; vc[((size_t)b * 128 + c) * 512 + 511] = 0; }
}

DEVI void phase_norm(const float* __restrict__ src, const float* __restrict__ w, bf16_t* __restrict__ dstb, float* __restrict__ dstf) {
  int lane = opaque_tid() & 63;
  int gw = blockIdx.x * 4 + (opaque_tid() >> 6), nw = gridDim.x * 4;
  for (int row = gw; row < M_; row += nw) {
    const float4* s4 = (const float4*)(src + (size_t)row * 1024);
    float4 v[4]; float ss = 0.f;
#pragma unroll
    for (int i = 0; i < 4; i++) { v[i] = s4[lane + i * 64]; ss += v[i].x * v[i].x + v[i].y * v[i].y + v[i].z * v[i].z + v[i].w * v[i].w; }
#pragma unroll
    for (int o = 32; o >= 1; o >>= 1) ss += __shfl_xor(ss, o);
    float rs = rsqrtf(ss * (1.f / 1024.f) + 1e-6f);
#pragma unroll
    for (int i = 0; i < 4; i++) {
      float4 ww = ((const float4*)w)[lane + i * 64];
      float a = v[i].x * rs * ww.x, b = v[i].y * rs * ww.y, c = v[i].z * rs * ww.z, d = v[i].w * rs * ww.w;
      if (dstf) ((float4*)(dstf + (size_t)row * 1024))[lane + i * 64] = make_float4(a, b, c, d);
      else ((uint2*)(dstb + (size_t)row * 1024))[lane + i * 64] = make_uint2(pack2(a, b), pack2(c, d));
    }
  }
}
DEVI void phase_xprep(const float* __restrict__ src, bf16_t* __restrict__ dstb, float* __restrict__ ss) {
  int lane = opaque_tid() & 63;
  int gw = blockIdx.x * 4 + (opaque_tid() >> 6), nw = gridDim.x * 4;
  for (int row = gw; row < M_; row += nw) {
    const float4* s4 = (const float4*)(src + (size_t)row * 1024);
    float acc = 0.f;
#pragma unroll
    for (int i = 0; i < 4; i++) {
      float4 v = s4[lane + i * 64];
      acc += v.x * v.x + v.y * v.y + v.z * v.z + v.w * v.w;
      ((uint2*)(dstb + (size_t)row * 1024))[lane + i * 64] = make_uint2(pack2(v.x, v.y), pack2(v.z, v.w));
    }
#pragma unroll
    for (int o = 32; o >= 1; o >>= 1) acc += __shfl_xor(acc, o);
    if (lane == 0) ss[row] = acc;
  }
}
DEVI void phase_cvt_p(const float* __restrict__ src, bf16_t* __restrict__ dst) {
  size_t n4 = (size_t)M_ * 256 / 4;
  for (size_t i = (size_t)blockIdx.x * 256 + opaque_tid(); i < n4; i += (size_t)gridDim.x * 256) {
    float4 v = ((const float4*)src)[i];
    ((uint2*)dst)[i] = make_uint2(pack2(v.x, v.y), pack2(v.z, v.w));
  }
}

struct GemmSmem { bf16_t a[2][128][72]; bf16_t b[2][128][72]; };

struct ALoadPlain {
  const bf16_t* A; int lda; int toff;
  DEVI void init(int lr, int lc) { toff = lr * lda + lc; }
  DEVI uint4 load(int i, int k) const { const bf16_t* ub = A + ((size_t)(i * 32) * lda + k); return *(const uint4*)(ub + toff); }
};

template <bool SWAP, class AL>
DEVI void gemm_mainloop(const AL& al_in, const bf16_t* __restrict__ Bt, int ldb, int K, char* smem, f32x4 (&acc)[4][4]) {
  GemmSmem& sm = *(GemmSmem*)smem;
  const int tid = opaque_tid(), lane = tid & 63, wid = tid >> 6, wr = wid >> 1, wc = wid & 1;
  const int lr = tid >> 3, lc = (tid & 7) * 8;
  const int fr = lane & 15, fq = lane >> 4;
  uint4 ra0, ra1, ra2, ra3, rb0, rb1, rb2, rb3;
  uint4 qa0, qa1, qa2, qa3, qb0, qb1, qb2, qb3;
  const int btoff = lr * ldb + lc;
  AL al = al_in; al.init(lr, lc);
#define GL_A(k) do { ra0 = al.load(0, (k)); ra1 = al.load(1, (k)); ra2 = al.load(2, (k)); ra3 = al.load(3, (k)); \
    rb0 = *(const uint4*)(Bt + (k) + btoff); rb1 = *(const uint4*)(Bt + ((size_t)32 * ldb + (k)) + btoff); rb2 = *(const uint4*)(Bt + ((size_t)64 * ldb + (k)) + btoff); rb3 = *(const uint4*)(Bt + ((size_t)96 * ldb + (k)) + btoff); } while (0)
#define GL_B(k) do { qa0 = al.load(0, (k)); qa1 = al.load(1, (k)); qa2 = al.load(2, (k)); qa3 = al.load(3, (k)); \
    qb0 = *(const uint4*)(Bt + (k) + btoff); qb1 = *(const uint4*)(Bt + ((size_t)32 * ldb + (k)) + btoff); qb2 = *(const uint4*)(Bt + ((size_t)64 * ldb + (k)) + btoff); qb3 = *(const uint4*)(Bt + ((size_t)96 * ldb + (k)) + btoff); } while (0)
#define ST_A(bf) do { *(uint4*)&sm.a[bf][lr][lc] = ra0; *(uint4*)&sm.a[bf][lr + 32][lc] = ra1; *(uint4*)&sm.a[bf][lr + 64][lc] = ra2; *(uint4*)&sm.a[bf][lr + 96][lc] = ra3; \
    *(uint4*)&sm.b[bf][lr][lc] = rb0; *(uint4*)&sm.b[bf][lr + 32][lc] = rb1; *(uint4*)&sm.b[bf][lr + 64][lc] = rb2; *(uint4*)&sm.b[bf][lr + 96][lc] = rb3; } while (0)
#define ST_B(bf) do { *(uint4*)&sm.a[bf][lr][lc] = qa0; *(uint4*)&sm.a[bf][lr + 32][lc] = qa1; *(uint4*)&sm.a[bf][lr + 64][lc] = qa2; *(uint4*)&sm.a[bf][lr + 96][lc] = qa3; \
    *(uint4*)&sm.b[bf][lr][lc] = qb0; *(uint4*)&sm.b[bf][lr + 32][lc] = qb1; *(uint4*)&sm.b[bf][lr + 64][lc] = qb2; *(uint4*)&sm.b[bf][lr + 96][lc] = qb3; } while (0)
#define COMPUTE(bf) do { _Pragma("unroll") for (int kk = 0; kk < 2; kk++) { \
      bf16x8 af[4], bfr[4]; \
      _Pragma("unroll") for (int i = 0; i < 4; i++) af[i] = *(const bf16x8*)&sm.a[bf][wr * 64 + i * 16 + fr][kk * 32 + fq * 8]; \
      _Pragma("unroll") for (int j = 0; j < 4; j++) bfr[j] = *(const bf16x8*)&sm.b[bf][wc * 64 + j * 16 + fr][kk * 32 + fq * 8]; \
      __builtin_amdgcn_s_setprio(1); \
      _Pragma("unroll") for (int i = 0; i < 4; i++) _Pragma("unroll") for (int j = 0; j < 4; j++) \
          acc[i][j] = SWAP ? mfma16(bfr[j], af[i], acc[i][j]) : mfma16(af[i], bfr[j], acc[i][j]); \
      __builtin_amdgcn_s_setprio(0); } } while (0)
  const int nk = K >> 6;
  GL_A(0);
  ST_A(0);
  GL_A(64);
  __syncthreads();
  for (int kt = 0; kt < nk; kt += 2) {
    if (kt + 2 < nk) GL_B((kt + 2) * 64);
    COMPUTE(0);
    ST_A(1);
    __syncthreads();
    if (kt + 3 < nk) GL_A((kt + 3) * 64);
    COMPUTE(1);
    if (kt + 2 < nk) ST_B(0);
    __syncthreads();
  }
#undef GL_A
#undef GL_B
#undef ST_A
#undef ST_B
#undef COMPUTE
}
template <bool SWAP>
DEVI void gemm_mainloop_dma(const bf16_t* __restrict__ A, int lda, const bf16_t* __restrict__ Bt, int ldb, int K, char* smem, f32x4 (&acc)[8][4]) {
  const int tid = opaque_tid(), lane = tid & 63, wid = tid >> 6, wr = wid >> 1, wc = wid & 1;
  const int fr = lane & 15, fq = lane >> 4;
  const int gc = (tid & 3) ^ ((0x1320 >> (((tid >> 4) & 3) * 4)) & 3);
  const int aoff = (tid >> 2) * lda + gc * 8, boff = (tid >> 2) * ldb + gc * 8;
  char* lds_t = smem + tid * 16;
#define DMA_ISSUE(st, k0) do { \
    _Pragma("unroll") for (int j = 0; j < 4; j++) \
      __builtin_amdgcn_global_load_lds((const unsigned*)(A + ((size_t)(j * 64) * lda + (k0)) + aoff), (unsigned*)(lds_t + (st) * 24576 + j * 4096), 16, 0, 0); \
    _Pragma("unroll") for (int j = 0; j < 2; j++) \
      __builtin_amdgcn_global_load_lds((const unsigned*)(Bt + ((size_t)(j * 64) * ldb + (k0)) + boff), (unsigned*)(lds_t + (st) * 24576 + 16384 + j * 4096), 16, 0, 0); } while (0)
  const int co = (fq ^ ((0x1320 >> (((fr >> 2) & 3) * 4)) & 3)) * 16;
  const int arow = (wr * 128 + fr) * 64 + co, brow = 16384 + (wc * 64 + fr) * 64 + co;
  const int nk = K >> 5;
  DMA_ISSUE(0, 0); DMA_ISSUE(1, 32);
  int stg = 0;
  for (int kt = 0; kt < nk; kt++) {
    if (kt + 1 < nk) asm volatile("s_waitcnt vmcnt(6)" ::: "memory");
    else asm volatile("s_waitcnt vmcnt(0)" ::: "memory");
    __builtin_amdgcn_s_barrier();
    int nst = stg == 0 ? 2 : stg - 1;
    if (kt + 2 < nk) DMA_ISSUE(nst, (kt + 2) * 32);
    const char* st = smem + stg * 24576;
    bf16x8 bfr[4];
#pragma unroll
    for (int j = 0; j < 4; j++) bfr[j] = *(const bf16x8*)(st + brow + j * 1024);
#pragma unroll
    for (int ih = 0; ih < 2; ih++) {
      bf16x8 af[4];
#pragma unroll
      for (int i = 0; i < 4; i++) af[i] = *(const bf16x8*)(st + arow + (ih * 4 + i) * 1024);
      __builtin_amdgcn_s_setprio(1);
#pragma unroll
      for (int i = 0; i < 4; i++)
#pragma unroll
        for (int j = 0; j < 4; j++)
          acc[ih * 4 + i][j] = SWAP ? mfma16(bfr[j], af[i], acc[ih * 4 + i][j]) : mfma16(af[i], bfr[j], acc[ih * 4 + i][j]);
      __builtin_amdgcn_s_setprio(0);
    }
    stg = stg == 2 ? 0 : stg + 1;
  }
  __syncthreads();
#undef DMA_ISSUE
}
DEVI void zero_acc8(f32x4 (&acc)[8][4]) {
#pragma unroll
  for (int i = 0; i < 8; i++)
#pragma unroll
    for (int j = 0; j < 4; j++) acc[i][j] = f32x4{0.f, 0.f, 0.f, 0.f};
}
DEVI int xcd_vid() { int g8 = gridDim.x >> 3; return (blockIdx.x & 7) * g8 + (blockIdx.x >> 3); }
DEVI void zero_acc(f32x4 (&acc)[4][4]) {
#pragma unroll
  for (int i = 0; i < 4; i++)
#pragma unroll
    for (int j = 0; j < 4; j++) acc[i][j] = f32x4{0.f, 0.f, 0.f, 0.f};
}

enum { EP_BF16 = 0, EP_RELU2 = 1, EP_RESID = 2 };
DEVI float row_rstd(const float* ss, size_t m) { return rsqrtf(ss[m] * (1.f / 1024.f) + 1e-6f); }
template <int EP>
DEVI void phase_gemm(const bf16_t* A, int lda, const bf16_t* Bt, int K, int NT, bf16_t* Cb, int ldc,
                     const float* res, float* outf, bf16_t* hb, const float* ss_in, float* ss_out, char* smem) {
  const int tid = opaque_tid(), lane = tid & 63, wid = tid >> 6, wr = wid >> 1, wc = wid & 1, fr = lane & 15, fq = lane >> 4;
  const int ntiles = 256 * NT;
  for (int tile = xcd_vid(); tile < ntiles; tile += gridDim.x) {
    int mt = tile / NT, nt = tile % NT;
    f32x4 acc[8][4]; zero_acc8(acc);
    gemm_mainloop_dma<true>(A + (size_t)mt * 256 * lda, lda, Bt + (size_t)nt * 128 * K, K, K, smem, acc);
#pragma unroll
    for (int i = 0; i < 8; i++) {
      size_t m = (size_t)mt * 256 + wr * 128 + i * 16 + fr;
      float rs = (EP == EP_RELU2) ? row_rstd(ss_in, m) : 1.f;
      float part = 0.f;
#pragma unroll
      for (int j = 0; j < 4; j++) {
        int n = nt * 128 + wc * 64 + j * 16 + fq * 4;
        f32x4 v = acc[i][j];
        if (EP == EP_BF16) {
          *(uint2*)(Cb + m * ldc + n) = make_uint2(pack2(v[0], v[1]), pack2(v[2], v[3]));
        } else if (EP == EP_RELU2) {
          float a = fmaxf(v[0], 0.f) * rs, b = fmaxf(v[1], 0.f) * rs, c = fmaxf(v[2], 0.f) * rs, d = fmaxf(v[3], 0.f) * rs;
          *(uint2*)(Cb + m * ldc + n) = make_uint2(pack2(a * a, b * b), pack2(c * c, d * d));
        } else {
          float4 r = *(const float4*)(res + m * 1024 + n);
          float o0 = r.x + v[0], o1 = r.y + v[1], o2 = r.z + v[2], o3 = r.w + v[3];
          *(float4*)(outf + m * 1024 + n) = make_float4(o0, o1, o2, o3);
          *(uint2*)(hb + m * 1024 + n) = make_uint2(pack2(o0, o1), pack2(o2, o3));
          part += o0 * o0 + o1 * o1 + o2 * o2 + o3 * o3;
        }
      }
      if (EP == EP_RESID) {
        part += __shfl_xor(part, 16); part += __shfl_xor(part, 32);
        if (fq == 0) atomicAdd(&ss_out[m], part);
      }
      __builtin_amdgcn_sched_barrier(0);
    }
  }
}

struct ALoadF32 {
  const float* A; int lda; int lr, lc;
  DEVI void init(int lr_, int lc_) { lr = lr_; lc = lc_; }
  DEVI uint4 load(int i, int k) const {
    const float4* s = (const float4*)(A + (size_t)(lr + i * 32) * lda + k + lc);
    float4 a = s[0], b = s[1];
    return make_uint4(pack2(a.x, a.y), pack2(a.z, a.w), pack2(b.x, b.y), pack2(b.z, b.w));
  }
};
DEVI void phase_pp(const bf16_t* pf, const bf16_t* Wp, bf16_t* pp, char* smem) {
  const int tid = opaque_tid(), lane = tid & 63, wid = tid >> 6, wr = wid >> 1, wc = wid & 1, fr = lane & 15, fq = lane >> 4;
  for (int tile = xcd_vid(); tile < 256 * 8; tile += gridDim.x) {
    int mt = tile >> 3, nt = tile & 7;
    f32x4 acc[8][4]; zero_acc8(acc);
    gemm_mainloop_dma<true>(pf + (size_t)mt * 256 * 256, 256, Wp + (size_t)nt * 128 * 256, 256, 256, smem, acc);
#pragma unroll
    for (int i = 0; i < 8; i++) {
      size_t m = (size_t)mt * 256 + wr * 128 + i * 16 + fr;
#pragma unroll
      for (int j = 0; j < 4; j++) {
        int n = nt * 128 + wc * 64 + j * 16 + fq * 4;
        f32x4 v = acc[i][j];
        *(uint2*)(pp + m * 1024 + n) = make_uint2(pack2(v[0], v[1]), pack2(v[2], v[3]));
      }
    }
  }
}
DEVI void phase_ple(const bf16_t* hbin, const bf16_t* Wg, const bf16_t* pp, float* h, bf16_t* hb, const float* ss_in, float* ss_out, char* smem) {
  const int tid = opaque_tid(), lane = tid & 63, wid = tid >> 6, wr = wid >> 1, wc = wid & 1, fr = lane & 15, fq = lane >> 4;
  for (int tile = xcd_vid(); tile < 256 * 8; tile += gridDim.x) {
    int mt = tile >> 3, nt = tile & 7;
    f32x4 acc[8][4]; zero_acc8(acc);
    gemm_mainloop_dma<true>(hbin + (size_t)mt * 256 * 1024, 1024, Wg + (size_t)nt * 128 * 1024, 1024, 1024, smem, acc);
#pragma unroll
    for (int i = 0; i < 8; i++) {
      size_t m = (size_t)mt * 256 + wr * 128 + i * 16 + fr;
      float rs = row_rstd(ss_in, m);
      float part = 0.f;
#pragma unroll
      for (int j = 0; j < 4; j++) {
        int n = nt * 128 + wc * 64 + j * 16 + fq * 4;
        float4 r = *(const float4*)(h + m * 1024 + n);
        uint2 q = *(const uint2*)(pp + m * 1024 + n);
        f32x4 g = acc[i][j];
        float o0 = r.x + sigmoidf_(g[0] * rs) * lo2f(q.x), o1 = r.y + sigmoidf_(g[1] * rs) * hi2f(q.x);
        float o2 = r.z + sigmoidf_(g[2] * rs) * lo2f(q.y), o3 = r.w + sigmoidf_(g[3] * rs) * hi2f(q.y);
        *(float4*)(h + m * 1024 + n) = make_float4(o0, o1, o2, o3);
        if (hb) {
          *(uint2*)(hb + m * 1024 + n) = make_uint2(pack2(o0, o1), pack2(o2, o3));
          part += o0 * o0 + o1 * o1 + o2 * o2 + o3 * o3;
        }
      }
      if (hb) {
        part += __shfl_xor(part, 16); part += __shfl_xor(part, 32);
        if (fq == 0) atomicAdd(&ss_out[m], part);
      }
      __builtin_amdgcn_sched_barrier(0);
    }
  }
}

struct InTileKind { int kind; int ycol; bf16_t* vt; int vtrows; int nsmall; };
template <bool EVEN>
DEVI InTileKind in_tile_kind(const Params& p, int nt) {
  InTileKind k{0, nt * 128, nullptr, 0, 0};
  char* Y = gws(p) + OFF_Y;
  if (EVEN) {
    if (nt >= 8 && nt < 12) { k.kind = 2; k.vt = (bf16_t*)(Y + 448 * MiB) + (size_t)(nt - 8) * 128 * S_; k.vtrows = 512; }
    else if (nt == 28) { k.kind = 3; k.nsmall = 16; }
  } else {
    if (nt < 5 || nt == 6 || nt == 8) k.kind = 1;
    else if (nt == 7) { k.kind = 2; k.vt = (bf16_t*)(Y + 288 * MiB); k.vtrows = 128; }
    else if (nt == 9) { k.kind = 2; k.vt = (bf16_t*)(Y + 304 * MiB); k.vtrows = 128; }
    else if (nt == 18) { k.kind = 3; k.nsmall = 24; }
  }
  return k;
}
template <bool EVEN>
DEVI void phase_gemm_in(const Params& p, const bf16_t* hn, const float* ss_in, char* smem) {
  const int tid = opaque_tid(), lane = tid & 63, wid = tid >> 6, wr = wid >> 1, wc = wid & 1, fr = lane & 15, fq = lane >> 4;
  constexpr int NT = EVEN ? 29 : 19;
  constexpr int LDY = EVEN ? YE_LD : YO_LD;
  const bf16_t* Wt = (const bf16_t*)(gws(p) + OFF_WT) + (EVEN ? WT_IN_E : WT_IN_O);
  bf16_t* Y = (bf16_t*)(gws(p) + OFF_Y);
  float* ysm = (float*)(gws(p) + OFF_SM);
  const float* rope = (const float*)(gws(p) + OFF_MISC + MS_ROPE);
  for (int tile = xcd_vid(); tile < 256 * NT; tile += gridDim.x) {
    int mt = tile / NT, nt = tile % NT;
    InTileKind tk = in_tile_kind<EVEN>(p, nt);
    f32x4 acc[8][4]; zero_acc8(acc);
    gemm_mainloop_dma<true>(hn + (size_t)mt * 256 * 1024, 1024, Wt + (size_t)nt * 128 * 1024, 1024, 1024, smem, acc);
    if (tk.kind == 2) {
      int b = (mt * 256) / S_, s0 = (mt * 256) % S_;
#pragma unroll
      for (int i = 0; i < 8; i++)
#pragma unroll
        for (int j = 0; j < 4; j++) {
          int n = wc * 64 + j * 16 + fq * 4, s = s0 + wr * 128 + i * 16 + fr;
          f32x4 v = acc[i][j] * row_rstd(ss_in, (size_t)mt * 256 + wr * 128 + i * 16 + fr);
          bf16_t* dst = tk.vt + ((size_t)b * tk.vtrows + n) * S_ + s;
#pragma unroll
          for (int r = 0; r < 4; r++) dst[(size_t)r * S_] = f2bf(v[r]);
        }
    } else {
#pragma unroll
      for (int i = 0; i < 8; i++) {
        size_t m = (size_t)mt * 256 + wr * 128 + i * 16 + fr;
        {
          float rs = row_rstd(ss_in, m);
#pragma unroll
          for (int j = 0; j < 4; j++) acc[i][j] *= rs;
        }
        if (tk.kind == 1) {
          const float* rp = rope + m * 16;
          f32x4 v = acc[i][0];
#pragma unroll
          for (int r = 0; r < 4; r++) {
            float pv = __shfl_xor(v[r], 32);
            int d8 = (fq & 1) * 4 + r;
            float c = rp[d8], s = rp[8 + d8];
            acc[i][0][r] = (fq < 2) ? (v[r] * c - pv * s) : (v[r] * c + pv * s);
          }
        }
#pragma unroll
        for (int j = 0; j < 4; j++) {
          int nl = wc * 64 + j * 16 + fq * 4;
          f32x4 v = acc[i][j];
          if (tk.kind == 3) {
#pragma unroll
            for (int r = 0; r < 4; r++) if (nl + r < tk.nsmall) ysm[m * 32 + nl + r] = v[r];
          } else {
            *(uint2*)(Y + m * LDY + tk.ycol + nl) = make_uint2(pack2(v[0], v[1]), pack2(v[2], v[3]));
          }
        }
      }
    }
  }
}

struct AttnSmem { bf16_t k[2][64][72]; bf16_t vt[2][64][72]; float fk[2][64]; };
constexpr int SM_IMP = 37376;
constexpr int SM_SELM = 71168;
constexpr int SM_BOR = 72192;
constexpr int SM_SLOT = 73712;
typedef unsigned long long u64;

DEVI int next_tile(u64 lo, u64 hi, int after) {
  if (after < 63) { u64 x = lo & (~0ull << (after + 1)); if (x) return __builtin_ctzll(x); }
  int a2 = after < 63 ? -1 : after - 64;
  if (a2 < 63) { u64 y = hi & (~0ull << (a2 + 1)); if (y) return 64 + __builtin_ctzll(y); }
  return -1;
}

DEVI float xq_max(float a) {
  auto r = __builtin_amdgcn_permlane16_swap(__float_as_uint(a), __float_as_uint(a), false, false);
  a = fmaxf(a, fmaxf(__uint_as_float(r[0]), __uint_as_float(r[1])));
  auto q = __builtin_amdgcn_permlane32_swap(__float_as_uint(a), __float_as_uint(a), false, false);
  return fmaxf(a, fmaxf(__uint_as_float(q[0]), __uint_as_float(q[1])));
}
template <int MODE, int NQT, class Pol>
DEVI void attn_compute(Pol& pol, AttnSmem& sm, int buf, int kb, const bf16x8 (&qf)[NQT][2], f32x4 (&o)[4][NQT], float (&m)[NQT], float (&l)[NQT], float* impw, int fr, int fq) {
      pol.begin(kb, sm.fk[buf]);
      const bool msk = pol.masked(kb);
      f32x4 s[4][NQT];
#pragma unroll
      for (int kt = 0; kt < 4; kt++)
#pragma unroll
        for (int qt = 0; qt < NQT; qt++) s[kt][qt] = f32x4{0.f, 0.f, 0.f, 0.f};
#pragma unroll
      for (int kt = 0; kt < 4; kt++)
#pragma unroll
        for (int kk = 0; kk < 2; kk++) {
          bf16x8 kf = *(const bf16x8*)&sm.k[buf][kt * 16 + fr][kk * 32 + fq * 8];
#pragma unroll
          for (int qt = 0; qt < NQT; qt++) s[kt][qt] = mfma16(kf, qf[qt][kk], s[kt][qt]);
        }
      bf16x8 vfr[2][4];
      if (MODE != 1) {
#pragma unroll
        for (int h2 = 0; h2 < 2; h2++)
#pragma unroll
          for (int dt = 0; dt < 4; dt++) {
            const bf16_t* vr = &sm.vt[buf][dt * 16 + fr][h2 * 32 + fq * 4];
            uint2 v0 = *(const uint2*)vr, v1 = *(const uint2*)(vr + 16);
            vfr[h2][dt] = mk8(v0.x, v0.y, v1.x, v1.y);
          }
      }
      bf16x8 pfr[2][NQT];
      float psum[4][4];
      if (MODE == 2) {
#pragma unroll
        for (int kt = 0; kt < 4; kt++)
#pragma unroll
          for (int r = 0; r < 4; r++) psum[kt][r] = 0.f;
      }
#pragma unroll
      for (int qt = 0; qt < NQT; qt++) {
        float t[4][4];
        if (Pol::UB && MODE != 2 && !msk) {
          const float bl = pol.lane_bias();
          float mxr = fmaxf(fmaxf(s[0][qt][0], s[0][qt][1]), fmaxf(s[0][qt][2], s[0][qt][3]));
#pragma unroll
          for (int kt = 1; kt < 4; kt++) mxr = fmaxf(mxr, fmaxf(fmaxf(s[kt][qt][0], s[kt][qt][1]), fmaxf(s[kt][qt][2], s[kt][qt][3])));
          float mx = xq_max(fmaf(mxr, pol.sc, bl));
          float mnew = fmaxf(m[qt], mx);
          float alpha = fexp2(m[qt] - mnew);
          m[qt] = mnew;
          const float cb = bl - fmaxf(mnew, 0.1f * NEGF);
          float ps = 0.f;
#pragma unroll
          for (int kt = 0; kt < 4; kt++)
#pragma unroll
            for (int r = 0; r < 4; r++) { t[kt][r] = fexp2(fmaf(s[kt][qt][r], pol.sc, cb)); ps += t[kt][r]; }
          l[qt] = l[qt] * alpha + ps;
          if (MODE == 0) {
            if (__any(alpha != 1.f)) {
#pragma unroll
              for (int dt = 0; dt < 4; dt++) o[dt][qt] *= alpha;
            }
          }
        } else {
#pragma unroll
        for (int kt = 0; kt < 4; kt++) {
          f32x4 bb = pol.bias4(kt * 16 + fq * 4);
#pragma unroll
          for (int r = 0; r < 4; r++) t[kt][r] = fmaf(s[kt][qt][r], pol.sc, bb[r]);
        }
        if (msk) {
#pragma unroll
          for (int kt = 0; kt < 4; kt++)
#pragma unroll
            for (int r = 0; r < 4; r++) t[kt][r] = pol.ok(qt, kt * 16 + fq * 4 + r) ? t[kt][r] : NEGF;
        }
        if (MODE == 2) {
#pragma unroll
          for (int kt = 0; kt < 4; kt++)
#pragma unroll
            for (int r = 0; r < 4; r++) {
              t[kt][r] = fexp2(t[kt][r] - fmaxf(m[qt], 0.1f * NEGF)) * l[qt];
              psum[kt][r] += t[kt][r];
            }
        } else {
          float mx = fmaxf(fmaxf(t[0][0], t[0][1]), fmaxf(t[0][2], t[0][3]));
#pragma unroll
          for (int kt = 1; kt < 4; kt++) mx = fmaxf(mx, fmaxf(fmaxf(t[kt][0], t[kt][1]), fmaxf(t[kt][2], t[kt][3])));
          mx = xq_max(mx);
          float mnew = fmaxf(m[qt], mx);
          float alpha = fexp2(m[qt] - mnew);
          m[qt] = mnew;
          float ps = 0.f;
          const float meff = fmaxf(mnew, 0.1f * NEGF);
#pragma unroll
          for (int kt = 0; kt < 4; kt++)
#pragma unroll
            for (int r = 0; r < 4; r++) { t[kt][r] = fexp2(t[kt][r] - meff); ps += t[kt][r]; }
          l[qt] = l[qt] * alpha + ps;
          if (MODE == 0) {
            if (__any(alpha != 1.f)) {
#pragma unroll
              for (int dt = 0; dt < 4; dt++) o[dt][qt] *= alpha;
            }
          }
        }
        }
        if (MODE != 1) {
#pragma unroll
          for (int h2 = 0; h2 < 2; h2++)
            pfr[h2][qt] = mk8(pack2(t[2 * h2][0], t[2 * h2][1]), pack2(t[2 * h2][2], t[2 * h2][3]), pack2(t[2 * h2 + 1][0], t[2 * h2 + 1][1]), pack2(t[2 * h2 + 1][2], t[2 * h2 + 1][3]));
        }
      }
      if (MODE == 2) {
#pragma unroll
        for (int kt = 0; kt < 4; kt++) {
          int c = kb * 16 + kt * 4 + fq;
          atomicAdd(&impw[fr * 132 + c], (psum[kt][0] + psum[kt][1]) + (psum[kt][2] + psum[kt][3]));
          atomicAdd(&impw[fr * 132 + c + 1], psum[kt][3]);
        }
      }
      if (MODE != 1) {
#pragma unroll
        for (int h2 = 0; h2 < 2; h2++)
#pragma unroll
          for (int dt = 0; dt < 4; dt++) {
#pragma unroll
            for (int qt = 0; qt < NQT; qt++) o[dt][qt] = mfma16(vfr[h2][dt], pfr[h2][qt], o[dt][qt]);
          }
      }
    }
template <int MODE, int NQT, class Pol>
DEVI void attn_core(Pol& pol, char* smem, const bf16x8 (&qf)[NQT][2], const bf16_t* __restrict__ Kg, int ldk,
                    const bf16_t* __restrict__ Vtg, int ldv, const float* __restrict__ fkg, u64 mlo, u64 mhi,
                    f32x4 (&o)[4][NQT], float (&m)[NQT], float (&l)[NQT], float* impw) {
  AttnSmem& sm = *(AttnSmem*)smem;
  const int tid = opaque_tid(), lane = tid & 63, fr = lane & 15, fq = lane >> 4;
  const int lrow = tid >> 3, lch = (tid & 7) * 8;
  int kb = next_tile(mlo, mhi, -1);
  if (kb < 0) return;
  uint4 ak0, ak1, av0 = make_uint4(0, 0, 0, 0), av1 = make_uint4(0, 0, 0, 0); float4 af4 = make_float4(0, 0, 0, 0);
  uint4 bk0, bk1, bv0 = make_uint4(0, 0, 0, 0), bv1 = make_uint4(0, 0, 0, 0); float4 bf4 = make_float4(0, 0, 0, 0);
#define GLOADX(P, t) do { \
    P##k0 = GLD16(Kg + (size_t)((t) * 64 + lrow) * ldk + lch); \
    P##k1 = GLD16(Kg + (size_t)((t) * 64 + lrow + 32) * ldk + lch); \
    if (MODE != 1) { P##v0 = GLD16(Vtg + (size_t)(lrow) * ldv + (t) * 64 + lch); \
                     P##v1 = GLD16(Vtg + (size_t)(lrow + 32) * ldv + (t) * 64 + lch); } \
    if (fkg != nullptr && tid < 16) P##f4 = GLDF4(fkg + (t) * 64 + tid * 4); } while (0)
#define SSTOREX(P, b) do { \
    *(uint4*)&sm.k[b][lrow][lch] = P##k0; *(uint4*)&sm.k[b][lrow + 32][lch] = P##k1; \
    if (MODE != 1) { *(uint4*)&sm.vt[b][lrow][lch] = P##v0; *(uint4*)&sm.vt[b][lrow + 32][lch] = P##v1; } \
    if (fkg != nullptr && tid < 16) *(float4*)&sm.fk[b][tid * 4] = P##f4; } while (0)
#define ATTN_STEP(S, L) do { \
    int kb2 = kb1 >= 0 ? next_tile(mlo, mhi, kb1) : -1; \
    if (kb2 >= 0) GLOADX(L, kb2); \
    if (pol.active(kb)) attn_compute<MODE, NQT, Pol>(pol, sm, buf, kb, qf, o, m, l, impw, fr, fq); \
    if (kb1 >= 0) SSTOREX(S, buf ^ 1); \
    __syncthreads(); \
    buf ^= 1; kb = kb1; kb1 = kb2; } while (0)
  int kb1 = next_tile(mlo, mhi, kb);
  GLOADX(a, kb); SSTOREX(a, 0);
  if (kb1 >= 0) GLOADX(a, kb1);
  __syncthreads();
  int buf = 0;
  for (;;) {
    ATTN_STEP(a, b);
    if (kb < 0) break;
    ATTN_STEP(b, a);
    if (kb < 0) break;
  }
#undef GLOADX
#undef SSTOREX
#undef ATTN_STEP
}
template <int NQT>
DEVI void zero_o(f32x4 (&o)[4][NQT]) {
#pragma unroll
  for (int i = 0; i < 4; i++)
#pragma unroll
    for (int j = 0; j < NQT; j++) o[i][j] = f32x4{0.f, 0.f, 0.f, 0.f};
}

DEVI void phase_fox_f(const Params& p, char* smem) {
  const int tid = opaque_tid(), lane = tid & 63, wid = tid >> 6;
  {
    unsigned* kmaxp = (unsigned*)(gws(p) + OFF_MISC + MS_KMAX);
    for (int slab = blockIdx.x; slab < M_ / 128; slab += gridDim.x) {
      int tok = slab * 128 + (tid >> 1), hh0 = (tid & 1) * 4, b = tok / S_;
      const uint4* kr = (const uint4*)((const bf16_t*)(gws(p) + OFF_Y) + (size_t)tok * YE_LD + 512 + hh0 * 64);
#pragma unroll
      for (int hh = 0; hh < 4; hh++) {
        float ss = 0.f;
#pragma unroll
        for (int c = 0; c < 8; c++) {
          uint4 v = kr[hh * 8 + c];
          float a0 = lo2f(v.x), a1 = hi2f(v.x), a2 = lo2f(v.y), a3 = hi2f(v.y), a4 = lo2f(v.z), a5 = hi2f(v.z), a6 = lo2f(v.w), a7 = hi2f(v.w);
          ss += a0 * a0 + a1 * a1 + a2 * a2 + a3 * a3 + a4 * a4 + a5 * a5 + a6 * a6 + a7 * a7;
        }
        ss = fmaxf(ss, __shfl_xor(ss, 2)); ss = fmaxf(ss, __shfl_xor(ss, 4)); ss = fmaxf(ss, __shfl_xor(ss, 8));
        ss = fmaxf(ss, __shfl_xor(ss, 16)); ss = fmaxf(ss, __shfl_xor(ss, 32));
        if (lane < 2) atomicMax(&kmaxp[b * 8 + hh0 + hh], __float_as_uint(ss));
      }
    }
  }
  if (blockIdx.x < 64) {
    int gw = blockIdx.x, b = gw >> 3, h = gw & 7;
    const float* ysm = (const float*)(gws(p) + OFF_SM) + (size_t)b * S_ * 32 + h;
    float bf = gin(p, 5)[h];
    float* F = (float*)(gws(p) + OFF_MISC + MS_FOXF) + (size_t)gw * S_;
    float ls[32];
    float sum = 0.f;
#pragma unroll
    for (int i = 0; i < 32; i++) { float x = ysm[(size_t)(tid * 32 + i) * 32] + bf; ls[i] = -softplusf_(-x); sum += ls[i]; }
    float incl = sum;
#pragma unroll
    for (int o = 1; o < 64; o <<= 1) { float t = __shfl_up(incl, o); if (lane >= o) incl += t; }
    float* wsum = (float*)smem;
    if (lane == 63) wsum[wid] = incl;
    __syncthreads();
    float off = 0.f;
    for (int w = 0; w < wid; w++) off += wsum[w];
    float run = off + incl - sum;
#pragma unroll
    for (int i = 0; i < 32; i++) { run += ls[i]; F[tid * 32 + i] = run * LOG2E; }
    __syncthreads();
  }
}

struct FoxPol {
  static constexpr bool UB = false;
  DEVI float lane_bias() const { return 0.f; }
  int tq0; int qmin, qmax; int kb; const float* fk; float sc;
  DEVI bool active(int kb_) const { return kb_ * 64 <= qmax; }
  DEVI bool masked(int kb_) const { return kb_ * 64 + 63 > qmin; }
  DEVI void begin(int kb_, const float* f) { kb = kb_; fk = f; }
  DEVI bool ok(int qt, int kl) const { return kb * 64 + kl <= tq0 + qt * 16; }
  DEVI f32x4 bias4(int kl0) const { float4 v = *(const float4*)&fk[kl0]; return f32x4{-v.x, -v.y, -v.z, -v.w}; }
};

DEVI void fox_tile(const Params& p, int item, char* smem) {
  const int tid = opaque_tid(), lane = tid & 63, wid = tid >> 6, fr = lane & 15, fq = lane >> 4;
  int qblk = 63 - (item >> 6), bh = item & 63, b = bh >> 3, h = bh & 7;
  int q0 = qblk * 128 + wid * 32;
  const bf16_t* Y = (const bf16_t*)(gws(p) + OFF_Y) + (size_t)b * S_ * YE_LD;
  const float* F = (const float*)(gws(p) + OFF_MISC + MS_FOXF) + (size_t)bh * S_;
  bf16x8 qf[2][2];
  FoxPol pol;
#pragma unroll
  for (int qt = 0; qt < 2; qt++) {
    int t = q0 + qt * 16 + fr;
#pragma unroll
    for (int kk = 0; kk < 2; kk++) qf[qt][kk] = *(const bf16x8*)(Y + (size_t)t * YE_LD + h * 64 + kk * 32 + fq * 8);
  }
  pol.tq0 = q0 + fr; pol.qmin = q0; pol.qmax = q0 + 31; pol.sc = 0.125f * LOG2E; pol.kb = 0; pol.fk = nullptr;
  f32x4 o[4][2]; zero_o<2>(o);
  float m[2] = {NEGF, NEGF}, l[2] = {0.f, 0.f};
  float qn2 = 0.f;
#pragma unroll
  for (int qt = 0; qt < 2; qt++) {
    float ss = 0.f;
#pragma unroll
    for (int kk = 0; kk < 2; kk++)
#pragma unroll
      for (int e = 0; e < 8; e++) { float v = bf2f((bf16_t)qf[qt][kk][e]); ss += v * v; }
    ss += __shfl_xor(ss, 16); ss += __shfl_xor(ss, 32);
    qn2 = fmaxf(qn2, ss);
  }
#pragma unroll
  for (int o = 8; o >= 1; o >>= 1) qn2 = fmaxf(qn2, __shfl_xor(qn2, o));
  float* red = (float*)(smem + SM_BOR);
  if (lane == 0) red[wid] = qn2;
  __syncthreads();
  qn2 = fmaxf(fmaxf(red[0], red[1]), fmaxf(red[2], red[3]));
  float kmax2 = ((const float*)(gws(p) + OFF_MISC + MS_KMAX))[bh];
  float qkmax = sqrtf(qn2 * kmax2) * pol.sc * 1.001f;
  float thr = -(128.f + 2.f * qkmax);
  int nt = qblk * 2 + 2;
  float fq0 = F[qblk * 128];
  u64 mlo, mhi;
  {
    int k0 = lane, k1 = lane + 64;
    bool n0 = (k0 < nt) && (k0 >= nt - 2 || fq0 - F[k0 * 64 + 63] >= thr);
    bool n1 = (k1 < nt) && (k1 >= nt - 2 || fq0 - F[(k1 < 128 ? k1 : 127) * 64 + 63] >= thr);
    mlo = __ballot(n0); mhi = __ballot(n1);
  }
  const bf16_t* vT = (const bf16_t*)(gws(p) + OFF_Y + 448 * MiB) + ((size_t)b * 512 + h * 64) * S_;
  attn_core<0, 2>(pol, smem, qf, Y + 512 + h * 64, YE_LD, vT, S_, F, mlo, mhi, o, m, l, nullptr);
  bf16_t* mix = (bf16_t*)(gws(p) + OFF_MIX) + (size_t)b * S_ * 1024;
#pragma unroll
  for (int qt = 0; qt < 2; qt++) {
    float lt = l[qt]; lt += __shfl_xor(lt, 16); lt += __shfl_xor(lt, 32);
    float inv = 1.f / lt;
#pragma unroll
    for (int dt = 0; dt < 4; dt++) {
      f32x4 v = o[dt][qt];
      *(uint2*)(mix + (size_t)(pol.tq0 + qt * 16) * 1024 + h * 64 + dt * 16 + fq * 4) = make_uint2(pack2(v[0] * inv, v[1] * inv), pack2(v[2] * inv, v[3] * inv));
    }
  }
}

DEVI void emit_afrag(const bf16_t* st, int ld, int nrt, int nkk, char* gdst) {
  for (int c = opaque_tid(); c < nrt * nkk * 64; c += 256) {
    int ln = c & 63, rk = c >> 6, rt = rk / nkk, kk = rk % nkk;
    int row = rt * 16 + (ln & 15), k0 = kk * 32 + (ln >> 4) * 4;
    uint2 a = *(const uint2*)&st[row * ld + k0], b = *(const uint2*)&st[row * ld + k0 + 16];
    *(uint4*)(gdst + (size_t)c * 16) = make_uint4(a.x, a.y, b.x, b.y);
  }
}

DEVI void gdn_pre_tile(const Params& p, int chunk, char* smem) {
  const int tid = opaque_tid(), lane = tid & 63, wid = tid >> 6, fr = lane & 15, fq = lane >> 4;
  int n = chunk & 127, h = (chunk >> 7) & 3, b = chunk >> 9;
  size_t tok0 = (size_t)b * S_ + n * 64;
  bf16_t* qn = (bf16_t*)smem;
  bf16_t* kn = (bf16_t*)(smem + 17408);
  bf16_t* vs = (bf16_t*)(smem + 34816);
  float* L = (float*)(smem + 53248);
  float* sbeta = (float*)(smem + 69632);
  float* sgc = sbeta + 64; float* seg = sbeta + 128; float* sbe = sbeta + 192;
  const bf16_t* Y = (const bf16_t*)(gws(p) + OFF_Y);
  const float* ysm = (const float*)(gws(p) + OFF_SM);
  char* gbase = gws(p) + OFF_X + (size_t)chunk * GDN_CH_BYTES;
  if (tid < 64) {
    float gb = ysm[(tok0 + tid) * 32 + 8 + h], ga = ysm[(tok0 + tid) * 32 + 12 + h];
    float beta = sigmoidf_(gb);
    float g = -expf(gin(p, 7)[h]) * softplusf_(ga + gin(p, 8)[h]);
    float gc = g;
#pragma unroll
    for (int o = 1; o < 64; o <<= 1) { float t = __shfl_up(gc, o); if (lane >= o) gc += t; }
    float eg = expf(gc);
    sbeta[tid] = beta; sgc[tid] = gc; seg[tid] = eg; sbe[tid] = beta * eg;
    if (tid == 63) ((float*)(gws(p) + OFF_MISC + MS_EGL))[chunk] = eg;
  }
  {
    int dc = tid & 15, tg = tid >> 4, d0 = dc * 8;
#pragma unroll 1
    for (int mat = 0; mat < 3; mat++) {
      int col = 1536 + mat * 512 + h * 128 + d0;
      int cch = mat * 512 + h * 128 + d0;
      float w[4][8];
#pragma unroll
      for (int j = 0; j < 4; j++)
#pragma unroll
        for (int e = 0; e < 8; e++) w[j][e] = gin(p, 6)[j * 1536 + cch + e];
      uint4 xr[7];
#pragma unroll
      for (int i = 0; i < 7; i++) {
        int lt = tg * 4 - 3 + i;
        if (n * 64 + lt >= 0) xr[i] = *(const uint4*)(Y + (tok0 + lt) * YE_LD + col); else xr[i] = make_uint4(0, 0, 0, 0);
      }
#pragma unroll
      for (int tt = 0; tt < 4; tt++) {
        float x[8];
#pragma unroll
        for (int e = 0; e < 8; e++) x[e] = 0.f;
#pragma unroll
        for (int j = 0; j < 4; j++) {
          uint4 v = xr[tt + j];
          x[0] += w[j][0] * lo2f(v.x); x[1] += w[j][1] * hi2f(v.x); x[2] += w[j][2] * lo2f(v.y); x[3] += w[j][3] * hi2f(v.y);
          x[4] += w[j][4] * lo2f(v.z); x[5] += w[j][5] * hi2f(v.z); x[6] += w[j][6] * lo2f(v.w); x[7] += w[j][7] * hi2f(v.w);
        }
        float ss = 0.f;
#pragma unroll
        for (int e = 0; e < 8; e++) { x[e] = x[e] * sigmoidf_(x[e]); ss += x[e] * x[e]; }
        float sc = 1.f;
        if (mat < 2) {
          ss += __shfl_xor(ss, 1); ss += __shfl_xor(ss, 2); ss += __shfl_xor(ss, 4); ss += __shfl_xor(ss, 8);
          sc = rsqrtf(ss + 1e-6f) * (mat == 0 ? 0.08838834764831845f : 1.f);
        }
        bf16_t* dst = (mat == 0 ? qn : (mat == 1 ? kn : vs)) + (tg * 4 + tt) * 136 + d0;
        *(uint4*)dst = make_uint4(pack2(x[0] * sc, x[1] * sc), pack2(x[2] * sc, x[3] * sc), pack2(x[4] * sc, x[5] * sc), pack2(x[6] * sc, x[7] * sc));
      }
    }
  }
  __syncthreads();
  {
    bf16x8 ka[4], qa[4];
#pragma unroll
    for (int kk = 0; kk < 4; kk++) {
      ka[kk] = *(const bf16x8*)&kn[(wid * 16 + fr) * 136 + kk * 32 + fq * 8];
      qa[kk] = *(const bf16x8*)&qn[(wid * 16 + fr) * 136 + kk * 32 + fq * 8];
    }
#pragma unroll
    for (int ct = 0; ct < 4; ct++) {
      f32x4 aL = {0.f, 0.f, 0.f, 0.f}, aA = {0.f, 0.f, 0.f, 0.f};
#pragma unroll
      for (int kk = 0; kk < 4; kk++) {
        bf16x8 kb = *(const bf16x8*)&kn[(ct * 16 + fr) * 136 + kk * 32 + fq * 8];
        aL = mfma16(ka[kk], kb, aL);
        aA = mfma16(qa[kk], kb, aA);
      }
      int j = ct * 16 + fr;
      float gj = sgc[j];
#pragma unroll
      for (int r = 0; r < 4; r++) {
        int i = wid * 16 + fq * 4 + r;
        float dec = (i >= j) ? expf(sgc[i] - gj) : 0.f;
        L[i * 64 + j] = (i > j) ? sbeta[i] * aL[r] * dec : 0.f;
        float av = aA[r] * dec;
        int kk2 = j >> 5, within = j & 31, tt = within >> 4, qd = (within & 15) >> 2, jj = within & 3;
        int ln = qd * 16 + (i & 15);
        *(bf16_t*)(gbase + 49152 + ((size_t)((wid * 2 + kk2) * 64 + ln)) * 16 + (tt * 4 + jj) * 2) = f2bf(av);
      }
    }
  }
  __syncthreads();
  float x[64];
  {
    const int c = tid;
    const bf16_t* rsrc = (c < 128) ? (vs + c) : (kn + (c - 128));
    const float* rsc = (c < 128) ? sbeta : sbe;
#pragma unroll
    for (int i = 0; i < 64; i++) {
      float r = bf2f(rsrc[i * 136]) * rsc[i];
#pragma unroll
      for (int j4 = 0; j4 < (i + 3) / 4; j4++) {
        float4 lv = *(const float4*)&L[i * 64 + j4 * 4];
        if (j4 * 4 + 0 < i) r -= lv.x * x[j4 * 4 + 0];
        if (j4 * 4 + 1 < i) r -= lv.y * x[j4 * 4 + 1];
        if (j4 * 4 + 2 < i) r -= lv.z * x[j4 * 4 + 2];
        if (j4 * 4 + 3 < i) r -= lv.w * x[j4 * 4 + 3];
      }
      x[i] = r;
    }
  }
  __syncthreads();
  if (tid >= 128) {
#pragma unroll
    for (int i = 0; i < 64; i++) vs[i * 136 + (tid - 128)] = f2bf(x[i]);
  }
  __syncthreads();
  emit_afrag(vs, 136, 4, 4, gbase);
  __syncthreads();
  if (tid < 128) {
#pragma unroll
    for (int i = 0; i < 64; i++) vs[i * 136 + tid] = f2bf(x[i]);
  }
  __syncthreads();
  for (int c = tid; c < 2048; c += 256) {
    int ln = c & 63, rt = (c >> 6) & 3, ds = c >> 8;
    int row = rt * 16 + (ln >> 4) * 4, col = ds * 16 + (ln & 15);
    unsigned a = (unsigned)vs[row * 136 + col] | ((unsigned)vs[(row + 1) * 136 + col] << 16);
    unsigned bq = (unsigned)vs[(row + 2) * 136 + col] | ((unsigned)vs[(row + 3) * 136 + col] << 16);
    *(uint2*)(gbase + 57344 + (size_t)c * 8) = make_uint2(a, bq);
  }
  __syncthreads();
  for (int e = tid; e < 64 * 128; e += 256) { int i = e >> 7, d = e & 127; vs[i * 136 + d] = f2bf(bf2f(qn[i * 136 + d]) * seg[i]); }
  __syncthreads();
  emit_afrag(vs, 136, 4, 4, gbase + 16384);
  __syncthreads();
  {
    float gl = sgc[63];
    for (int e = tid; e < 64 * 128; e += 256) { int j = e >> 7, d = e & 127; vs[d * 72 + j] = f2bf(bf2f(kn[j * 136 + d]) * expf(gl - sgc[j])); }
  }
  __syncthreads();
  emit_afrag(vs, 72, 8, 2, gbase + 32768);
  __syncthreads();
}

DEVI void gdn_scan_item(const Params& p, int item, char* smem) {
  const int tid = opaque_tid(), lane = tid & 63, wid = tid >> 6, fr = lane & 15, fq = lane >> 4;
  int bh = item >> 1, half = item & 1, ds = half * 4 + wid, b = bh >> 2, h = bh & 3;
  const float* eglp = (const float*)(gws(p) + OFF_MISC + MS_EGL) + bh * 128;
  bf16_t* Yo = (bf16_t*)(gws(p) + OFF_Y) + (size_t)b * S_ * YE_LD + 1536 + h * 128 + ds * 16 + fr;
  char* bufA = smem;
  char* bufB = smem + 32768;
  const char* gbase = gws(p) + OFF_X + (size_t)(bh * 128) * GDN_CH_BYTES;
  uint4 ra0, ra1, ra2, ra3, ra4, ra5, ra6, ra7, rb0, rb1, rb2, rb3, rb4, rb5, rb6, rb7;
#define SCAN_GLOAD(n) do { const char* cb = gbase + (size_t)(n) * GDN_CH_BYTES; \
    ra0 = GLD16(cb + (size_t)(tid + 0) * 16); \
    ra1 = GLD16(cb + (size_t)(tid + 256) * 16); \
    ra2 = GLD16(cb + (size_t)(tid + 512) * 16); \
    ra3 = GLD16(cb + (size_t)(tid + 768) * 16); \
    ra4 = GLD16(cb + (size_t)(tid + 1024) * 16); \
    ra5 = GLD16(cb + (size_t)(tid + 1280) * 16); \
    ra6 = GLD16(cb + (size_t)(tid + 1536) * 16); \
    ra7 = GLD16(cb + (size_t)(tid + 1792) * 16); \
    rb0 = GLD16(cb + 32768 + (size_t)(tid + 0) * 16); \
    rb1 = GLD16(cb + 32768 + (size_t)(tid + 256) * 16); \
    rb2 = GLD16(cb + 32768 + (size_t)(tid + 512) * 16); \
    rb3 = GLD16(cb + 32768 + (size_t)(tid + 768) * 16); \
    rb4 = GLD16(cb + 32768 + (size_t)(tid + 1024) * 16); \
    rb5 = GLD16(cb + 32768 + (size_t)(tid + 1280) * 16); \
    rb6 = GLD16(cb + 57344 + half * 8192 + (size_t)(tid + 0) * 16); \
    rb7 = GLD16(cb + 57344 + half * 8192 + (size_t)(tid + 256) * 16); \
  } while (0)
#define SCAN_SSTORE() do { \
    *(uint4*)(bufA + (tid + 0) * 16) = ra0; *(uint4*)(bufB + (tid + 0) * 16) = rb0; \
    *(uint4*)(bufA + (tid + 256) * 16) = ra1; *(uint4*)(bufB + (tid + 256) * 16) = rb1; \
    *(uint4*)(bufA + (tid + 512) * 16) = ra2; *(uint4*)(bufB + (tid + 512) * 16) = rb2; \
    *(uint4*)(bufA + (tid + 768) * 16) = ra3; *(uint4*)(bufB + (tid + 768) * 16) = rb3; \
    *(uint4*)(bufA + (tid + 1024) * 16) = ra4; *(uint4*)(bufB + (tid + 1024) * 16) = rb4; \
    *(uint4*)(bufA + (tid + 1280) * 16) = ra5; *(uint4*)(bufB + (tid + 1280) * 16) = rb5; \
    *(uint4*)(bufA + (tid + 1536) * 16) = ra6; *(uint4*)(bufB + (tid + 1536) * 16) = rb6; \
    *(uint4*)(bufA + (tid + 1792) * 16) = ra7; *(uint4*)(bufB + (tid + 1792) * 16) = rb7; \
  } while (0)
  SCAN_GLOAD(0);
  SCAN_SSTORE();
  __syncthreads();
  f32x4 S[8];
#pragma unroll
  for (int i = 0; i < 8; i++) S[i] = f32x4{0.f, 0.f, 0.f, 0.f};
#pragma unroll 1
  for (int n = 0; n < 128; n++) {
    if (n + 1 < 128) SCAN_GLOAD(n + 1);
    float egl = eglp[n];
    bf16x8 sb[4];
#pragma unroll
    for (int kk = 0; kk < 4; kk++)
      sb[kk] = mk8(pack2(S[2 * kk][0], S[2 * kk][1]), pack2(S[2 * kk][2], S[2 * kk][3]), pack2(S[2 * kk + 1][0], S[2 * kk + 1][1]), pack2(S[2 * kk + 1][2], S[2 * kk + 1][3]));
    f32x4 vn[4], oo[4];
#pragma unroll
    for (int rt = 0; rt < 4; rt++) {
      f32x4 acc = {0.f, 0.f, 0.f, 0.f};
#pragma unroll
      for (int kk = 0; kk < 4; kk++) acc = mfma16(*(const bf16x8*)(bufA + ((rt * 4 + kk) * 64 + lane) * 16), sb[kk], acc);
      uint2 uu = *(const uint2*)(bufB + 24576 + ((wid * 4 + rt) * 64 + lane) * 8);
      vn[rt] = f32x4{lo2f(uu.x) - acc[0], hi2f(uu.x) - acc[1], lo2f(uu.y) - acc[2], hi2f(uu.y) - acc[3]};
    }
#pragma unroll
    for (int rt = 0; rt < 4; rt++) {
      f32x4 acc = {0.f, 0.f, 0.f, 0.f};
#pragma unroll
      for (int kk = 0; kk < 4; kk++) acc = mfma16(*(const bf16x8*)(bufA + 16384 + ((rt * 4 + kk) * 64 + lane) * 16), sb[kk], acc);
      oo[rt] = acc;
    }
    bf16x8 vb[2];
#pragma unroll
    for (int k2 = 0; k2 < 2; k2++)
      vb[k2] = mk8(pack2(vn[2 * k2][0], vn[2 * k2][1]), pack2(vn[2 * k2][2], vn[2 * k2][3]), pack2(vn[2 * k2 + 1][0], vn[2 * k2 + 1][1]), pack2(vn[2 * k2 + 1][2], vn[2 * k2 + 1][3]));
#pragma unroll
    for (int rt = 0; rt < 4; rt++)
#pragma unroll
      for (int k2 = 0; k2 < 2; k2++) oo[rt] = mfma16(*(const bf16x8*)(bufB + 16384 + ((rt * 2 + k2) * 64 + lane) * 16), vb[k2], oo[rt]);
#pragma unroll
    for (int dk = 0; dk < 8; dk++) {
      f32x4 acc = S[dk] * egl;
#pragma unroll
      for (int k2 = 0; k2 < 2; k2++) acc = mfma16(*(const bf16x8*)(bufB + ((dk * 2 + k2) * 64 + lane) * 16), vb[k2], acc);
      S[dk] = acc;
    }
#pragma unroll
    for (int rt = 0; rt < 4; rt++)
#pragma unroll
      for (int r = 0; r < 4; r++) Yo[(size_t)(n * 64 + rt * 16 + fq * 4 + r) * YE_LD] = f2bf(oo[rt][r]);
    __syncthreads();
    if (n + 1 < 128) SCAN_SSTORE();
    __syncthreads();
  }
#undef SCAN_GLOAD
#undef SCAN_SSTORE
}

DEVI void phase_gdn_post(const Params& p) {
  int lane = opaque_tid() & 63;
  int gw = blockIdx.x * 4 + (opaque_tid() >> 6), nw = gridDim.x * 4;
  const bf16_t* Y = (const bf16_t*)(gws(p) + OFF_Y);
  bf16_t* mix = (bf16_t*)(gws(p) + OFF_MIX);
  int c0 = lane * 8;
  float nwv[8];
#pragma unroll
  for (int e = 0; e < 8; e++) nwv[e] = gin(p, 9)[(c0 & 127) + e];
  for (int row = gw; row < M_; row += nw) {
    uint4 ov = *(const uint4*)(Y + (size_t)row * YE_LD + 1536 + c0);
    uint4 zv = *(const uint4*)(Y + (size_t)row * YE_LD + 3072 + c0);
    float o[8] = {lo2f(ov.x), hi2f(ov.x), lo2f(ov.y), hi2f(ov.y), lo2f(ov.z), hi2f(ov.z), lo2f(ov.w), hi2f(ov.w)};
    float z[8] = {lo2f(zv.x), hi2f(zv.x), lo2f(zv.y), hi2f(zv.y), lo2f(zv.z), hi2f(zv.z), lo2f(zv.w), hi2f(zv.w)};
    float ss = 0.f;
#pragma unroll
    for (int e = 0; e < 8; e++) ss += o[e] * o[e];
    ss += __shfl_xor(ss, 1); ss += __shfl_xor(ss, 2); ss += __shfl_xor(ss, 4); ss += __shfl_xor(ss, 8);
    float rs = rsqrtf(ss * (1.f / 128.f) + 1e-6f);
    float r[8];
#pragma unroll
    for (int e = 0; e < 8; e++) r[e] = o[e] * rs * nwv[e] * (z[e] * sigmoidf_(z[e]));
    *(uint4*)(mix + (size_t)row * 1024 + 512 + c0) = make_uint4(pack2(r[0], r[1]), pack2(r[2], r[3]), pack2(r[4], r[5]), pack2(r[6], r[7]));
  }
}

struct ALoadCmp {
  const bf16_t* Y; const float* pe; int mt; int col0; int lr, lc;
  DEVI void init(int lr_, int lc_) { lr = lr_; lc = lc_; }
  DEVI uint4 load(int i, int kin) const {
    int row = lr + i * 32, k = kin + lc;
    int R = mt * 128 + row; if (R > 8175) R = 8175;
    int bn = R >> 1, g = R & 1, b = bn / 511, n = bn - b * 511;
    int l = k >> 6, d = k & 63;
    uint4 v = *(const uint4*)(Y + ((size_t)b * S_ + 16 * n + l) * YO_LD + col0 + g * 64 + d);
    const float4* pp = (const float4*)(pe + l * 64 + d);
    float4 p0 = pp[0], p1 = pp[1];
    return make_uint4(pack2(lo2f(v.x) + p0.x, hi2f(v.x) + p0.y), pack2(lo2f(v.y) + p0.z, hi2f(v.y) + p0.w),
                      pack2(lo2f(v.z) + p1.x, hi2f(v.z) + p1.y), pack2(lo2f(v.w) + p1.z, hi2f(v.w) + p1.w));
  }
};
DEVI void cmp_tile(const Params& p, int tile, char* smem) {
  const int tid = opaque_tid(), lane = tid & 63, wid = tid >> 6, wr = wid >> 1, wc = wid & 1, fr = lane & 15, fq = lane >> 4;
  int kv = tile >> 6, mt = tile & 63;
  const bf16_t* WT = (const bf16_t*)(gws(p) + OFF_WT);
  ALoadCmp al{(const bf16_t*)(gws(p) + OFF_Y), gin(p, kv ? 16 : 13), mt, kv ? 640 : 512, 0, 0};
  f32x4 acc[4][4]; zero_acc(acc);
  gemm_mainloop<false>(al, WT + (kv ? WT_CV1 : WT_CK1), 2048, 2048, smem, acc);
  bf16_t* hid = (bf16_t*)smem;
  bf16_t* w2 = (bf16_t*)(smem + 34816);
#pragma unroll
  for (int i = 0; i < 4; i++)
#pragma unroll
    for (int j = 0; j < 4; j++)
#pragma unroll
      for (int r = 0; r < 4; r++) hid[(wr * 64 + i * 16 + fq * 4 + r) * 136 + wc * 64 + j * 16 + fr] = f2bf(gelu_tanh(acc[i][j][r]));
  const bf16_t* w2g = WT + (kv ? WT_CV2 : WT_CK2);
  for (int c = tid; c < 1024; c += 256) { int row = c >> 4, ch = (c & 15) * 8; *(uint4*)&w2[row * 136 + ch] = *(const uint4*)(w2g + row * 128 + ch); }
  __syncthreads();
  f32x4 a2[2][4];
#pragma unroll
  for (int i = 0; i < 2; i++)
#pragma unroll
    for (int j = 0; j < 4; j++) a2[i][j] = f32x4{0.f, 0.f, 0.f, 0.f};
#pragma unroll
  for (int kk = 0; kk < 4; kk++) {
    bf16x8 af[2], bfv[4];
#pragma unroll
    for (int i = 0; i < 2; i++) af[i] = *(const bf16x8*)&hid[(wid * 32 + i * 16 + fr) * 136 + kk * 32 + fq * 8];
#pragma unroll
    for (int j = 0; j < 4; j++) bfv[j] = *(const bf16x8*)&w2[(j * 16 + fr) * 136 + kk * 32 + fq * 8];
#pragma unroll
    for (int i = 0; i < 2; i++)
#pragma unroll
      for (int j = 0; j < 4; j++) a2[i][j] = mfma16(af[i], bfv[j], a2[i][j]);
  }
  bf16_t* kc = (bf16_t*)(gws(p) + OFF_MISC + MS_KCMP);
  bf16_t* vc = (bf16_t*)(gws(p) + OFF_MISC + MS_VCMPT);
#pragma unroll
  for (int i = 0; i < 2; i++)
#pragma unroll
    for (int r = 0; r < 4; r++) {
      int R = mt * 128 + wid * 32 + i * 16 + fq * 4 + r;
      if (R < 8176) {
        int bn = R >> 1, g = R & 1, b = bn / 511, n = bn - b * 511;
#pragma unroll
        for (int j = 0; j < 4; j++) {
          int d = j * 16 + fr;
          if (kv == 0) kc[(((size_t)b * 512 + n) * 2 + g) * 64 + d] = f2bf(a2[i][j][r]);
          else vc[(((size_t)b * 2 + g) * 64 + d) * 512 + n] = f2bf(a2[i][j][r]);
        }
      }
    }
  __syncthreads();
}

template <bool OUT>
DEVI void rglru_tile(const Params& p, int tile, char* smem) {
  const int tid = opaque_tid(), lane = tid & 63, wid = tid >> 6, fr = lane & 15, fq = lane >> 4;
  int nb = tile & 7, seg = (tile >> 3) & 127, b = tile >> 10;
  size_t tok0 = (size_t)b * S_ + seg * 64;
  float* xs = (float*)smem;
  bf16_t* xb = (bf16_t*)(smem + 16640);
  float* as = (float*)(smem + 25856);
  float* bs = (float*)(smem + 42496);
  const bf16_t* Y = (const bf16_t*)(gws(p) + OFF_Y);
  float* agg = (float*)(gws(p) + OFF_MISC + MS_RGAGG);
  {
    int t = tid >> 2, c0 = (tid & 3) * 16, ch = nb * 64 + c0;
    float x[16];
#pragma unroll
    for (int e = 0; e < 16; e++) x[e] = gin(p, 20)[ch + e];
#pragma unroll
    for (int j = 0; j < 4; j++) {
      int lt = t - 3 + j;
      if (seg * 64 + lt >= 0) {
        const uint4* src = (const uint4*)(Y + (tok0 + lt) * YO_LD + 1792 + ch);
        uint4 v0 = src[0], v1 = src[1];
        const float* w = gin(p, 19) + j * 512 + ch;
        x[0] += w[0] * lo2f(v0.x); x[1] += w[1] * hi2f(v0.x); x[2] += w[2] * lo2f(v0.y); x[3] += w[3] * hi2f(v0.y);
        x[4] += w[4] * lo2f(v0.z); x[5] += w[5] * hi2f(v0.z); x[6] += w[6] * lo2f(v0.w); x[7] += w[7] * hi2f(v0.w);
        x[8] += w[8] * lo2f(v1.x); x[9] += w[9] * hi2f(v1.x); x[10] += w[10] * lo2f(v1.y); x[11] += w[11] * hi2f(v1.y);
        x[12] += w[12] * lo2f(v1.z); x[13] += w[13] * hi2f(v1.z); x[14] += w[14] * lo2f(v1.w); x[15] += w[15] * hi2f(v1.w);
      }
    }
#pragma unroll
    for (int e = 0; e < 16; e++) { xs[t * 65 + c0 + e] = x[e]; xb[t * 72 + c0 + e] = f2bf(x[e]); }
  }
  __syncthreads();
  {
    const bf16_t* WT = (const bf16_t*)(gws(p) + OFF_WT);
    const bf16_t* wa = WT + WT_RGA + nb * 4096;
    const bf16_t* wx = WT + WT_RGX + nb * 4096;
    bf16x8 af[2];
#pragma unroll
    for (int kk = 0; kk < 2; kk++) af[kk] = *(const bf16x8*)&xb[(wid * 16 + fr) * 72 + kk * 32 + fq * 8];
#pragma unroll
    for (int j = 0; j < 4; j++) {
      f32x4 aA = {0.f, 0.f, 0.f, 0.f}, aX = {0.f, 0.f, 0.f, 0.f};
#pragma unroll
      for (int kk = 0; kk < 2; kk++) {
        aA = mfma16(af[kk], *(const bf16x8*)(wa + (j * 16 + fr) * 64 + kk * 32 + fq * 8), aA);
        aX = mfma16(af[kk], *(const bf16x8*)(wx + (j * 16 + fr) * 64 + kk * 32 + fq * 8), aX);
      }
      int c = j * 16 + fr, chn = nb * 64 + c;
      float ba = gin(p, 22)[chn], bx = gin(p, 24)[chn];
      float spl = softplusf_(-gin(p, 25)[chn]);
#pragma unroll
      for (int r = 0; r < 4; r++) {
        int t = wid * 16 + fq * 4 + r;
        float rr = sigmoidf_(aA[r] + ba), ig = sigmoidf_(aX[r] + bx);
        float la = -8.f * spl * rr;
        as[t * 65 + c] = expf(la);
        bs[t * 65 + c] = sqrtf(-expm1f(2.f * la)) * ig * xs[t * 65 + c];
      }
    }
  }
  __syncthreads();
  if (!OUT) {
    {
      int c = tid & 63, part = tid >> 6;
      float A = 1.f, Bv = 0.f;
#pragma unroll
      for (int t = 0; t < 16; t++) { float a = as[(part * 16 + t) * 65 + c]; Bv = a * Bv + bs[(part * 16 + t) * 65 + c]; A *= a; }
      float2* cw2 = (float2*)(smem + 61184);
      cw2[part * 64 + c] = make_float2(A, Bv);
      __syncthreads();
      if (tid < 64) {
        float At = 1.f, Bt = 0.f;
#pragma unroll
        for (int pp = 0; pp < 4; pp++) { float2 ab = cw2[pp * 64 + tid]; Bt = ab.x * Bt + ab.y; At *= ab.x; }
        float2* dst = (float2*)agg + ((size_t)(b * 128 + seg) * 512 + nb * 64 + tid);
        *dst = make_float2(At, Bt);
      }
    }
  } else {
    {
      int c = tid & 63, part = tid >> 6;
      int per = (seg + 3) >> 2, s_lo = part * per, s_hi = min(seg, s_lo + per);
      const float2* src = (const float2*)agg + ((size_t)(b * 128) * 512 + nb * 64 + c);
      float A = 1.f, Bv = 0.f;
#pragma unroll 8
      for (int s2 = s_lo; s2 < s_hi; s2++) { float2 ab = src[(size_t)s2 * 512]; Bv = ab.x * Bv + ab.y; A *= ab.x; }
      float2* cw = (float2*)(smem + 59136);
      cw[part * 64 + c] = make_float2(A, Bv);
    }
    __syncthreads();
    {
      int c = tid & 63, part = tid >> 6;
      float A = 1.f, Bv = 0.f;
#pragma unroll
      for (int t = 0; t < 16; t++) { float a = as[(part * 16 + t) * 65 + c]; Bv = a * Bv + bs[(part * 16 + t) * 65 + c]; A *= a; }
      float2* cw2 = (float2*)(smem + 61184);
      cw2[part * 64 + c] = make_float2(A, Bv);
      __syncthreads();
      const float2* cw = (const float2*)(smem + 59136);
      float hh = 0.f;
#pragma unroll
      for (int pp = 0; pp < 4; pp++) { float2 ab = cw[pp * 64 + c]; hh = ab.x * hh + ab.y; }
      for (int pp = 0; pp < part; pp++) { float2 ab = cw2[pp * 64 + c]; hh = ab.x * hh + ab.y; }
#pragma unroll
      for (int t = 0; t < 16; t++) { int ti = (part * 16 + t) * 65 + c; hh = as[ti] * hh + bs[ti]; bs[ti] = hh; }
    }
    __syncthreads();
    int t = tid >> 2, c0 = (tid & 3) * 16, ch = nb * 64 + c0;
    const uint4* gsrc = (const uint4*)(Y + (tok0 + t) * YO_LD + 1280 + ch);
    uint4 g0 = gsrc[0], g1 = gsrc[1];
    float gv[16] = {lo2f(g0.x), hi2f(g0.x), lo2f(g0.y), hi2f(g0.y), lo2f(g0.z), hi2f(g0.z), lo2f(g0.w), hi2f(g0.w),
                    lo2f(g1.x), hi2f(g1.x), lo2f(g1.y), hi2f(g1.y), lo2f(g1.z), hi2f(g1.z), lo2f(g1.w), hi2f(g1.w)};
    float yv[16];
#pragma unroll
    for (int e = 0; e < 16; e++) yv[e] = bs[t * 65 + c0 + e] * gelu_tanh(gv[e]);
    uint4* dst = (uint4*)((bf16_t*)(gws(p) + OFF_MIX) + (tok0 + t) * 1024 + 512 + ch);
    dst[0] = make_uint4(pack2(yv[0], yv[1]), pack2(yv[2], yv[3]), pack2(yv[4], yv[5]), pack2(yv[6], yv[7]));
    dst[1] = make_uint4(pack2(yv[8], yv[9]), pack2(yv[10], yv[11]), pack2(yv[12], yv[13]), pack2(yv[14], yv[15]));
  }
  __syncthreads();
}

template <int BR>
struct NsaPol {
  static constexpr bool UB = true;
  int t; int tmin; int kb; const u64* selq; const u64* worq; float sc; bool selbit;
  DEVI float lane_bias() const { return (BR == 1 && !selbit) ? NEGF : 0.f; }
  DEVI bool active(int kb_) const {
    if (BR == 1) return (worq[kb_ >> 6] >> (kb_ & 63)) & 1;
    return true;
  }
  DEVI bool masked(int kb_) const {
    if (BR == 2) return !((kb_ * 64 + 63 <= tmin) && (tmin + 15 - kb_ * 64 < 512));
    if (BR == 1) return kb_ * 64 + 63 > tmin;
    return true;
  }
  DEVI void begin(int kb_, const float*) {
    kb = kb_;
    if (BR == 1) selbit = (selq[kb_ >> 6] >> (kb_ & 63)) & 1;
  }
  DEVI bool ok(int qt, int kl) const {
    int key = kb * 64 + kl;
    if (BR == 0) return (16 * key + 31 <= t) && (key < 511);
    if (BR == 1) return selbit && (key <= t);
    return (key <= t) && (t - key < 512);
  }
  DEVI f32x4 bias4(int) const { return f32x4{0.f, 0.f, 0.f, 0.f}; }
};

DEVI void nsa_tile(const Params& p, int item, char* smem) {
  const int tid = opaque_tid(), lane = tid & 63, wid = tid >> 6, fr = lane & 15, fq = lane >> 4;
  const int qg = wid >> 1, hp = wid & 1;
  int qb = 255 - (item >> 4), bg = item & 15, b = bg >> 1, g = bg & 1;
  int q0 = qb * 32, cur = q0 >> 6;
  int t = q0 + qg * 16 + fr;
  size_t mrow = (size_t)b * S_ + t;
  const bf16_t* Y = (const bf16_t*)(gws(p) + OFF_Y) + (size_t)b * S_ * YO_LD;
  const float* ysm = (const float*)(gws(p) + OFF_SM) + mrow * 32;
  float* impw = (float*)(smem + SM_IMP) + wid * (16 * 132);
  float* otot = impw;
  u64* selm = (u64*)(smem + SM_SELM) + qg * 32;
  u64* bor = (u64*)(smem + SM_BOR);
  bf16x8 qf[2][2];
#pragma unroll
  for (int qt = 0; qt < 2; qt++)
#pragma unroll
    for (int kk = 0; kk < 2; kk++) qf[qt][kk] = *(const bf16x8*)(Y + (size_t)t * YO_LD + (g * 4 + hp * 2 + qt) * 64 + kk * 32 + fq * 8);
  for (int i = lane; i < 16 * 132; i += 64) impw[i] = 0.f;
  f32x4 o[4][2];
  float m[2], l[2];
  const float sc = 0.125f * LOG2E;
  {
    int nkv = (q0 / 16) / 64 + 1; if (nkv > 8) nkv = 8;
    u64 mlo = (1ull << nkv) - 1;
    const bf16_t* Kg = (const bf16_t*)(gws(p) + OFF_MISC + MS_KCMP) + (size_t)b * 512 * 128 + g * 64;
    const bf16_t* Vt = (const bf16_t*)(gws(p) + OFF_MISC + MS_VCMPT) + ((size_t)b * 2 + g) * 64 * 512;
    NsaPol<0> pol; pol.t = t; pol.tmin = q0 + qg * 16; pol.kb = 0; pol.sc = sc; pol.selq = nullptr; pol.worq = nullptr; pol.selbit = false;
#pragma unroll
    for (int qt = 0; qt < 2; qt++) { m[qt] = NEGF; l[qt] = 0.f; }
    zero_o<2>(o);
    attn_core<1, 2>(pol, smem, qf, Kg, 128, Vt, 512, nullptr, mlo, 0ull, o, m, l, nullptr);
#pragma unroll
    for (int qt = 0; qt < 2; qt++) { float lt = l[qt]; lt += __shfl_xor(lt, 16); lt += __shfl_xor(lt, 32); l[qt] = lt > 0.f ? 1.f / lt : 0.f; }
    attn_core<2, 2>(pol, smem, qf, Kg, 128, Vt, 512, nullptr, mlo, 0ull, o, m, l, impw);
  }
  __syncthreads();
  {
    float* ia = (float*)(smem + SM_IMP) + (qg * 2) * (16 * 132);
    const float* ib = ia + 16 * 132;
#pragma unroll 1
    for (int qq = 0; qq < 8; qq++) {
      int q = hp * 8 + qq;
      float* iv = ia + q * 132;
      const float* ivb = ib + q * 132;
      float v0 = iv[lane] + ivb[lane], v1 = iv[lane + 64] + ivb[lane + 64];
      int c0 = 0, c1 = 0;
      if (cur >= 16) {
        iv[lane] = (lane >= 1 && lane <= cur - 2) ? v0 : -1.f;
        iv[lane + 64] = (lane + 64 <= cur - 2) ? v1 : -1.f;
        if (lane < 4) iv[128 + lane] = -1.f;
        const int n4 = (cur + 2) >> 2;
        for (int m4 = 0; m4 < n4; m4++) {
          float4 x = *(const float4*)&iv[m4 * 4];
          int mb = m4 * 4;
          c0 += (x.x > v0) || (x.x == v0 && mb + 0 < lane);
          c0 += (x.y > v0) || (x.y == v0 && mb + 1 < lane);
          c0 += (x.z > v0) || (x.z == v0 && mb + 2 < lane);
          c0 += (x.w > v0) || (x.w == v0 && mb + 3 < lane);
          c1 += (x.x > v1) || (x.x == v1 && mb + 0 < lane + 64);
          c1 += (x.y > v1) || (x.y == v1 && mb + 1 < lane + 64);
          c1 += (x.z > v1) || (x.z == v1 && mb + 2 < lane + 64);
          c1 += (x.w > v1) || (x.w == v1 && mb + 3 < lane + 64);
        }
      }
      int m0 = lane, m1 = lane + 64;
      bool s0, s1;
      if (cur < 16) { s0 = m0 <= cur; s1 = false; }
      else {
        s0 = (m0 == 0) || (m0 == cur) || (m0 == cur - 1) || (m0 >= 1 && m0 <= cur - 2 && 3 + c0 < 16);
        s1 = (m1 == cur) || (m1 == cur - 1) || (m1 <= cur - 2 && 3 + c1 < 16);
      }
      u64 lo = __ballot(s0), hi = __ballot(s1);
      if (lane == 0) { selm[q * 2] = lo; selm[q * 2 + 1] = hi; }
    }
  }
  __syncthreads();
  {
    u64 wlo = selm[fr * 2], whi = selm[fr * 2 + 1];
#pragma unroll
    for (int off = 1; off < 16; off <<= 1) { wlo |= __shfl_xor(wlo, off); whi |= __shfl_xor(whi, off); }
    if (lane == 0) { bor[wid * 2] = wlo; bor[wid * 2 + 1] = whi; }
  }
#pragma unroll
  for (int dt = 0; dt < 4; dt++)
#pragma unroll
    for (int qt = 0; qt < 2; qt++) {
      f32x4 v = o[dt][qt]; float gg = sigmoidf_(ysm[(g * 4 + hp * 2 + qt) * 3 + 0]);
      otot[((dt * 2 + qt) * 2 + 0) * 64 + lane] = __uint_as_float(pack2(v[0] * gg, v[1] * gg));
      otot[((dt * 2 + qt) * 2 + 1) * 64 + lane] = __uint_as_float(pack2(v[2] * gg, v[3] * gg));
    }
  __syncthreads();
  u64 blo = bor[0] | bor[2] | bor[4] | bor[6], bhi = bor[1] | bor[3] | bor[5] | bor[7];
  {
    u64 clo = cur >= 63 ? ~0ull : ((1ull << (cur + 1)) - 1);
    u64 chi = cur < 64 ? 0ull : (cur >= 127 ? ~0ull : ((1ull << (cur - 63)) - 1));
    blo &= clo; bhi &= chi;
  }
  {
    NsaPol<1> pol; pol.t = t; pol.tmin = q0 + qg * 16; pol.kb = 0; pol.sc = sc; pol.selq = selm + fr * 2; pol.worq = bor + wid * 2; pol.selbit = false;
#pragma unroll
    for (int qt = 0; qt < 2; qt++) { m[qt] = NEGF; l[qt] = 0.f; }
    zero_o<2>(o);
    const bf16_t* Vt = (const bf16_t*)(gws(p) + OFF_Y + 288 * MiB) + ((size_t)b * 128 + g * 64) * S_;
    attn_core<0, 2>(pol, smem, qf, Y + 768 + g * 64, YO_LD, Vt, S_, nullptr, blo, bhi, o, m, l, nullptr);
#pragma unroll
    for (int qt = 0; qt < 2; qt++) {
      float lt = l[qt]; lt += __shfl_xor(lt, 16); lt += __shfl_xor(lt, 32);
      float sc2 = sigmoidf_(ysm[(g * 4 + hp * 2 + qt) * 3 + 1]) / lt;
#pragma unroll
      for (int dt = 0; dt < 4; dt++) {
        f32x4 v = o[dt][qt];
        unsigned a = __float_as_uint(otot[((dt * 2 + qt) * 2 + 0) * 64 + lane]), bq = __float_as_uint(otot[((dt * 2 + qt) * 2 + 1) * 64 + lane]);
        otot[((dt * 2 + qt) * 2 + 0) * 64 + lane] = __uint_as_float(pack2(lo2f(a) + v[0] * sc2, hi2f(a) + v[1] * sc2));
        otot[((dt * 2 + qt) * 2 + 1) * 64 + lane] = __uint_as_float(pack2(lo2f(bq) + v[2] * sc2, hi2f(bq) + v[3] * sc2));
      }
    }
  }
  {
    NsaPol<2> pol; pol.t = t; pol.tmin = q0 + qg * 16; pol.kb = 0; pol.sc = sc; pol.selq = nullptr; pol.worq = nullptr; pol.selbit = false;
#pragma unroll
    for (int qt = 0; qt < 2; qt++) { m[qt] = NEGF; l[qt] = 0.f; }
    zero_o<2>(o);
    int k0 = (q0 - 511) < 0 ? 0 : ((q0 - 511) >> 6);
    u64 wl = 0, wh = 0;
    for (int k = k0; k <= cur; k++) { if (k < 64) wl |= 1ull << k; else wh |= 1ull << (k - 64); }
    const bf16_t* Vt = (const bf16_t*)(gws(p) + OFF_Y + 304 * MiB) + ((size_t)b * 128 + g * 64) * S_;
    attn_core<0, 2>(pol, smem, qf, Y + 1024 + g * 64, YO_LD, Vt, S_, nullptr, wl, wh, o, m, l, nullptr);
    bf16_t* mix = (bf16_t*)(gws(p) + OFF_MIX) + mrow * 1024;
#pragma unroll
    for (int qt = 0; qt < 2; qt++) {
      float lt = l[qt]; lt += __shfl_xor(lt, 16); lt += __shfl_xor(lt, 32);
      float sc2 = sigmoidf_(ysm[(g * 4 + hp * 2 + qt) * 3 + 2]) / lt;
#pragma unroll
      for (int dt = 0; dt < 4; dt++) {
        f32x4 v = o[dt][qt];
        unsigned a = __float_as_uint(otot[((dt * 2 + qt) * 2 + 0) * 64 + lane]), bq = __float_as_uint(otot[((dt * 2 + qt) * 2 + 1) * 64 + lane]);
        *(uint2*)(mix + (g * 4 + hp * 2 + qt) * 64 + dt * 16 + fq * 4) =
            make_uint2(pack2(lo2f(a) + v[0] * sc2, hi2f(a) + v[1] * sc2), pack2(lo2f(bq) + v[2] * sc2, hi2f(bq) + v[3] * sc2));
      }
    }
  }
  __syncthreads();
}

DEVI int next_item(int* ctr, char* smem) {
  int* slot = (int*)(smem + SM_SLOT);
  __syncthreads();
  if (opaque_tid() == 0) *slot = atomicAdd(ctr, 1);
  __syncthreads();
  return *slot;
}

constexpr int NPHASE = 17;
DEVI void grid_bar(unsigned* ctr, unsigned target) {
  __syncthreads();
  if (threadIdx.x == 0) {
    __threadfence();
    __hip_atomic_fetch_add(ctr, 1u, __ATOMIC_RELAXED, __HIP_MEMORY_SCOPE_AGENT);
    while (__hip_atomic_load(ctr, __ATOMIC_RELAXED, __HIP_MEMORY_SCOPE_AGENT) < target) __builtin_amdgcn_s_sleep(8);
    __threadfence();
  }
  __syncthreads();
}
__global__ void __launch_bounds__(256, 2) mega(Params p, int ph0, int ph1) {
  extern __shared__ __attribute__((aligned(16))) char smem[];
  cg::grid_group grid = cg::this_grid();
  char* ws0 = p.ws;
#define PH(n, ...) if ((n) >= ph0 && (n) <= ph1) { \
    char* ws = ws0; asm volatile("" : "+s"(ws)); ws = as_global(ws); \
    const bf16_t* WT = (const bf16_t*)(ws + OFF_WT); bf16_t* hn = (bf16_t*)(ws + OFF_HN); bf16_t* Yb = (bf16_t*)(ws + OFF_Y); \
    bf16_t* mix = (bf16_t*)(ws + OFF_MIX); bf16_t* pbf = (bf16_t*)(ws + OFF_X); bf16_t* ppb = (bf16_t*)(ws + OFF_X + 32 * MiB); (void)ppb; int* ctr = (int*)(ws + OFF_MISC + MS_CTR); \
    Params* gp = (Params*)(ws + OFF_MISC + MS_PTAB); float* h = as_global(gp->out); \
    float* ss = (float*)(ws + OFF_MISC + MS_SS); bf16_t* hn2 = (bf16_t*)(ws + OFF_MIX); (void)ss; (void)hn2; (void)WT; (void)hn; (void)Yb; (void)mix; (void)pbf; (void)ctr; (void)h; \
    __VA_ARGS__ } if ((n) >= ph0 && (n) < ph1) grid.sync();
  PH(0, if (blockIdx.x == 0 && threadIdx.x < 34) gp->in[threadIdx.x] = p.in[threadIdx.x];
        if (blockIdx.x == 0 && threadIdx.x == 0) { gp->out = p.out; gp->ws = p.ws; gp->positions = p.positions; }
        phase_prep(p, smem); phase_xprep(p.in[0], hn, ss);)
  PH(1, phase_gemm_in<true>(*gp, hn, ss, smem);)
  PH(2, phase_fox_f(*gp, smem); for (int t = blockIdx.x; t < 4096; t += gridDim.x) gdn_pre_tile(*gp, t, smem);)
  PH(3, for (;;) { int it = next_item(ctr + 0, smem); if (it >= 64 + 4096) break; if (it < 64) gdn_scan_item(*gp, it, smem); else fox_tile(*gp, it - 64, smem); })
  PH(4, phase_gdn_post(*gp); phase_cvt_p(as_global(gp->in[1]), pbf);)
  PH(5, phase_gemm<EP_RESID>(mix, 1024, WT + WT_OUT_E, 1024, 8, nullptr, 0, as_global(gp->in[0]), h, hn, nullptr, ss + 1 * M_, smem);)
  PH(6, phase_gemm<EP_RELU2>(hn, 1024, WT + WT_UP, 1024, 32, Yb, 4096, nullptr, nullptr, nullptr, ss + 1 * M_, nullptr, smem); phase_pp(pbf, WT + WT_PROJ, ppb, smem);)
  PH(7, phase_gemm<EP_RESID>(Yb, 4096, WT + WT_DOWN, 4096, 8, nullptr, 0, h, h, hn, nullptr, ss + 2 * M_, smem);)
  PH(8, phase_ple(hn, WT + WT_GATE, ppb, h, hn2, ss + 2 * M_, ss + 3 * M_, smem);)
  PH(9, phase_gemm_in<false>(*gp, hn2, ss + 3 * M_, smem);)
  PH(10, for (int t = blockIdx.x; t < 128; t += gridDim.x) cmp_tile(*gp, t, smem); for (int t = blockIdx.x; t < 8192; t += gridDim.x) rglru_tile<false>(*gp, t, smem); phase_cvt_p(as_global(gp->in[1]) + (size_t)M_ * 256, pbf);)
  PH(11, for (;;) { int it = next_item(ctr + 1, smem); if (it >= 4096 + 8192) break; if (it < 4096) nsa_tile(*gp, it, smem); else rglru_tile<true>(*gp, it - 4096, smem); })
  PH(12, phase_gemm<EP_RESID>(mix, 1024, WT + WT_OUT_O, 1024, 8, nullptr, 0, h, h, hn, nullptr, ss + 4 * M_, smem);)
  PH(13, phase_gemm<EP_RELU2>(hn, 1024, WT + WT_UP + 4096 * 1024, 1024, 32, Yb, 4096, nullptr, nullptr, nullptr, ss + 4 * M_, nullptr, smem); phase_pp(pbf, WT + WT_PROJ + 1024 * 256, ppb, smem);)
  PH(14, phase_gemm<EP_RESID>(Yb, 4096, WT + WT_DOWN + 4096 * 1024, 4096, 8, nullptr, 0, h, h, hn, nullptr, ss + 5 * M_, smem);)
  PH(15, phase_ple(hn, WT + WT_GATE + 1024 * 1024, ppb, h, nullptr, ss + 5 * M_, nullptr, smem);)
  PH(16, phase_norm(h, as_global(gp->in[33]), nullptr, h);)
}

extern "C" void kernel_launch(void* const* d_in, const int* in_sizes, int n_in, void* d_out, int out_size, void* d_ws,
                              size_t ws_size, hipStream_t stream) {
  static int grid_blocks = 0;
  if (!grid_blocks) {
    hipFuncSetAttribute((const void*)mega, hipFuncAttributeMaxDynamicSharedMemorySize, LDS_BYTES);
    int dev = 0, cus = 0, per_cu = 0;
    hipGetDevice(&dev);
    hipDeviceGetAttribute(&cus, hipDeviceAttributeMultiprocessorCount, dev);
    hipOccupancyMaxActiveBlocksPerMultiprocessor(&per_cu, mega, 256, LDS_BYTES);
    if (per_cu > 2) per_cu = 2;
    if (per_cu < 1) per_cu = 1;
    grid_blocks = cus * per_cu;
  }
  Params p;
  memset((void*)&p, 0, sizeof(p));
  for (int i = 0; i < 34; i++) p.in[i] = (const float*)d_in[i];
  p.positions = (const int*)d_in[2];
  p.out = (float*)d_out;
  p.ws = (char*)d_ws;
  bf16_t* WT = (bf16_t*)((char*)d_ws + OFF_WT);
  auto F = [&](int i) { return (const float*)d_in[i]; };
  int nd = 0, t0 = 0;
  auto add = [&](const float* src, bf16_t* dst, int K, int N, int Nd, int kind, int nb, const float* scale) {
    p.wd[nd].src = src; p.wd[nd].dst = dst; p.wd[nd].scale = scale; p.wd[nd].K = K; p.wd[nd].N = N; p.wd[nd].Nd = Nd; p.wd[nd].kind = kind; p.wd[nd].nb = nb; p.wd[nd].tile0 = t0;
    t0 += nb * (K / 64) * (Nd / 64);
    nd++;
  };
  add(F(4), WT + WT_IN_E, 1024, 3600, 3712, 1, 1, F(3));
  add(F(10), WT + WT_OUT_E, 1024, 1024, 1024, 0, 1, nullptr);
  add(F(12), WT + WT_IN_O, 1024, 2328, 2432, 2, 1, F(11));
  add(F(26), WT + WT_OUT_O, 1024, 1024, 1024, 0, 1, nullptr);
  add(F(28), WT + WT_UP, 1024, 4096, 4096, 0, 2, F(27));
  add(F(29), WT + WT_DOWN, 4096, 1024, 1024, 0, 2, nullptr);
  add(F(31), WT + WT_GATE, 1024, 1024, 1024, 0, 2, F(30));
  add(F(32), WT + WT_PROJ, 256, 1024, 1024, 0, 2, nullptr);
  add(F(14), WT + WT_CK1, 2048, 128, 128, 0, 1, nullptr);
  add(F(17), WT + WT_CV1, 2048, 128, 128, 0, 1, nullptr);
  add(F(15), WT + WT_CK2, 128, 64, 64, 0, 1, nullptr);
  add(F(18), WT + WT_CV2, 128, 64, 64, 0, 1, nullptr);
  add(F(21), WT + WT_RGA, 64, 64, 64, 0, 8, nullptr);
  add(F(23), WT + WT_RGX, 64, 64, 64, 0, 8, nullptr);
  while (nd < NWD) { p.wd[nd].K = 64; p.wd[nd].N = 64; p.wd[nd].Nd = 64; p.wd[nd].tile0 = 0x7fffffff; nd++; }
  p.prep_tiles = t0;
  int ph0 = 0, ph1 = NPHASE - 1;
  void* args[] = {&p, &ph0, &ph1};
  hipError_t e = hipLaunchCooperativeKernel((void*)mega, dim3(grid_blocks), dim3(256), args, LDS_BYTES, stream);
  if (e != hipSuccess) fprintf(stderr, "cooperative launch failed: %s (grid %d)\n", hipGetErrorString(e), grid_blocks);
}
```

```cpp
#include <hip/hip_runtime.h>
#include <hip/hip_cooperative_groups.h>
#include <stdint.h>
#include <stdio.h>
#include <string.h>
namespace cg = cooperative_groups;

typedef unsigned short bf16_t;
typedef __attribute__((ext_vector_type(8))) short bf16x8;
typedef __attribute__((ext_vector_type(4))) float f32x4;
#define DEVI __device__ __forceinline__

constexpr int S_ = 8192, B_ = 8, M_ = 65536;
constexpr size_t MiB = 1ull << 20;
constexpr size_t OFF_WT = 0, OFF_Y = 64 * MiB, OFF_MIX = 576 * MiB, OFF_SM = 704 * MiB, OFF_MISC = 712 * MiB,
                 OFF_X = 736 * MiB, OFF_HN = 896 * MiB;
constexpr size_t WT_IN_E = 0;
constexpr size_t WT_OUT_E = WT_IN_E + 3712 * 1024;
constexpr size_t WT_IN_O = WT_OUT_E + 1024 * 1024;
constexpr size_t WT_OUT_O = WT_IN_O + 2432 * 1024;
constexpr size_t WT_UP = WT_OUT_O + 1024 * 1024;
constexpr size_t WT_DOWN = WT_UP + 2 * 4096 * 1024;
constexpr size_t WT_GATE = WT_DOWN + 2 * 4096 * 1024;
constexpr size_t WT_PROJ = WT_GATE + 2 * 1024 * 1024;
constexpr size_t WT_CK1 = WT_PROJ + 2 * 1024 * 256;
constexpr size_t WT_CV1 = WT_CK1 + 128 * 2048;
constexpr size_t WT_CK2 = WT_CV1 + 128 * 2048;
constexpr size_t WT_CV2 = WT_CK2 + 64 * 128;
constexpr size_t WT_RGA = WT_CV2 + 64 * 128;
constexpr size_t WT_RGX = WT_RGA + 8 * 64 * 64;
constexpr size_t MS_ROPE = 0;
constexpr size_t MS_FOXF = 4 * MiB;
constexpr size_t MS_EGL = 6 * MiB;
constexpr size_t MS_CTR = 6 * MiB + 65536;
constexpr size_t MS_KCMP = 7 * MiB;
constexpr size_t MS_VCMPT = 8 * MiB;
constexpr size_t MS_RGAGG = 9 * MiB;
constexpr size_t MS_PTAB = 13 * MiB;
constexpr size_t MS_KMAX = 14 * MiB;
constexpr size_t MS_SS = 15 * MiB;
constexpr int YE_LD = 3584, YO_LD = 2304;
constexpr int GDN_CH_BYTES = 73728;
constexpr int LDS_BYTES = 73728;
constexpr float LOG2E = 1.4426950408889634f;
constexpr float NEGF = -1e30f;

struct WDesc { const float* src; bf16_t* dst; const float* scale; int K, N, Nd, kind, nb, tile0; };
constexpr int NWD = 18;
struct Params {
  const float* in[34];
  const int* positions;
  float* out;
  char* ws;
  WDesc wd[NWD];
  int prep_tiles;
  int pad_;
};

template <class T> DEVI T* as_global(T* q) {
  typedef T __attribute__((address_space(1)))* gp_t;
  return (T*)((gp_t)q);
}
typedef unsigned v4u_t_ __attribute__((ext_vector_type(4)));
typedef float v4f_t_ __attribute__((ext_vector_type(4)));
DEVI uint4 gld16_(const void* q) { typedef const v4u_t_ __attribute__((address_space(1))) gv; v4u_t_ v = *(gv*)q; return make_uint4(v.x, v.y, v.z, v.w); }
DEVI float4 gldf4_(const void* q) { typedef const v4f_t_ __attribute__((address_space(1))) gv; v4f_t_ v = *(gv*)q; return make_float4(v.x, v.y, v.z, v.w); }
#define GLD16(ptr) gld16_(ptr)
#define GLDF4(ptr) gldf4_(ptr)
DEVI char* gws(const Params& p) { return as_global(p.ws); }
DEVI const float* gin(const Params& p, int i) { return as_global(p.in[i]); }
DEVI int opaque_tid() { int t = threadIdx.x; asm volatile("" : "+v"(t)); return t; }
DEVI bf16_t f2bf(float f) { unsigned u = __float_as_uint(f); u += 0x7fffu + ((u >> 16) & 1u); return (bf16_t)(u >> 16); }
DEVI float bf2f(bf16_t b) { return __uint_as_float(((unsigned)b) << 16); }
typedef __bf16 bf2_t_ __attribute__((ext_vector_type(2)));
typedef float f2_t_ __attribute__((ext_vector_type(2)));
DEVI unsigned pack2(float a, float b) { f2_t_ f = {a, b}; bf2_t_ hh = __builtin_convertvector(f, bf2_t_); return __builtin_bit_cast(unsigned, hh); }
DEVI float lo2f(unsigned u) { return __uint_as_float(u << 16); }
DEVI float hi2f(unsigned u) { return __uint_as_float(u & 0xffff0000u); }
DEVI f32x4 mfma16(bf16x8 a, bf16x8 b, f32x4 c) { return __builtin_amdgcn_mfma_f32_16x16x32_bf16(a, b, c, 0, 0, 0); }
DEVI float sigmoidf_(float x) { return 1.f / (1.f + __expf(-x)); }
DEVI float softplusf_(float x) { return fmaxf(x, 0.f) + log1pf(__expf(-fabsf(x))); }
DEVI float gelu_tanh(float x) { float u = 0.7978845608028654f * (x + 0.044715f * x * x * x); float e = __expf(-2.f * fabsf(u)); float t = (1.f - e) / (1.f + e); t = u < 0 ? -t : t; return 0.5f * x * (1.f + t); }
DEVI float fexp2(float x) { return __builtin_amdgcn_exp2f(x); }
DEVI bf16x8 mk8(unsigned a, unsigned b, unsigned c, unsigned d) { uint4 v = make_uint4(a, b, c, d); return __builtin_bit_cast(bf16x8, v); }

DEVI int colmap(int kind, int n) {
  if (kind == 0) return n;
  if (kind == 1) {
    if (n < 1536) return n;
    if (n < 3584) return n + 8;
    if (n < 3592) return 1536 + (n - 3584);
    if (n < 3600) return n;
    return -1;
  }
  if (n < 1280) return n;
  if (n < 2304) return n + 24;
  if (n < 2328) return 1280 + (n - 2304);
  return -1;
}

DEVI void phase_prep(const Params& p, char* smem) {
  float (*t)[65] = (float (*)[65])smem;
  int tid = opaque_tid();
  for (int tile = blockIdx.x; tile < p.prep_tiles; tile += gridDim.x) {
    int di = 0;
#pragma unroll 1
    for (int i = 1; i < NWD; i++) if (tile >= p.wd[i].tile0) di = i;
    const WDesc& w = p.wd[di];
    int lt = tile - w.tile0;
    int tk = w.K / 64, tn = w.Nd / 64;
    int bi = lt / (tk * tn); lt -= bi * tk * tn;
    int k0 = (lt / tn) * 64, n0 = (lt % tn) * 64;
    const float* src = w.src + (size_t)bi * w.K * w.N;
    bf16_t* dst = w.dst + (size_t)bi * w.Nd * w.K;
    int nl = tid & 63, kl = tid >> 6;
    int col = colmap(w.kind, n0 + nl);
    if (col >= w.N) col = -1;
#pragma unroll 4
    for (int pp = 0; pp < 16; pp++) {
      int k = kl + pp * 4;
      float scl = w.scale ? w.scale[bi * w.K + k0 + k] : 1.f;
      t[k][nl] = (col >= 0) ? src[(size_t)(k0 + k) * w.N + col] * scl : 0.f;
    }
    __syncthreads();
#pragma unroll 4
    for (int pp = 0; pp < 16; pp++) {
      int n = kl + pp * 4;
      dst[(size_t)(n0 + n) * w.K + k0 + nl] = f2bf(t[nl][n]);
    }
    __syncthreads();
  }
  float* rope = (float*)(gws(p) + OFF_MISC + MS_ROPE);
  int gt = blockIdx.x * 256 + tid, gs = gridDim.x * 256;
  for (int i = gt; i < M_ * 8; i += gs) {
    int m = i >> 3, f = i & 7;
    float invf = powf(500000.f, -(float)f * 0.125f);
    float ang = (float)p.positions[m] * invf;
    double n = rint((double)ang * 0.15915494309189535);
    float r = (float)((double)ang - n * 6.283185307179586);
    rope[m * 16 + f] = cosf(r);
    rope[m * 16 + 8 + f] = sinf(r);
  }
  if (gt < 16) ((int*)(gws(p) + OFF_MISC + MS_CTR))[gt] = 0;
  if (gt < 64) ((unsigned*)(gws(p) + OFF_MISC + MS_KMAX))[gt] = 0u;
  { float* ssz = (float*)(gws(p) + OFF_MISC + MS_SS); for (int i = M_ + gt; i < 6 * M_; i += gs) ssz[i] = 0.f; }
  bf16_t* kc = (bf16_t*)(gws(p) + OFF_MISC + MS_KCMP);
  bf16_t* vc = (bf16_t*)(gws(p) + OFF_MISC + MS_VCMPT);
  for (int i = gt; i < B_ * 128; i += gs) { int b = i >> 7, c = i & 127; kc[((size_t)b * 512 + 511) * 128 + c] = 0; vc[((size_t)b * 128 + c) * 512 + 511] = 0; }
}

DEVI void phase_norm(const float* __restrict__ src, const float* __restrict__ w, bf16_t* __restrict__ dstb, float* __restrict__ dstf) {
  int lane = opaque_tid() & 63;
  int gw = blockIdx.x * 4 + (opaque_tid() >> 6), nw = gridDim.x * 4;
  for (int row = gw; row < M_; row += nw) {
    const float4* s4 = (const float4*)(src + (size_t)row * 1024);
    float4 v[4]; float ss = 0.f;
#pragma unroll
    for (int i = 0; i < 4; i++) { v[i] = s4[lane + i * 64]; ss += v[i].x * v[i].x + v[i].y * v[i].y + v[i].z * v[i].z + v[i].w * v[i].w; }
#pragma unroll
    for (int o = 32; o >= 1; o >>= 1) ss += __shfl_xor(ss, o);
    float rs = rsqrtf(ss * (1.f / 1024.f) + 1e-6f);
#pragma unroll
    for (int i = 0; i < 4; i++) {
      float4 ww = ((const float4*)w)[lane + i * 64];
      float a = v[i].x * rs * ww.x, b = v[i].y * rs * ww.y, c = v[i].z * rs * ww.z, d = v[i].w * rs * ww.w;
      if (dstf) ((float4*)(dstf + (size_t)row * 1024))[lane + i * 64] = make_float4(a, b, c, d);
      else ((uint2*)(dstb + (size_t)row * 1024))[lane + i * 64] = make_uint2(pack2(a, b), pack2(c, d));
    }
  }
}
DEVI void phase_xprep(const float* __restrict__ src, bf16_t* __restrict__ dstb, float* __restrict__ ss) {
  int lane = opaque_tid() & 63;
  int gw = blockIdx.x * 4 + (opaque_tid() >> 6), nw = gridDim.x * 4;
  for (int row = gw; row < M_; row += nw) {
    const float4* s4 = (const float4*)(src + (size_t)row * 1024);
    float acc = 0.f;
#pragma unroll
    for (int i = 0; i < 4; i++) {
      float4 v = s4[lane + i * 64];
      acc += v.x * v.x + v.y * v.y + v.z * v.z + v.w * v.w;
      ((uint2*)(dstb + (size_t)row * 1024))[lane + i * 64] = make_uint2(pack2(v.x, v.y), pack2(v.z, v.w));
    }
#pragma unroll
    for (int o = 32; o >= 1; o >>= 1) acc += __shfl_xor(acc, o);
    if (lane == 0) ss[row] = acc;
  }
}
DEVI void phase_cvt_p(const float* __restrict__ src, bf16_t* __restrict__ dst) {
  size_t n4 = (size_t)M_ * 256 / 4;
  for (size_t i = (size_t)blockIdx.x * 256 + opaque_tid(); i < n4; i += (size_t)gridDim.x * 256) {
    float4 v = ((const float4*)src)[i];
    ((uint2*)dst)[i] = make_uint2(pack2(v.x, v.y), pack2(v.z, v.w));
  }
}

struct GemmSmem { bf16_t a[2][128][72]; bf16_t b[2][128][72]; };

struct ALoadPlain {
  const bf16_t* A; int lda; int toff;
  DEVI void init(int lr, int lc) { toff = lr * lda + lc; }
  DEVI uint4 load(int i, int k) const { const bf16_t* ub = A + ((size_t)(i * 32) * lda + k); return *(const uint4*)(ub + toff); }
};

template <bool SWAP, class AL>
DEVI void gemm_mainloop(const AL& al_in, const bf16_t* __restrict__ Bt, int ldb, int K, char* smem, f32x4 (&acc)[4][4]) {
  GemmSmem& sm = *(GemmSmem*)smem;
  const int tid = opaque_tid(), lane = tid & 63, wid = tid >> 6, wr = wid >> 1, wc = wid & 1;
  const int lr = tid >> 3, lc = (tid & 7) * 8;
  const int fr = lane & 15, fq = lane >> 4;
  uint4 ra0, ra1, ra2, ra3, rb0, rb1, rb2, rb3;
  uint4 qa0, qa1, qa2, qa3, qb0, qb1, qb2, qb3;
  const int btoff = lr * ldb + lc;
  AL al = al_in; al.init(lr, lc);
#define GL_A(k) do { ra0 = al.load(0, (k)); ra1 = al.load(1, (k)); ra2 = al.load(2, (k)); ra3 = al.load(3, (k)); \
    rb0 = *(const uint4*)(Bt + (k) + btoff); rb1 = *(const uint4*)(Bt + ((size_t)32 * ldb + (k)) + btoff); rb2 = *(const uint4*)(Bt + ((size_t)64 * ldb + (k)) + btoff); rb3 = *(const uint4*)(Bt + ((size_t)96 * ldb + (k)) + btoff); } while (0)
#define GL_B(k) do { qa0 = al.load(0, (k)); qa1 = al.load(1, (k)); qa2 = al.load(2, (k)); qa3 = al.load(3, (k)); \
    qb0 = *(const uint4*)(Bt + (k) + btoff); qb1 = *(const uint4*)(Bt + ((size_t)32 * ldb + (k)) + btoff); qb2 = *(const uint4*)(Bt + ((size_t)64 * ldb + (k)) + btoff); qb3 = *(const uint4*)(Bt + ((size_t)96 * ldb + (k)) + btoff); } while (0)
#define ST_A(bf) do { *(uint4*)&sm.a[bf][lr][lc] = ra0; *(uint4*)&sm.a[bf][lr + 32][lc] = ra1; *(uint4*)&sm.a[bf][lr + 64][lc] = ra2; *(uint4*)&sm.a[bf][lr + 96][lc] = ra3; \
    *(uint4*)&sm.b[bf][lr][lc] = rb0; *(uint4*)&sm.b[bf][lr + 32][lc] = rb1; *(uint4*)&sm.b[bf][lr + 64][lc] = rb2; *(uint4*)&sm.b[bf][lr + 96][lc] = rb3; } while (0)
#define ST_B(bf) do { *(uint4*)&sm.a[bf][lr][lc] = qa0; *(uint4*)&sm.a[bf][lr + 32][lc] = qa1; *(uint4*)&sm.a[bf][lr + 64][lc] = qa2; *(uint4*)&sm.a[bf][lr + 96][lc] = qa3; \
    *(uint4*)&sm.b[bf][lr][lc] = qb0; *(uint4*)&sm.b[bf][lr + 32][lc] = qb1; *(uint4*)&sm.b[bf][lr + 64][lc] = qb2; *(uint4*)&sm.b[bf][lr + 96][lc] = qb3; } while (0)
#define COMPUTE(bf) do { _Pragma("unroll") for (int kk = 0; kk < 2; kk++) { \
      bf16x8 af[4], bfr[4]; \
      _Pragma("unroll") for (int i = 0; i < 4; i++) af[i] = *(const bf16x8*)&sm.a[bf][wr * 64 + i * 16 + fr][kk * 32 + fq * 8]; \
      _Pragma("unroll") for (int j = 0; j < 4; j++) bfr[j] = *(const bf16x8*)&sm.b[bf][wc * 64 + j * 16 + fr][kk * 32 + fq * 8]; \
      __builtin_amdgcn_s_setprio(1); \
      _Pragma("unroll") for (int i = 0; i < 4; i++) _Pragma("unroll") for (int j = 0; j < 4; j++) \
          acc[i][j] = SWAP ? mfma16(bfr[j], af[i], acc[i][j]) : mfma16(af[i], bfr[j], acc[i][j]); \
      __builtin_amdgcn_s_setprio(0); } } while (0)
  const int nk = K >> 6;
  GL_A(0);
  ST_A(0);
  GL_A(64);
  __syncthreads();
  for (int kt = 0; kt < nk; kt += 2) {
    if (kt + 2 < nk) GL_B((kt + 2) * 64);
    COMPUTE(0);
    ST_A(1);
    __syncthreads();
    if (kt + 3 < nk) GL_A((kt + 3) * 64);
    COMPUTE(1);
    if (kt + 2 < nk) ST_B(0);
    __syncthreads();
  }
#undef GL_A
#undef GL_B
#undef ST_A
#undef ST_B
#undef COMPUTE
}
template <bool SWAP>
DEVI void gemm_mainloop_dma(const bf16_t* __restrict__ A, int lda, const bf16_t* __restrict__ Bt, int ldb, int K, char* smem, f32x4 (&acc)[8][4]) {
  const int tid = opaque_tid(), lane = tid & 63, wid = tid >> 6, wr = wid >> 1, wc = wid & 1;
  const int fr = lane & 15, fq = lane >> 4;
  const int gc = (tid & 3) ^ ((0x1320 >> (((tid >> 4) & 3) * 4)) & 3);
  const int aoff = (tid >> 2) * lda + gc * 8, boff = (tid >> 2) * ldb + gc * 8;
  char* lds_t = smem + tid * 16;
#define DMA_ISSUE(st, k0) do { \
    _Pragma("unroll") for (int j = 0; j < 4; j++) \
      __builtin_amdgcn_global_load_lds((const unsigned*)(A + ((size_t)(j * 64) * lda + (k0)) + aoff), (unsigned*)(lds_t + (st) * 24576 + j * 4096), 16, 0, 0); \
    _Pragma("unroll") for (int j = 0; j < 2; j++) \
      __builtin_amdgcn_global_load_lds((const unsigned*)(Bt + ((size_t)(j * 64) * ldb + (k0)) + boff), (unsigned*)(lds_t + (st) * 24576 + 16384 + j * 4096), 16, 0, 0); } while (0)
  const int co = (fq ^ ((0x1320 >> (((fr >> 2) & 3) * 4)) & 3)) * 16;
  const int arow = (wr * 128 + fr) * 64 + co, brow = 16384 + (wc * 64 + fr) * 64 + co;
  const int nk = K >> 5;
  DMA_ISSUE(0, 0); DMA_ISSUE(1, 32);
  int stg = 0;
  for (int kt = 0; kt < nk; kt++) {
    if (kt + 1 < nk) asm volatile("s_waitcnt vmcnt(6)" ::: "memory");
    else asm volatile("s_waitcnt vmcnt(0)" ::: "memory");
    __builtin_amdgcn_s_barrier();
    int nst = stg == 0 ? 2 : stg - 1;
    if (kt + 2 < nk) DMA_ISSUE(nst, (kt + 2) * 32);
    const char* st = smem + stg * 24576;
    bf16x8 bfr[4];
#pragma unroll
    for (int j = 0; j < 4; j++) bfr[j] = *(const bf16x8*)(st + brow + j * 1024);
#pragma unroll
    for (int ih = 0; ih < 2; ih++) {
      bf16x8 af[4];
#pragma unroll
      for (int i = 0; i < 4; i++) af[i] = *(const bf16x8*)(st + arow + (ih * 4 + i) * 1024);
      __builtin_amdgcn_s_setprio(1);
#pragma unroll
      for (int i = 0; i < 4; i++)
#pragma unroll
        for (int j = 0; j < 4; j++)
          acc[ih * 4 + i][j] = SWAP ? mfma16(bfr[j], af[i], acc[ih * 4 + i][j]) : mfma16(af[i], bfr[j], acc[ih * 4 + i][j]);
      __builtin_amdgcn_s_setprio(0);
    }
    stg = stg == 2 ? 0 : stg + 1;
  }
  __syncthreads();
#undef DMA_ISSUE
}
DEVI void zero_acc8(f32x4 (&acc)[8][4]) {
#pragma unroll
  for (int i = 0; i < 8; i++)
#pragma unroll
    for (int j = 0; j < 4; j++) acc[i][j] = f32x4{0.f, 0.f, 0.f, 0.f};
}
DEVI int xcd_vid() { int g8 = gridDim.x >> 3; return (blockIdx.x & 7) * g8 + (blockIdx.x >> 3); }
DEVI void zero_acc(f32x4 (&acc)[4][4]) {
#pragma unroll
  for (int i = 0; i < 4; i++)
#pragma unroll
    for (int j = 0; j < 4; j++) acc[i][j] = f32x4{0.f, 0.f, 0.f, 0.f};
}

enum { EP_BF16 = 0, EP_RELU2 = 1, EP_RESID = 2 };
DEVI float row_rstd(const float* ss, size_t m) { return rsqrtf(ss[m] * (1.f / 1024.f) + 1e-6f); }
template <int EP>
DEVI void phase_gemm(const bf16_t* A, int lda, const bf16_t* Bt, int K, int NT, bf16_t* Cb, int ldc,
                     const float* res, float* outf, bf16_t* hb, const float* ss_in, float* ss_out, char* smem) {
  const int tid = opaque_tid(), lane = tid & 63, wid = tid >> 6, wr = wid >> 1, wc = wid & 1, fr = lane & 15, fq = lane >> 4;
  const int ntiles = 256 * NT;
  for (int tile = xcd_vid(); tile < ntiles; tile += gridDim.x) {
    int mt = tile / NT, nt = tile % NT;
    f32x4 acc[8][4]; zero_acc8(acc);
    gemm_mainloop_dma<true>(A + (size_t)mt * 256 * lda, lda, Bt + (size_t)nt * 128 * K, K, K, smem, acc);
#pragma unroll
    for (int i = 0; i < 8; i++) {
      size_t m = (size_t)mt * 256 + wr * 128 + i * 16 + fr;
      float rs = (EP == EP_RELU2) ? row_rstd(ss_in, m) : 1.f;
      float part = 0.f;
#pragma unroll
      for (int j = 0; j < 4; j++) {
        int n = nt * 128 + wc * 64 + j * 16 + fq * 4;
        f32x4 v = acc[i][j];
        if (EP == EP_BF16) {
          *(uint2*)(Cb + m * ldc + n) = make_uint2(pack2(v[0], v[1]), pack2(v[2], v[3]));
        } else if (EP == EP_RELU2) {
          float a = fmaxf(v[0], 0.f) * rs, b = fmaxf(v[1], 0.f) * rs, c = fmaxf(v[2], 0.f) * rs, d = fmaxf(v[3], 0.f) * rs;
          *(uint2*)(Cb + m * ldc + n) = make_uint2(pack2(a * a, b * b), pack2(c * c, d * d));
        } else {
          float4 r = *(const float4*)(res + m * 1024 + n);
          float o0 = r.x + v[0], o1 = r.y + v[1], o2 = r.z + v[2], o3 = r.w + v[3];
          *(float4*)(outf + m * 1024 + n) = make_float4(o0, o1, o2, o3);
          *(uint2*)(hb + m * 1024 + n) = make_uint2(pack2(o0, o1), pack2(o2, o3));
          part += o0 * o0 + o1 * o1 + o2 * o2 + o3 * o3;
        }
      }
      if (EP == EP_RESID) {
        part += __shfl_xor(part, 16); part += __shfl_xor(part, 32);
        if (fq == 0) atomicAdd(&ss_out[m], part);
      }
      __builtin_amdgcn_sched_barrier(0);
    }
  }
}

struct ALoadF32 {
  const float* A; int lda; int lr, lc;
  DEVI void init(int lr_, int lc_) { lr = lr_; lc = lc_; }
  DEVI uint4 load(int i, int k) const {
    const float4* s = (const float4*)(A + (size_t)(lr + i * 32) * lda + k + lc);
    float4 a = s[0], b = s[1];
    return make_uint4(pack2(a.x, a.y), pack2(a.z, a.w), pack2(b.x, b.y), pack2(b.z, b.w));
  }
};
DEVI void phase_pp(const bf16_t* pf, const bf16_t* Wp, bf16_t* pp, char* smem) {
  const int tid = opaque_tid(), lane = tid & 63, wid = tid >> 6, wr = wid >> 1, wc = wid & 1, fr = lane & 15, fq = lane >> 4;
  for (int tile = xcd_vid(); tile < 256 * 8; tile += gridDim.x) {
    int mt = tile >> 3, nt = tile & 7;
    f32x4 acc[8][4]; zero_acc8(acc);
    gemm_mainloop_dma<true>(pf + (size_t)mt * 256 * 256, 256, Wp + (size_t)nt * 128 * 256, 256, 256, smem, acc);
#pragma unroll
    for (int i = 0; i < 8; i++) {
      size_t m = (size_t)mt * 256 + wr * 128 + i * 16 + fr;
#pragma unroll
      for (int j = 0; j < 4; j++) {
        int n = nt * 128 + wc * 64 + j * 16 + fq * 4;
        f32x4 v = acc[i][j];
        *(uint2*)(pp + m * 1024 + n) = make_uint2(pack2(v[0], v[1]), pack2(v[2], v[3]));
      }
    }
  }
}
DEVI void phase_ple(const bf16_t* hbin, const bf16_t* Wg, const bf16_t* pp, float* h, bf16_t* hb, const float* ss_in, float* ss_out, char* smem) {
  const int tid = opaque_tid(), lane = tid & 63, wid = tid >> 6, wr = wid >> 1, wc = wid & 1, fr = lane & 15, fq = lane >> 4;
  for (int tile = xcd_vid(); tile < 256 * 8; tile += gridDim.x) {
    int mt = tile >> 3, nt = tile & 7;
    f32x4 acc[8][4]; zero_acc8(acc);
    gemm_mainloop_dma<true>(hbin + (size_t)mt * 256 * 1024, 1024, Wg + (size_t)nt * 128 * 1024, 1024, 1024, smem, acc);
#pragma unroll
    for (int i = 0; i < 8; i++) {
      size_t m = (size_t)mt * 256 + wr * 128 + i * 16 + fr;
      float rs = row_rstd(ss_in, m);
      float part = 0.f;
#pragma unroll
      for (int j = 0; j < 4; j++) {
        int n = nt * 128 + wc * 64 + j * 16 + fq * 4;
        float4 r = *(const float4*)(h + m * 1024 + n);
        uint2 q = *(const uint2*)(pp + m * 1024 + n);
        f32x4 g = acc[i][j];
        float o0 = r.x + sigmoidf_(g[0] * rs) * lo2f(q.x), o1 = r.y + sigmoidf_(g[1] * rs) * hi2f(q.x);
        float o2 = r.z + sigmoidf_(g[2] * rs) * lo2f(q.y), o3 = r.w + sigmoidf_(g[3] * rs) * hi2f(q.y);
        *(float4*)(h + m * 1024 + n) = make_float4(o0, o1, o2, o3);
        if (hb) {
          *(uint2*)(hb + m * 1024 + n) = make_uint2(pack2(o0, o1), pack2(o2, o3));
          part += o0 * o0 + o1 * o1 + o2 * o2 + o3 * o3;
        }
      }
      if (hb) {
        part += __shfl_xor(part, 16); part += __shfl_xor(part, 32);
        if (fq == 0) atomicAdd(&ss_out[m], part);
      }
      __builtin_amdgcn_sched_barrier(0);
    }
  }
}

struct InTileKind { int kind; int ycol; bf16_t* vt; int vtrows; int nsmall; };
template <bool EVEN>
DEVI InTileKind in_tile_kind(const Params& p, int nt) {
  InTileKind k{0, nt * 128, nullptr, 0, 0};
  char* Y = gws(p) + OFF_Y;
  if (EVEN) {
    if (nt >= 8 && nt < 12) { k.kind = 2; k.vt = (bf16_t*)(Y + 448 * MiB) + (size_t)(nt - 8) * 128 * S_; k.vtrows = 512; }
    else if (nt == 28) { k.kind = 3; k.nsmall = 16; }
  } else {
    if (nt < 5 || nt == 6 || nt == 8) k.kind = 1;
    else if (nt == 7) { k.kind = 2; k.vt = (bf16_t*)(Y + 288 * MiB); k.vtrows = 128; }
    else if (nt == 9) { k.kind = 2; k.vt = (bf16_t*)(Y + 304 * MiB); k.vtrows = 128; }
    else if (nt == 18) { k.kind = 3; k.nsmall = 24; }
  }
  return k;
}
template <bool EVEN>
DEVI void phase_gemm_in(const Params& p, const bf16_t* hn, const float* ss_in, char* smem) {
  const int tid = opaque_tid(), lane = tid & 63, wid = tid >> 6, wr = wid >> 1, wc = wid & 1, fr = lane & 15, fq = lane >> 4;
  constexpr int NT = EVEN ? 29 : 19;
  constexpr int LDY = EVEN ? YE_LD : YO_LD;
  const bf16_t* Wt = (const bf16_t*)(gws(p) + OFF_WT) + (EVEN ? WT_IN_E : WT_IN_O);
  bf16_t* Y = (bf16_t*)(gws(p) + OFF_Y);
  float* ysm = (float*)(gws(p) + OFF_SM);
  const float* rope = (const float*)(gws(p) + OFF_MISC + MS_ROPE);
  for (int tile = xcd_vid(); tile < 256 * NT; tile += gridDim.x) {
    int mt = tile / NT, nt = tile % NT;
    InTileKind tk = in_tile_kind<EVEN>(p, nt);
    f32x4 acc[8][4]; zero_acc8(acc);
    gemm_mainloop_dma<true>(hn + (size_t)mt * 256 * 1024, 1024, Wt + (size_t)nt * 128 * 1024, 1024, 1024, smem, acc);
    if (tk.kind == 2) {
      int b = (mt * 256) / S_, s0 = (mt * 256) % S_;
#pragma unroll
      for (int i = 0; i < 8; i++)
#pragma unroll
        for (int j = 0; j < 4; j++) {
          int n = wc * 64 + j * 16 + fq * 4, s = s0 + wr * 128 + i * 16 + fr;
          f32x4 v = acc[i][j] * row_rstd(ss_in, (size_t)mt * 256 + wr * 128 + i * 16 + fr);
          bf16_t* dst = tk.vt + ((size_t)b * tk.vtrows + n) * S_ + s;
#pragma unroll
          for (int r = 0; r < 4; r++) dst[(size_t)r * S_] = f2bf(v[r]);
        }
    } else {
#pragma unroll
      for (int i = 0; i < 8; i++) {
        size_t m = (size_t)mt * 256 + wr * 128 + i * 16 + fr;
        {
          float rs = row_rstd(ss_in, m);
#pragma unroll
          for (int j = 0; j < 4; j++) acc[i][j] *= rs;
        }
        if (tk.kind == 1) {
          const float* rp = rope + m * 16;
          f32x4 v = acc[i][0];
#pragma unroll
          for (int r = 0; r < 4; r++) {
            float pv = __shfl_xor(v[r], 32);
            int d8 = (fq & 1) * 4 + r;
            float c = rp[d8], s = rp[8 + d8];
            acc[i][0][r] = (fq < 2) ? (v[r] * c - pv * s) : (v[r] * c + pv * s);
          }
        }
#pragma unroll
        for (int j = 0; j < 4; j++) {
          int nl = wc * 64 + j * 16 + fq * 4;
          f32x4 v = acc[i][j];
          if (tk.kind == 3) {
#pragma unroll
            for (int r = 0; r < 4; r++) if (nl + r < tk.nsmall) ysm[m * 32 + nl + r] = v[r];
          } else {
            *(uint2*)(Y + m * LDY + tk.ycol + nl) = make_uint2(pack2(v[0], v[1]), pack2(v[2], v[3]));
          }
        }
      }
    }
  }
}

struct AttnSmem { bf16_t k[2][64][72]; bf16_t vt[2][64][72]; float fk[2][64]; };
constexpr int SM_IMP = 37376;
constexpr int SM_SELM = 71168;
constexpr int SM_BOR = 72192;
constexpr int SM_SLOT = 73712;
typedef unsigned long long u64;

DEVI int next_tile(u64 lo, u64 hi, int after) {
  if (after < 63) { u64 x = lo & (~0ull << (after + 1)); if (x) return __builtin_ctzll(x); }
  int a2 = after < 63 ? -1 : after - 64;
  if (a2 < 63) { u64 y = hi & (~0ull << (a2 + 1)); if (y) return 64 + __builtin_ctzll(y); }
  return -1;
}

DEVI float xq_max(float a) {
  auto r = __builtin_amdgcn_permlane16_swap(__float_as_uint(a), __float_as_uint(a), false, false);
  a = fmaxf(a, fmaxf(__uint_as_float(r[0]), __uint_as_float(r[1])));
  auto q = __builtin_amdgcn_permlane32_swap(__float_as_uint(a), __float_as_uint(a), false, false);
  return fmaxf(a, fmaxf(__uint_as_float(q[0]), __uint_as_float(q[1])));
}
template <int MODE, int NQT, class Pol>
DEVI void attn_compute(Pol& pol, AttnSmem& sm, int buf, int kb, const bf16x8 (&qf)[NQT][2], f32x4 (&o)[4][NQT], float (&m)[NQT], float (&l)[NQT], float* impw, int fr, int fq) {
      pol.begin(kb, sm.fk[buf]);
      const bool msk = pol.masked(kb);
      f32x4 s[4][NQT];
#pragma unroll
      for (int kt = 0; kt < 4; kt++)
#pragma unroll
        for (int qt = 0; qt < NQT; qt++) s[kt][qt] = f32x4{0.f, 0.f, 0.f, 0.f};
      bf16x8 kfr[4][2];
#pragma unroll
      for (int kt = 0; kt < 4; kt++)
#pragma unroll
        for (int kk = 0; kk < 2; kk++) kfr[kt][kk] = *(const bf16x8*)&sm.k[buf][kt * 16 + fr][kk * 32 + fq * 8];
#pragma unroll
      for (int qt = 0; qt < NQT; qt++)
#pragma unroll
        for (int kt = 0; kt < 4; kt++)
#pragma unroll
          for (int kk = 0; kk < 2; kk++) s[kt][qt] = mfma16(kfr[kt][kk], qf[qt][kk], s[kt][qt]);
      bf16x8 vfr[2][4];
      if (MODE != 1) {
#pragma unroll
        for (int h2 = 0; h2 < 2; h2++)
#pragma unroll
          for (int dt = 0; dt < 4; dt++) {
            const bf16_t* vr = &sm.vt[buf][dt * 16 + fr][h2 * 32 + fq * 4];
            uint2 v0 = *(const uint2*)vr, v1 = *(const uint2*)(vr + 16);
            vfr[h2][dt] = mk8(v0.x, v0.y, v1.x, v1.y);
          }
      }
      bf16x8 pfr[2][NQT];
      float psum[4][4];
      if (MODE == 2) {
#pragma unroll
        for (int kt = 0; kt < 4; kt++)
#pragma unroll
          for (int r = 0; r < 4; r++) psum[kt][r] = 0.f;
      }
#pragma unroll
      for (int qt = 0; qt < NQT; qt++) {
        float t[4][4];
        if (Pol::UB && MODE != 2 && !msk) {
          const float bl = pol.lane_bias();
          float mxr = fmaxf(fmaxf(s[0][qt][0], s[0][qt][1]), fmaxf(s[0][qt][2], s[0][qt][3]));
#pragma unroll
          for (int kt = 1; kt < 4; kt++) mxr = fmaxf(mxr, fmaxf(fmaxf(s[kt][qt][0], s[kt][qt][1]), fmaxf(s[kt][qt][2], s[kt][qt][3])));
          float mx = xq_max(fmaf(mxr, pol.sc, bl));
          float mnew = fmaxf(m[qt], mx);
          float alpha = fexp2(m[qt] - mnew);
          m[qt] = mnew;
          const float cb = bl - fmaxf(mnew, 0.1f * NEGF);
          float ps = 0.f;
#pragma unroll
          for (int kt = 0; kt < 4; kt++)
#pragma unroll
            for (int r = 0; r < 4; r++) { t[kt][r] = fexp2(fmaf(s[kt][qt][r], pol.sc, cb)); ps += t[kt][r]; }
          l[qt] = l[qt] * alpha + ps;
          if (MODE == 0) {
            if (__any(alpha != 1.f)) {
#pragma unroll
              for (int dt = 0; dt < 4; dt++) o[dt][qt] *= alpha;
            }
          }
        } else {
#pragma unroll
        for (int kt = 0; kt < 4; kt++) {
          f32x4 bb = pol.bias4(kt * 16 + fq * 4);
#pragma unroll
          for (int r = 0; r < 4; r++) t[kt][r] = fmaf(s[kt][qt][r], pol.sc, bb[r]);
        }
        if (msk) {
#pragma unroll
          for (int kt = 0; kt < 4; kt++)
#pragma unroll
            for (int r = 0; r < 4; r++) t[kt][r] = pol.ok(qt, kt * 16 + fq * 4 + r) ? t[kt][r] : NEGF;
        }
        if (MODE == 2) {
#pragma unroll
          for (int kt = 0; kt < 4; kt++)
#pragma unroll
            for (int r = 0; r < 4; r++) {
              t[kt][r] = fexp2(t[kt][r] - fmaxf(m[qt], 0.1f * NEGF)) * l[qt];
              psum[kt][r] += t[kt][r];
            }
        } else {
          float mx = fmaxf(fmaxf(t[0][0], t[0][1]), fmaxf(t[0][2], t[0][3]));
#pragma unroll
          for (int kt = 1; kt < 4; kt++) mx = fmaxf(mx, fmaxf(fmaxf(t[kt][0], t[kt][1]), fmaxf(t[kt][2], t[kt][3])));
          mx = xq_max(mx);
          float mnew = fmaxf(m[qt], mx);
          float alpha = fexp2(m[qt] - mnew);
          m[qt] = mnew;
          float ps = 0.f;
          const float meff = fmaxf(mnew, 0.1f * NEGF);
#pragma unroll
          for (int kt = 0; kt < 4; kt++)
#pragma unroll
            for (int r = 0; r < 4; r++) { t[kt][r] = fexp2(t[kt][r] - meff); ps += t[kt][r]; }
          l[qt] = l[qt] * alpha + ps;
          if (MODE == 0) {
            if (__any(alpha != 1.f)) {
#pragma unroll
              for (int dt = 0; dt < 4; dt++) o[dt][qt] *= alpha;
            }
          }
        }
        }
        if (MODE != 1) {
#pragma unroll
          for (int h2 = 0; h2 < 2; h2++)
            pfr[h2][qt] = mk8(pack2(t[2 * h2][0], t[2 * h2][1]), pack2(t[2 * h2][2], t[2 * h2][3]), pack2(t[2 * h2 + 1][0], t[2 * h2 + 1][1]), pack2(t[2 * h2 + 1][2], t[2 * h2 + 1][3]));
#pragma unroll
          for (int h2 = 0; h2 < 2; h2++)
#pragma unroll
            for (int dt = 0; dt < 4; dt++) o[dt][qt] = mfma16(vfr[h2][dt], pfr[h2][qt], o[dt][qt]);
        }
      }
      if (MODE == 2) {
#pragma unroll
        for (int kt = 0; kt < 4; kt++) {
          int c = kb * 16 + kt * 4 + fq;
          atomicAdd(&impw[fr * 132 + c], (psum[kt][0] + psum[kt][1]) + (psum[kt][2] + psum[kt][3]));
          atomicAdd(&impw[fr * 132 + c + 1], psum[kt][3]);
        }
      }

    }
template <int MODE, int NQT, class Pol>
DEVI void attn_core(Pol& pol, char* smem, const bf16x8 (&qf)[NQT][2], const bf16_t* __restrict__ Kg, int ldk,
                    const bf16_t* __restrict__ Vtg, int ldv, const float* __restrict__ fkg, u64 mlo, u64 mhi,
                    f32x4 (&o)[4][NQT], float (&m)[NQT], float (&l)[NQT], float* impw) {
  AttnSmem& sm = *(AttnSmem*)smem;
  const int tid = opaque_tid(), lane = tid & 63, fr = lane & 15, fq = lane >> 4;
  const int lrow = tid >> 3, lch = (tid & 7) * 8;
  int kb = next_tile(mlo, mhi, -1);
  if (kb < 0) return;
  uint4 ak0, ak1, av0 = make_uint4(0, 0, 0, 0), av1 = make_uint4(0, 0, 0, 0); float4 af4 = make_float4(0, 0, 0, 0);
  uint4 bk0, bk1, bv0 = make_uint4(0, 0, 0, 0), bv1 = make_uint4(0, 0, 0, 0); float4 bf4 = make_float4(0, 0, 0, 0);
#define GLOADX(P, t) do { \
    P##k0 = GLD16(Kg + (size_t)((t) * 64 + lrow) * ldk + lch); \
    P##k1 = GLD16(Kg + (size_t)((t) * 64 + lrow + 32) * ldk + lch); \
    if (MODE != 1) { P##v0 = GLD16(Vtg + (size_t)(lrow) * ldv + (t) * 64 + lch); \
                     P##v1 = GLD16(Vtg + (size_t)(lrow + 32) * ldv + (t) * 64 + lch); } \
    if (fkg != nullptr && tid < 16) P##f4 = GLDF4(fkg + (t) * 64 + tid * 4); } while (0)
#define SSTOREX(P, b) do { \
    *(uint4*)&sm.k[b][lrow][lch] = P##k0; *(uint4*)&sm.k[b][lrow + 32][lch] = P##k1; \
    if (MODE != 1) { *(uint4*)&sm.vt[b][lrow][lch] = P##v0; *(uint4*)&sm.vt[b][lrow + 32][lch] = P##v1; } \
    if (fkg != nullptr && tid < 16) *(float4*)&sm.fk[b][tid * 4] = P##f4; } while (0)
#define ATTN_STEP(S, L) do { \
    int kb2 = kb1 >= 0 ? next_tile(mlo, mhi, kb1) : -1; \
    if (kb2 >= 0) GLOADX(L, kb2); \
    if (pol.active(kb)) attn_compute<MODE, NQT, Pol>(pol, sm, buf, kb, qf, o, m, l, impw, fr, fq); \
    if (kb1 >= 0) SSTOREX(S, buf ^ 1); \
    __syncthreads(); \
    buf ^= 1; kb = kb1; kb1 = kb2; } while (0)
  int kb1 = next_tile(mlo, mhi, kb);
  GLOADX(a, kb); SSTOREX(a, 0);
  if (kb1 >= 0) GLOADX(a, kb1);
  __syncthreads();
  int buf = 0;
  for (;;) {
    ATTN_STEP(a, b);
    if (kb < 0) break;
    ATTN_STEP(b, a);
    if (kb < 0) break;
  }
#undef GLOADX
#undef SSTOREX
#undef ATTN_STEP
}
template <int NQT>
DEVI void zero_o(f32x4 (&o)[4][NQT]) {
#pragma unroll
  for (int i = 0; i < 4; i++)
#pragma unroll
    for (int j = 0; j < NQT; j++) o[i][j] = f32x4{0.f, 0.f, 0.f, 0.f};
}

DEVI void phase_fox_f(const Params& p, char* smem) {
  const int tid = opaque_tid(), lane = tid & 63, wid = tid >> 6;
  {
    unsigned* kmaxp = (unsigned*)(gws(p) + OFF_MISC + MS_KMAX);
    for (int slab = blockIdx.x; slab < M_ / 128; slab += gridDim.x) {
      int tok = slab * 128 + (tid >> 1), hh0 = (tid & 1) * 4, b = tok / S_;
      const uint4* kr = (const uint4*)((const bf16_t*)(gws(p) + OFF_Y) + (size_t)tok * YE_LD + 512 + hh0 * 64);
#pragma unroll
      for (int hh = 0; hh < 4; hh++) {
        float ss = 0.f;
#pragma unroll
        for (int c = 0; c < 8; c++) {
          uint4 v = kr[hh * 8 + c];
          float a0 = lo2f(v.x), a1 = hi2f(v.x), a2 = lo2f(v.y), a3 = hi2f(v.y), a4 = lo2f(v.z), a5 = hi2f(v.z), a6 = lo2f(v.w), a7 = hi2f(v.w);
          ss += a0 * a0 + a1 * a1 + a2 * a2 + a3 * a3 + a4 * a4 + a5 * a5 + a6 * a6 + a7 * a7;
        }
        ss = fmaxf(ss, __shfl_xor(ss, 2)); ss = fmaxf(ss, __shfl_xor(ss, 4)); ss = fmaxf(ss, __shfl_xor(ss, 8));
        ss = fmaxf(ss, __shfl_xor(ss, 16)); ss = fmaxf(ss, __shfl_xor(ss, 32));
        if (lane < 2) atomicMax(&kmaxp[b * 8 + hh0 + hh], __float_as_uint(ss));
      }
    }
  }
  if (blockIdx.x < 64) {
    int gw = blockIdx.x, b = gw >> 3, h = gw & 7;
    const float* ysm = (const float*)(gws(p) + OFF_SM) + (size_t)b * S_ * 32 + h;
    float bf = gin(p, 5)[h];
    float* F = (float*)(gws(p) + OFF_MISC + MS_FOXF) + (size_t)gw * S_;
    float ls[32];
    float sum = 0.f;
#pragma unroll
    for (int i = 0; i < 32; i++) { float x = ysm[(size_t)(tid * 32 + i) * 32] + bf; ls[i] = -softplusf_(-x); sum += ls[i]; }
    float incl = sum;
#pragma unroll
    for (int o = 1; o < 64; o <<= 1) { float t = __shfl_up(incl, o); if (lane >= o) incl += t; }
    float* wsum = (float*)smem;
    if (lane == 63) wsum[wid] = incl;
    __syncthreads();
    float off = 0.f;
    for (int w = 0; w < wid; w++) off += wsum[w];
    float run = off + incl - sum;
#pragma unroll
    for (int i = 0; i < 32; i++) { run += ls[i]; F[tid * 32 + i] = run * LOG2E; }
    __syncthreads();
  }
}

struct FoxPol {
  static constexpr bool UB = false;
  DEVI float lane_bias() const { return 0.f; }
  int tq0; int qmin, qmax; int kb; const float* fk; float sc;
  DEVI bool active(int kb_) const { return kb_ * 64 <= qmax; }
  DEVI bool masked(int kb_) const { return kb_ * 64 + 63 > qmin; }
  DEVI void begin(int kb_, const float* f) { kb = kb_; fk = f; }
  DEVI bool ok(int qt, int kl) const { return kb * 64 + kl <= tq0 + qt * 16; }
  DEVI f32x4 bias4(int kl0) const { float4 v = *(const float4*)&fk[kl0]; return f32x4{-v.x, -v.y, -v.z, -v.w}; }
};

DEVI void fox_tile(const Params& p, int item, char* smem) {
  const int tid = opaque_tid(), lane = tid & 63, wid = tid >> 6, fr = lane & 15, fq = lane >> 4;
  int qblk = 63 - (item >> 6), bh = item & 63, b = bh >> 3, h = bh & 7;
  int q0 = qblk * 128 + wid * 32;
  const bf16_t* Y = (const bf16_t*)(gws(p) + OFF_Y) + (size_t)b * S_ * YE_LD;
  const float* F = (const float*)(gws(p) + OFF_MISC + MS_FOXF) + (size_t)bh * S_;
  bf16x8 qf[2][2];
  FoxPol pol;
#pragma unroll
  for (int qt = 0; qt < 2; qt++) {
    int t = q0 + qt * 16 + fr;
#pragma unroll
    for (int kk = 0; kk < 2; kk++) qf[qt][kk] = *(const bf16x8*)(Y + (size_t)t * YE_LD + h * 64 + kk * 32 + fq * 8);
  }
  pol.tq0 = q0 + fr; pol.qmin = q0; pol.qmax = q0 + 31; pol.sc = 0.125f * LOG2E; pol.kb = 0; pol.fk = nullptr;
  f32x4 o[4][2]; zero_o<2>(o);
  float m[2] = {NEGF, NEGF}, l[2] = {0.f, 0.f};
  float qn2 = 0.f;
#pragma unroll
  for (int qt = 0; qt < 2; qt++) {
    float ss = 0.f;
#pragma unroll
    for (int kk = 0; kk < 2; kk++)
#pragma unroll
      for (int e = 0; e < 8; e++) { float v = bf2f((bf16_t)qf[qt][kk][e]); ss += v * v; }
    ss += __shfl_xor(ss, 16); ss += __shfl_xor(ss, 32);
    qn2 = fmaxf(qn2, ss);
  }
#pragma unroll
  for (int o = 8; o >= 1; o >>= 1) qn2 = fmaxf(qn2, __shfl_xor(qn2, o));
  float* red = (float*)(smem + SM_BOR);
  if (lane == 0) red[wid] = qn2;
  __syncthreads();
  qn2 = fmaxf(fmaxf(red[0], red[1]), fmaxf(red[2], red[3]));
  float kmax2 = ((const float*)(gws(p) + OFF_MISC + MS_KMAX))[bh];
  float qkmax = sqrtf(qn2 * kmax2) * pol.sc * 1.001f;
  float thr = -(128.f + 2.f * qkmax);
  int nt = qblk * 2 + 2;
  float fq0 = F[qblk * 128];
  u64 mlo, mhi;
  {
    int k0 = lane, k1 = lane + 64;
    bool n0 = (k0 < nt) && (k0 >= nt - 2 || fq0 - F[k0 * 64 + 63] >= thr);
    bool n1 = (k1 < nt) && (k1 >= nt - 2 || fq0 - F[(k1 < 128 ? k1 : 127) * 64 + 63] >= thr);
    mlo = __ballot(n0); mhi = __ballot(n1);
  }
  const bf16_t* vT = (const bf16_t*)(gws(p) + OFF_Y + 448 * MiB) + ((size_t)b * 512 + h * 64) * S_;
  attn_core<0, 2>(pol, smem, qf, Y + 512 + h * 64, YE_LD, vT, S_, F, mlo, mhi, o, m, l, nullptr);
  bf16_t* mix = (bf16_t*)(gws(p) + OFF_MIX) + (size_t)b * S_ * 1024;
#pragma unroll
  for (int qt = 0; qt < 2; qt++) {
    float lt = l[qt]; lt += __shfl_xor(lt, 16); lt += __shfl_xor(lt, 32);
    float inv = 1.f / lt;
#pragma unroll
    for (int dt = 0; dt < 4; dt++) {
      f32x4 v = o[dt][qt];
      *(uint2*)(mix + (size_t)(pol.tq0 + qt * 16) * 1024 + h * 64 + dt * 16 + fq * 4) = make_uint2(pack2(v[0] * inv, v[1] * inv), pack2(v[2] * inv, v[3] * inv));
    }
  }
}

DEVI void emit_afrag(const bf16_t* st, int ld, int nrt, int nkk, char* gdst) {
  for (int c = opaque_tid(); c < nrt * nkk * 64; c += 256) {
    int ln = c & 63, rk = c >> 6, rt = rk / nkk, kk = rk % nkk;
    int row = rt * 16 + (ln & 15), k0 = kk * 32 + (ln >> 4) * 4;
    uint2 a = *(const uint2*)&st[row * ld + k0], b = *(const uint2*)&st[row * ld + k0 + 16];
    *(uint4*)(gdst + (size_t)c * 16) = make_uint4(a.x, a.y, b.x, b.y);
  }
}

DEVI void gdn_pre_tile(const Params& p, int chunk, char* smem) {
  const int tid = opaque_tid(), lane = tid & 63, wid = tid >> 6, fr = lane & 15, fq = lane >> 4;
  int n = chunk & 127, h = (chunk >> 7) & 3, b = chunk >> 9;
  size_t tok0 = (size_t)b * S_ + n * 64;
  bf16_t* qn = (bf16_t*)smem;
  bf16_t* kn = (bf16_t*)(smem + 17408);
  bf16_t* vs = (bf16_t*)(smem + 34816);
  float* L = (float*)(smem + 53248);
  float* sbeta = (float*)(smem + 69632);
  float* sgc = sbeta + 64; float* seg = sbeta + 128; float* sbe = sbeta + 192;
  const bf16_t* Y = (const bf16_t*)(gws(p) + OFF_Y);
  const float* ysm = (const float*)(gws(p) + OFF_SM);
  char* gbase = gws(p) + OFF_X + (size_t)chunk * GDN_CH_BYTES;
  if (tid < 64) {
    float gb = ysm[(tok0 + tid) * 32 + 8 + h], ga = ysm[(tok0 + tid) * 32 + 12 + h];
    float beta = sigmoidf_(gb);
    float g = -expf(gin(p, 7)[h]) * softplusf_(ga + gin(p, 8)[h]);
    float gc = g;
#pragma unroll
    for (int o = 1; o < 64; o <<= 1) { float t = __shfl_up(gc, o); if (lane >= o) gc += t; }
    float eg = expf(gc);
    sbeta[tid] = beta; sgc[tid] = gc; seg[tid] = eg; sbe[tid] = beta * eg;
    if (tid == 63) ((float*)(gws(p) + OFF_MISC + MS_EGL))[chunk] = eg;
  }
  {
    int dc = tid & 15, tg = tid >> 4, d0 = dc * 8;
#pragma unroll 1
    for (int mat = 0; mat < 3; mat++) {
      int col = 1536 + mat * 512 + h * 128 + d0;
      int cch = mat * 512 + h * 128 + d0;
      float w[4][8];
#pragma unroll
      for (int j = 0; j < 4; j++)
#pragma unroll
        for (int e = 0; e < 8; e++) w[j][e] = gin(p, 6)[j * 1536 + cch + e];
      uint4 xr[7];
#pragma unroll
      for (int i = 0; i < 7; i++) {
        int lt = tg * 4 - 3 + i;
        if (n * 64 + lt >= 0) xr[i] = *(const uint4*)(Y + (tok0 + lt) * YE_LD + col); else xr[i] = make_uint4(0, 0, 0, 0);
      }
#pragma unroll
      for (int tt = 0; tt < 4; tt++) {
        float x[8];
#pragma unroll
        for (int e = 0; e < 8; e++) x[e] = 0.f;
#pragma unroll
        for (int j = 0; j < 4; j++) {
          uint4 v = xr[tt + j];
          x[0] += w[j][0] * lo2f(v.x); x[1] += w[j][1] * hi2f(v.x); x[2] += w[j][2] * lo2f(v.y); x[3] += w[j][3] * hi2f(v.y);
          x[4] += w[j][4] * lo2f(v.z); x[5] += w[j][5] * hi2f(v.z); x[6] += w[j][6] * lo2f(v.w); x[7] += w[j][7] * hi2f(v.w);
        }
        float ss = 0.f;
#pragma unroll
        for (int e = 0; e < 8; e++) { x[e] = x[e] * sigmoidf_(x[e]); ss += x[e] * x[e]; }
        float sc = 1.f;
        if (mat < 2) {
          ss += __shfl_xor(ss, 1); ss += __shfl_xor(ss, 2); ss += __shfl_xor(ss, 4); ss += __shfl_xor(ss, 8);
          sc = rsqrtf(ss + 1e-6f) * (mat == 0 ? 0.08838834764831845f : 1.f);
        }
        bf16_t* dst = (mat == 0 ? qn : (mat == 1 ? kn : vs)) + (tg * 4 + tt) * 136 + d0;
        *(uint4*)dst = make_uint4(pack2(x[0] * sc, x[1] * sc), pack2(x[2] * sc, x[3] * sc), pack2(x[4] * sc, x[5] * sc), pack2(x[6] * sc, x[7] * sc));
      }
    }
  }
  __syncthreads();
  {
    bf16x8 ka[4], qa[4];
#pragma unroll
    for (int kk = 0; kk < 4; kk++) {
      ka[kk] = *(const bf16x8*)&kn[(wid * 16 + fr) * 136 + kk * 32 + fq * 8];
      qa[kk] = *(const bf16x8*)&qn[(wid * 16 + fr) * 136 + kk * 32 + fq * 8];
    }
#pragma unroll
    for (int ct = 0; ct < 4; ct++) {
      f32x4 aL = {0.f, 0.f, 0.f, 0.f}, aA = {0.f, 0.f, 0.f, 0.f};
#pragma unroll
      for (int kk = 0; kk < 4; kk++) {
        bf16x8 kb = *(const bf16x8*)&kn[(ct * 16 + fr) * 136 + kk * 32 + fq * 8];
        aL = mfma16(ka[kk], kb, aL);
        aA = mfma16(qa[kk], kb, aA);
      }
      int j = ct * 16 + fr;
      float gj = sgc[j];
#pragma unroll
      for (int r = 0; r < 4; r++) {
        int i = wid * 16 + fq * 4 + r;
        float dec = (i >= j) ? expf(sgc[i] - gj) : 0.f;
        L[i * 64 + j] = (i > j) ? sbeta[i] * aL[r] * dec : 0.f;
        float av = aA[r] * dec;
        int kk2 = j >> 5, within = j & 31, tt = within >> 4, qd = (within & 15) >> 2, jj = within & 3;
        int ln = qd * 16 + (i & 15);
        *(bf16_t*)(gbase + 49152 + ((size_t)((wid * 2 + kk2) * 64 + ln)) * 16 + (tt * 4 + jj) * 2) = f2bf(av);
      }
    }
  }
  __syncthreads();
  float x[64];
  {
    const int c = tid;
    const bf16_t* rsrc = (c < 128) ? (vs + c) : (kn + (c - 128));
    const float* rsc = (c < 128) ? sbeta : sbe;
#pragma unroll
    for (int i = 0; i < 64; i++) {
      float r = bf2f(rsrc[i * 136]) * rsc[i];
#pragma unroll
      for (int j4 = 0; j4 < (i + 3) / 4; j4++) {
        float4 lv = *(const float4*)&L[i * 64 + j4 * 4];
        if (j4 * 4 + 0 < i) r -= lv.x * x[j4 * 4 + 0];
        if (j4 * 4 + 1 < i) r -= lv.y * x[j4 * 4 + 1];
        if (j4 * 4 + 2 < i) r -= lv.z * x[j4 * 4 + 2];
        if (j4 * 4 + 3 < i) r -= lv.w * x[j4 * 4 + 3];
      }
      x[i] = r;
    }
  }
  __syncthreads();
  if (tid >= 128) {
#pragma unroll
    for (int i = 0; i < 64; i++) vs[i * 136 + (tid - 128)] = f2bf(x[i]);
  }
  __syncthreads();
  emit_afrag(vs, 136, 4, 4, gbase);
  __syncthreads();
  if (tid < 128) {
#pragma unroll
    for (int i = 0; i < 64; i++) vs[i * 136 + tid] = f2bf(x[i]);
  }
  __syncthreads();
  for (int c = tid; c < 2048; c += 256) {
    int ln = c & 63, rt = (c >> 6) & 3, ds = c >> 8;
    int row = rt * 16 + (ln >> 4) * 4, col = ds * 16 + (ln & 15);
    unsigned a = (unsigned)vs[row * 136 + col] | ((unsigned)vs[(row + 1) * 136 + col] << 16);
    unsigned bq = (unsigned)vs[(row + 2) * 136 + col] | ((unsigned)vs[(row + 3) * 136 + col] << 16);
    *(uint2*)(gbase + 57344 + (size_t)c * 8) = make_uint2(a, bq);
  }
  __syncthreads();
  for (int e = tid; e < 64 * 128; e += 256) { int i = e >> 7, d = e & 127; vs[i * 136 + d] = f2bf(bf2f(qn[i * 136 + d]) * seg[i]); }
  __syncthreads();
  emit_afrag(vs, 136, 4, 4, gbase + 16384);
  __syncthreads();
  {
    float gl = sgc[63];
    for (int e = tid; e < 64 * 128; e += 256) { int j = e >> 7, d = e & 127; vs[d * 72 + j] = f2bf(bf2f(kn[j * 136 + d]) * expf(gl - sgc[j])); }
  }
  __syncthreads();
  emit_afrag(vs, 72, 8, 2, gbase + 32768);
  __syncthreads();
}

DEVI void gdn_scan_item(const Params& p, int item, char* smem) {
  const int tid = opaque_tid(), lane = tid & 63, wid = tid >> 6, fr = lane & 15, fq = lane >> 4;
  int bh = item >> 1, half = item & 1, ds = half * 4 + wid, b = bh >> 2, h = bh & 3;
  const float* eglp = (const float*)(gws(p) + OFF_MISC + MS_EGL) + bh * 128;
  bf16_t* Yo = (bf16_t*)(gws(p) + OFF_Y) + (size_t)b * S_ * YE_LD + 1536 + h * 128 + ds * 16 + fr;
  char* bufA = smem;
  char* bufB = smem + 32768;
  const char* gbase = gws(p) + OFF_X + (size_t)(bh * 128) * GDN_CH_BYTES;
  uint4 ra0, ra1, ra2, ra3, ra4, ra5, ra6, ra7, rb0, rb1, rb2, rb3, rb4, rb5, rb6, rb7;
#define SCAN_GLOAD(n) do { const char* cb = gbase + (size_t)(n) * GDN_CH_BYTES; \
    ra0 = GLD16(cb + (size_t)(tid + 0) * 16); \
    ra1 = GLD16(cb + (size_t)(tid + 256) * 16); \
    ra2 = GLD16(cb + (size_t)(tid + 512) * 16); \
    ra3 = GLD16(cb + (size_t)(tid + 768) * 16); \
    ra4 = GLD16(cb + (size_t)(tid + 1024) * 16); \
    ra5 = GLD16(cb + (size_t)(tid + 1280) * 16); \
    ra6 = GLD16(cb + (size_t)(tid + 1536) * 16); \
    ra7 = GLD16(cb + (size_t)(tid + 1792) * 16); \
    rb0 = GLD16(cb + 32768 + (size_t)(tid + 0) * 16); \
    rb1 = GLD16(cb + 32768 + (size_t)(tid + 256) * 16); \
    rb2 = GLD16(cb + 32768 + (size_t)(tid + 512) * 16); \
    rb3 = GLD16(cb + 32768 + (size_t)(tid + 768) * 16); \
    rb4 = GLD16(cb + 32768 + (size_t)(tid + 1024) * 16); \
    rb5 = GLD16(cb + 32768 + (size_t)(tid + 1280) * 16); \
    rb6 = GLD16(cb + 57344 + half * 8192 + (size_t)(tid + 0) * 16); \
    rb7 = GLD16(cb + 57344 + half * 8192 + (size_t)(tid + 256) * 16); \
  } while (0)
#define SCAN_SSTORE() do { \
    *(uint4*)(bufA + (tid + 0) * 16) = ra0; *(uint4*)(bufB + (tid + 0) * 16) = rb0; \
    *(uint4*)(bufA + (tid + 256) * 16) = ra1; *(uint4*)(bufB + (tid + 256) * 16) = rb1; \
    *(uint4*)(bufA + (tid + 512) * 16) = ra2; *(uint4*)(bufB + (tid + 512) * 16) = rb2; \
    *(uint4*)(bufA + (tid + 768) * 16) = ra3; *(uint4*)(bufB + (tid + 768) * 16) = rb3; \
    *(uint4*)(bufA + (tid + 1024) * 16) = ra4; *(uint4*)(bufB + (tid + 1024) * 16) = rb4; \
    *(uint4*)(bufA + (tid + 1280) * 16) = ra5; *(uint4*)(bufB + (tid + 1280) * 16) = rb5; \
    *(uint4*)(bufA + (tid + 1536) * 16) = ra6; *(uint4*)(bufB + (tid + 1536) * 16) = rb6; \
    *(uint4*)(bufA + (tid + 1792) * 16) = ra7; *(uint4*)(bufB + (tid + 1792) * 16) = rb7; \
  } while (0)
  SCAN_GLOAD(0);
  SCAN_SSTORE();
  __syncthreads();
  f32x4 S[8];
#pragma unroll
  for (int i = 0; i < 8; i++) S[i] = f32x4{0.f, 0.f, 0.f, 0.f};
#pragma unroll 1
  for (int n = 0; n < 128; n++) {
    if (n + 1 < 128) SCAN_GLOAD(n + 1);
    float egl = eglp[n];
    bf16x8 sb[4];
#pragma unroll
    for (int kk = 0; kk < 4; kk++)
      sb[kk] = mk8(pack2(S[2 * kk][0], S[2 * kk][1]), pack2(S[2 * kk][2], S[2 * kk][3]), pack2(S[2 * kk + 1][0], S[2 * kk + 1][1]), pack2(S[2 * kk + 1][2], S[2 * kk + 1][3]));
    f32x4 vn[4], oo[4];
#pragma unroll
    for (int rt = 0; rt < 4; rt++) {
      f32x4 acc = {0.f, 0.f, 0.f, 0.f};
#pragma unroll
      for (int kk = 0; kk < 4; kk++) acc = mfma16(*(const bf16x8*)(bufA + ((rt * 4 + kk) * 64 + lane) * 16), sb[kk], acc);
      uint2 uu = *(const uint2*)(bufB + 24576 + ((wid * 4 + rt) * 64 + lane) * 8);
      vn[rt] = f32x4{lo2f(uu.x) - acc[0], hi2f(uu.x) - acc[1], lo2f(uu.y) - acc[2], hi2f(uu.y) - acc[3]};
    }
#pragma unroll
    for (int rt = 0; rt < 4; rt++) {
      f32x4 acc = {0.f, 0.f, 0.f, 0.f};
#pragma unroll
      for (int kk = 0; kk < 4; kk++) acc = mfma16(*(const bf16x8*)(bufA + 16384 + ((rt * 4 + kk) * 64 + lane) * 16), sb[kk], acc);
      oo[rt] = acc;
    }
    bf16x8 vb[2];
#pragma unroll
    for (int k2 = 0; k2 < 2; k2++)
      vb[k2] = mk8(pack2(vn[2 * k2][0], vn[2 * k2][1]), pack2(vn[2 * k2][2], vn[2 * k2][3]), pack2(vn[2 * k2 + 1][0], vn[2 * k2 + 1][1]), pack2(vn[2 * k2 + 1][2], vn[2 * k2 + 1][3]));
#pragma unroll
    for (int rt = 0; rt < 4; rt++)
#pragma unroll
      for (int k2 = 0; k2 < 2; k2++) oo[rt] = mfma16(*(const bf16x8*)(bufB + 16384 + ((rt * 2 + k2) * 64 + lane) * 16), vb[k2], oo[rt]);
#pragma unroll
    for (int dk = 0; dk < 8; dk++) {
      f32x4 acc = S[dk] * egl;
#pragma unroll
      for (int k2 = 0; k2 < 2; k2++) acc = mfma16(*(const bf16x8*)(bufB + ((dk * 2 + k2) * 64 + lane) * 16), vb[k2], acc);
      S[dk] = acc;
    }
#pragma unroll
    for (int rt = 0; rt < 4; rt++)
#pragma unroll
      for (int r = 0; r < 4; r++) Yo[(size_t)(n * 64 + rt * 16 + fq * 4 + r) * YE_LD] = f2bf(oo[rt][r]);
    __syncthreads();
    if (n + 1 < 128) SCAN_SSTORE();
    __syncthreads();
  }
#undef SCAN_GLOAD
#undef SCAN_SSTORE
}

DEVI void phase_gdn_post(const Params& p) {
  int lane = opaque_tid() & 63;
  int gw = blockIdx.x * 4 + (opaque_tid() >> 6), nw = gridDim.x * 4;
  const bf16_t* Y = (const bf16_t*)(gws(p) + OFF_Y);
  bf16_t* mix = (bf16_t*)(gws(p) + OFF_MIX);
  int c0 = lane * 8;
  float nwv[8];
#pragma unroll
  for (int e = 0; e < 8; e++) nwv[e] = gin(p, 9)[(c0 & 127) + e];
  for (int row = gw; row < M_; row += nw) {
    uint4 ov = *(const uint4*)(Y + (size_t)row * YE_LD + 1536 + c0);
    uint4 zv = *(const uint4*)(Y + (size_t)row * YE_LD + 3072 + c0);
    float o[8] = {lo2f(ov.x), hi2f(ov.x), lo2f(ov.y), hi2f(ov.y), lo2f(ov.z), hi2f(ov.z), lo2f(ov.w), hi2f(ov.w)};
    float z[8] = {lo2f(zv.x), hi2f(zv.x), lo2f(zv.y), hi2f(zv.y), lo2f(zv.z), hi2f(zv.z), lo2f(zv.w), hi2f(zv.w)};
    float ss = 0.f;
#pragma unroll
    for (int e = 0; e < 8; e++) ss += o[e] * o[e];
    ss += __shfl_xor(ss, 1); ss += __shfl_xor(ss, 2); ss += __shfl_xor(ss, 4); ss += __shfl_xor(ss, 8);
    float rs = rsqrtf(ss * (1.f / 128.f) + 1e-6f);
    float r[8];
#pragma unroll
    for (int e = 0; e < 8; e++) r[e] = o[e] * rs * nwv[e] * (z[e] * sigmoidf_(z[e]));
    *(uint4*)(mix + (size_t)row * 1024 + 512 + c0) = make_uint4(pack2(r[0], r[1]), pack2(r[2], r[3]), pack2(r[4], r[5]), pack2(r[6], r[7]));
  }
}

struct ALoadCmp {
  const bf16_t* Y; const float* pe; int mt; int col0; int lr, lc;
  DEVI void init(int lr_, int lc_) { lr = lr_; lc = lc_; }
  DEVI uint4 load(int i, int kin) const {
    int row = lr + i * 32, k = kin + lc;
    int R = mt * 128 + row; if (R > 8175) R = 8175;
    int bn = R >> 1, g = R & 1, b = bn / 511, n = bn - b * 511;
    int l = k >> 6, d = k & 63;
    uint4 v = *(const uint4*)(Y + ((size_t)b * S_ + 16 * n + l) * YO_LD + col0 + g * 64 + d);
    const float4* pp = (const float4*)(pe + l * 64 + d);
    float4 p0 = pp[0], p1 = pp[1];
    return make_uint4(pack2(lo2f(v.x) + p0.x, hi2f(v.x) + p0.y), pack2(lo2f(v.y) + p0.z, hi2f(v.y) + p0.w),
                      pack2(lo2f(v.z) + p1.x, hi2f(v.z) + p1.y), pack2(lo2f(v.w) + p1.z, hi2f(v.w) + p1.w));
  }
};
DEVI void cmp_tile(const Params& p, int tile, char* smem) {
  const int tid = opaque_tid(), lane = tid & 63, wid = tid >> 6, wr = wid >> 1, wc = wid & 1, fr = lane & 15, fq = lane >> 4;
  int kv = tile >> 6, mt = tile & 63;
  const bf16_t* WT = (const bf16_t*)(gws(p) + OFF_WT);
  ALoadCmp al{(const bf16_t*)(gws(p) + OFF_Y), gin(p, kv ? 16 : 13), mt, kv ? 640 : 512, 0, 0};
  f32x4 acc[4][4]; zero_acc(acc);
  gemm_mainloop<false>(al, WT + (kv ? WT_CV1 : WT_CK1), 2048, 2048, smem, acc);
  bf16_t* hid = (bf16_t*)smem;
  bf16_t* w2 = (bf16_t*)(smem + 34816);
#pragma unroll
  for (int i = 0; i < 4; i++)
#pragma unroll
    for (int j = 0; j < 4; j++)
#pragma unroll
      for (int r = 0; r < 4; r++) hid[(wr * 64 + i * 16 + fq * 4 + r) * 136 + wc * 64 + j * 16 + fr] = f2bf(gelu_tanh(acc[i][j][r]));
  const bf16_t* w2g = WT + (kv ? WT_CV2 : WT_CK2);
  for (int c = tid; c < 1024; c += 256) { int row = c >> 4, ch = (c & 15) * 8; *(uint4*)&w2[row * 136 + ch] = *(const uint4*)(w2g + row * 128 + ch); }
  __syncthreads();
  f32x4 a2[2][4];
#pragma unroll
  for (int i = 0; i < 2; i++)
#pragma unroll
    for (int j = 0; j < 4; j++) a2[i][j] = f32x4{0.f, 0.f, 0.f, 0.f};
#pragma unroll
  for (int kk = 0; kk < 4; kk++) {
    bf16x8 af[2], bfv[4];
#pragma unroll
    for (int i = 0; i < 2; i++) af[i] = *(const bf16x8*)&hid[(wid * 32 + i * 16 + fr) * 136 + kk * 32 + fq * 8];
#pragma unroll
    for (int j = 0; j < 4; j++) bfv[j] = *(const bf16x8*)&w2[(j * 16 + fr) * 136 + kk * 32 + fq * 8];
#pragma unroll
    for (int i = 0; i < 2; i++)
#pragma unroll
      for (int j = 0; j < 4; j++) a2[i][j] = mfma16(af[i], bfv[j], a2[i][j]);
  }
  bf16_t* kc = (bf16_t*)(gws(p) + OFF_MISC + MS_KCMP);
  bf16_t* vc = (bf16_t*)(gws(p) + OFF_MISC + MS_VCMPT);
#pragma unroll
  for (int i = 0; i < 2; i++)
#pragma unroll
    for (int r = 0; r < 4; r++) {
      int R = mt * 128 + wid * 32 + i * 16 + fq * 4 + r;
      if (R < 8176) {
        int bn = R >> 1, g = R & 1, b = bn / 511, n = bn - b * 511;
#pragma unroll
        for (int j = 0; j < 4; j++) {
          int d = j * 16 + fr;
          if (kv == 0) kc[(((size_t)b * 512 + n) * 2 + g) * 64 + d] = f2bf(a2[i][j][r]);
          else vc[(((size_t)b * 2 + g) * 64 + d) * 512 + n] = f2bf(a2[i][j][r]);
        }
      }
    }
  __syncthreads();
}

template <bool OUT>
DEVI void rglru_tile(const Params& p, int tile, char* smem) {
  const int tid = opaque_tid(), lane = tid & 63, wid = tid >> 6, fr = lane & 15, fq = lane >> 4;
  int nb = tile & 7, seg = (tile >> 3) & 127, b = tile >> 10;
  size_t tok0 = (size_t)b * S_ + seg * 64;
  float* xs = (float*)smem;
  bf16_t* xb = (bf16_t*)(smem + 16640);
  float* as = (float*)(smem + 25856);
  float* bs = (float*)(smem + 42496);
  const bf16_t* Y = (const bf16_t*)(gws(p) + OFF_Y);
  float* agg = (float*)(gws(p) + OFF_MISC + MS_RGAGG);
  {
    int t = tid >> 2, c0 = (tid & 3) * 16, ch = nb * 64 + c0;
    float x[16];
#pragma unroll
    for (int e = 0; e < 16; e++) x[e] = gin(p, 20)[ch + e];
#pragma unroll
    for (int j = 0; j < 4; j++) {
      int lt = t - 3 + j;
      if (seg * 64 + lt >= 0) {
        const uint4* src = (const uint4*)(Y + (tok0 + lt) * YO_LD + 1792 + ch);
        uint4 v0 = src[0], v1 = src[1];
        const float* w = gin(p, 19) + j * 512 + ch;
        x[0] += w[0] * lo2f(v0.x); x[1] += w[1] * hi2f(v0.x); x[2] += w[2] * lo2f(v0.y); x[3] += w[3] * hi2f(v0.y);
        x[4] += w[4] * lo2f(v0.z); x[5] += w[5] * hi2f(v0.z); x[6] += w[6] * lo2f(v0.w); x[7] += w[7] * hi2f(v0.w);
        x[8] += w[8] * lo2f(v1.x); x[9] += w[9] * hi2f(v1.x); x[10] += w[10] * lo2f(v1.y); x[11] += w[11] * hi2f(v1.y);
        x[12] += w[12] * lo2f(v1.z); x[13] += w[13] * hi2f(v1.z); x[14] += w[14] * lo2f(v1.w); x[15] += w[15] * hi2f(v1.w);
      }
    }
#pragma unroll
    for (int e = 0; e < 16; e++) { xs[t * 65 + c0 + e] = x[e]; xb[t * 72 + c0 + e] = f2bf(x[e]); }
  }
  __syncthreads();
  {
    const bf16_t* WT = (const bf16_t*)(gws(p) + OFF_WT);
    const bf16_t* wa = WT + WT_RGA + nb * 4096;
    const bf16_t* wx = WT + WT_RGX + nb * 4096;
    bf16x8 af[2];
#pragma unroll
    for (int kk = 0; kk < 2; kk++) af[kk] = *(const bf16x8*)&xb[(wid * 16 + fr) * 72 + kk * 32 + fq * 8];
#pragma unroll
    for (int j = 0; j < 4; j++) {
      f32x4 aA = {0.f, 0.f, 0.f, 0.f}, aX = {0.f, 0.f, 0.f, 0.f};
#pragma unroll
      for (int kk = 0; kk < 2; kk++) {
        aA = mfma16(af[kk], *(const bf16x8*)(wa + (j * 16 + fr) * 64 + kk * 32 + fq * 8), aA);
        aX = mfma16(af[kk], *(const bf16x8*)(wx + (j * 16 + fr) * 64 + kk * 32 + fq * 8), aX);
      }
      int c = j * 16 + fr, chn = nb * 64 + c;
      float ba = gin(p, 22)[chn], bx = gin(p, 24)[chn];
      float spl = softplusf_(-gin(p, 25)[chn]);
#pragma unroll
      for (int r = 0; r < 4; r++) {
        int t = wid * 16 + fq * 4 + r;
        float rr = sigmoidf_(aA[r] + ba), ig = sigmoidf_(aX[r] + bx);
        float la = -8.f * spl * rr;
        as[t * 65 + c] = expf(la);
        bs[t * 65 + c] = sqrtf(-expm1f(2.f * la)) * ig * xs[t * 65 + c];
      }
    }
  }
  __syncthreads();
  if (!OUT) {
    {
      int c = tid & 63, part = tid >> 6;
      float A = 1.f, Bv = 0.f;
#pragma unroll
      for (int t = 0; t < 16; t++) { float a = as[(part * 16 + t) * 65 + c]; Bv = a * Bv + bs[(part * 16 + t) * 65 + c]; A *= a; }
      float2* cw2 = (float2*)(smem + 61184);
      cw2[part * 64 + c] = make_float2(A, Bv);
      __syncthreads();
      if (tid < 64) {
        float At = 1.f, Bt = 0.f;
#pragma unroll
        for (int pp = 0; pp < 4; pp++) { float2 ab = cw2[pp * 64 + tid]; Bt = ab.x * Bt + ab.y; At *= ab.x; }
        float2* dst = (float2*)agg + ((size_t)(b * 128 + seg) * 512 + nb * 64 + tid);
        *dst = make_float2(At, Bt);
      }
    }
  } else {
    {
      int c = tid & 63, part = tid >> 6;
      int per = (seg + 3) >> 2, s_lo = part * per, s_hi = min(seg, s_lo + per);
      const float2* src = (const float2*)agg + ((size_t)(b * 128) * 512 + nb * 64 + c);
      float A = 1.f, Bv = 0.f;
#pragma unroll 8
      for (int s2 = s_lo; s2 < s_hi; s2++) { float2 ab = src[(size_t)s2 * 512]; Bv = ab.x * Bv + ab.y; A *= ab.x; }
      float2* cw = (float2*)(smem + 59136);
      cw[part * 64 + c] = make_float2(A, Bv);
    }
    __syncthreads();
    {
      int c = tid & 63, part = tid >> 6;
      float A = 1.f, Bv = 0.f;
#pragma unroll
      for (int t = 0; t < 16; t++) { float a = as[(part * 16 + t) * 65 + c]; Bv = a * Bv + bs[(part * 16 + t) * 65 + c]; A *= a; }
      float2* cw2 = (float2*)(smem + 61184);
      cw2[part * 64 + c] = make_float2(A, Bv);
      __syncthreads();
      const float2* cw = (const float2*)(smem + 59136);
      float hh = 0.f;
#pragma unroll
      for (int pp = 0; pp < 4; pp++) { float2 ab = cw[pp * 64 + c]; hh = ab.x * hh + ab.y; }
      for (int pp = 0; pp < part; pp++) { float2 ab = cw2[pp * 64 + c]; hh = ab.x * hh + ab.y; }
#pragma unroll
      for (int t = 0; t < 16; t++) { int ti = (part * 16 + t) * 65 + c; hh = as[ti] * hh + bs[ti]; bs[ti] = hh; }
    }
    __syncthreads();
    int t = tid >> 2, c0 = (tid & 3) * 16, ch = nb * 64 + c0;
    const uint4* gsrc = (const uint4*)(Y + (tok0 + t) * YO_LD + 1280 + ch);
    uint4 g0 = gsrc[0], g1 = gsrc[1];
    float gv[16] = {lo2f(g0.x), hi2f(g0.x), lo2f(g0.y), hi2f(g0.y), lo2f(g0.z), hi2f(g0.z), lo2f(g0.w), hi2f(g0.w),
                    lo2f(g1.x), hi2f(g1.x), lo2f(g1.y), hi2f(g1.y), lo2f(g1.z), hi2f(g1.z), lo2f(g1.w), hi2f(g1.w)};
    float yv[16];
#pragma unroll
    for (int e = 0; e < 16; e++) yv[e] = bs[t * 65 + c0 + e] * gelu_tanh(gv[e]);
    uint4* dst = (uint4*)((bf16_t*)(gws(p) + OFF_MIX) + (tok0 + t) * 1024 + 512 + ch);
    dst[0] = make_uint4(pack2(yv[0], yv[1]), pack2(yv[2], yv[3]), pack2(yv[4], yv[5]), pack2(yv[6], yv[7]));
    dst[1] = make_uint4(pack2(yv[8], yv[9]), pack2(yv[10], yv[11]), pack2(yv[12], yv[13]), pack2(yv[14], yv[15]));
  }
  __syncthreads();
}

template <int BR>
struct NsaPol {
  static constexpr bool UB = true;
  int t; int tmin; int kb; const u64* selq; const u64* worq; float sc; bool selbit;
  DEVI float lane_bias() const { return (BR == 1 && !selbit) ? NEGF : 0.f; }
  DEVI bool active(int kb_) const {
    if (BR == 1) return (worq[kb_ >> 6] >> (kb_ & 63)) & 1;
    return true;
  }
  DEVI bool masked(int kb_) const {
    if (BR == 2) return !((kb_ * 64 + 63 <= tmin) && (tmin + 15 - kb_ * 64 < 512));
    if (BR == 1) return kb_ * 64 + 63 > tmin;
    return true;
  }
  DEVI void begin(int kb_, const float*) {
    kb = kb_;
    if (BR == 1) selbit = (selq[kb_ >> 6] >> (kb_ & 63)) & 1;
  }
  DEVI bool ok(int qt, int kl) const {
    int key = kb * 64 + kl;
    if (BR == 0) return (16 * key + 31 <= t) && (key < 511);
    if (BR == 1) return selbit && (key <= t);
    return (key <= t) && (t - key < 512);
  }
  DEVI f32x4 bias4(int) const { return f32x4{0.f, 0.f, 0.f, 0.f}; }
};

DEVI void nsa_tile(const Params& p, int item, char* smem) {
  const int tid = opaque_tid(), lane = tid & 63, wid = tid >> 6, fr = lane & 15, fq = lane >> 4;
  const int qg = wid >> 1, hp = wid & 1;
  int qb = 255 - (item >> 4), bg = item & 15, b = bg >> 1, g = bg & 1;
  int q0 = qb * 32, cur = q0 >> 6;
  int t = q0 + qg * 16 + fr;
  size_t mrow = (size_t)b * S_ + t;
  const bf16_t* Y = (const bf16_t*)(gws(p) + OFF_Y) + (size_t)b * S_ * YO_LD;
  const float* ysm = (const float*)(gws(p) + OFF_SM) + mrow * 32;
  float* impw = (float*)(smem + SM_IMP) + wid * (16 * 132);
  float* otot = impw;
  u64* selm = (u64*)(smem + SM_SELM) + qg * 32;
  u64* bor = (u64*)(smem + SM_BOR);
  bf16x8 qf[2][2];
#pragma unroll
  for (int qt = 0; qt < 2; qt++)
#pragma unroll
    for (int kk = 0; kk < 2; kk++) qf[qt][kk] = *(const bf16x8*)(Y + (size_t)t * YO_LD + (g * 4 + hp * 2 + qt) * 64 + kk * 32 + fq * 8);
  for (int i = lane; i < 16 * 132; i += 64) impw[i] = 0.f;
  f32x4 o[4][2];
  float m[2], l[2];
  const float sc = 0.125f * LOG2E;
  {
    int nkv = (q0 / 16) / 64 + 1; if (nkv > 8) nkv = 8;
    u64 mlo = (1ull << nkv) - 1;
    const bf16_t* Kg = (const bf16_t*)(gws(p) + OFF_MISC + MS_KCMP) + (size_t)b * 512 * 128 + g * 64;
    const bf16_t* Vt = (const bf16_t*)(gws(p) + OFF_MISC + MS_VCMPT) + ((size_t)b * 2 + g) * 64 * 512;
    NsaPol<0> pol; pol.t = t; pol.tmin = q0 + qg * 16; pol.kb = 0; pol.sc = sc; pol.selq = nullptr; pol.worq = nullptr; pol.selbit = false;
#pragma unroll
    for (int qt = 0; qt < 2; qt++) { m[qt] = NEGF; l[qt] = 0.f; }
    zero_o<2>(o);
    attn_core<1, 2>(pol, smem, qf, Kg, 128, Vt, 512, nullptr, mlo, 0ull, o, m, l, nullptr);
#pragma unroll
    for (int qt = 0; qt < 2; qt++) { float lt = l[qt]; lt += __shfl_xor(lt, 16); lt += __shfl_xor(lt, 32); l[qt] = lt > 0.f ? 1.f / lt : 0.f; }
    attn_core<2, 2>(pol, smem, qf, Kg, 128, Vt, 512, nullptr, mlo, 0ull, o, m, l, impw);
  }
  __syncthreads();
  {
    float* ia = (float*)(smem + SM_IMP) + (qg * 2) * (16 * 132);
    const float* ib = ia + 16 * 132;
#pragma unroll 1
    for (int qq = 0; qq < 8; qq++) {
      int q = hp * 8 + qq;
      float* iv = ia + q * 132;
      const float* ivb = ib + q * 132;
      float v0 = iv[lane] + ivb[lane], v1 = iv[lane + 64] + ivb[lane + 64];
      int c0 = 0, c1 = 0;
      if (cur >= 16) {
        iv[lane] = (lane >= 1 && lane <= cur - 2) ? v0 : -1.f;
        iv[lane + 64] = (lane + 64 <= cur - 2) ? v1 : -1.f;
        if (lane < 4) iv[128 + lane] = -1.f;
        const int n4 = (cur + 2) >> 2;
        for (int m4 = 0; m4 < n4; m4++) {
          float4 x = *(const float4*)&iv[m4 * 4];
          int mb = m4 * 4;
          c0 += (x.x > v0) || (x.x == v0 && mb + 0 < lane);
          c0 += (x.y > v0) || (x.y == v0 && mb + 1 < lane);
          c0 += (x.z > v0) || (x.z == v0 && mb + 2 < lane);
          c0 += (x.w > v0) || (x.w == v0 && mb + 3 < lane);
          c1 += (x.x > v1) || (x.x == v1 && mb + 0 < lane + 64);
          c1 += (x.y > v1) || (x.y == v1 && mb + 1 < lane + 64);
          c1 += (x.z > v1) || (x.z == v1 && mb + 2 < lane + 64);
          c1 += (x.w > v1) || (x.w == v1 && mb + 3 < lane + 64);
        }
      }
      int m0 = lane, m1 = lane + 64;
      bool s0, s1;
      if (cur < 16) { s0 = m0 <= cur; s1 = false; }
      else {
        s0 = (m0 == 0) || (m0 == cur) || (m0 == cur - 1) || (m0 >= 1 && m0 <= cur - 2 && 3 + c0 < 16);
        s1 = (m1 == cur) || (m1 == cur - 1) || (m1 <= cur - 2 && 3 + c1 < 16);
      }
      u64 lo = __ballot(s0), hi = __ballot(s1);
      if (lane == 0) { selm[q * 2] = lo; selm[q * 2 + 1] = hi; }
    }
  }
  __syncthreads();
  {
    u64 wlo = selm[fr * 2], whi = selm[fr * 2 + 1];
#pragma unroll
    for (int off = 1; off < 16; off <<= 1) { wlo |= __shfl_xor(wlo, off); whi |= __shfl_xor(whi, off); }
    if (lane == 0) { bor[wid * 2] = wlo; bor[wid * 2 + 1] = whi; }
  }
#pragma unroll
  for (int dt = 0; dt < 4; dt++)
#pragma unroll
    for (int qt = 0; qt < 2; qt++) {
      f32x4 v = o[dt][qt]; float gg = sigmoidf_(ysm[(g * 4 + hp * 2 + qt) * 3 + 0]);
      otot[((dt * 2 + qt) * 2 + 0) * 64 + lane] = __uint_as_float(pack2(v[0] * gg, v[1] * gg));
      otot[((dt * 2 + qt) * 2 + 1) * 64 + lane] = __uint_as_float(pack2(v[2] * gg, v[3] * gg));
    }
  __syncthreads();
  u64 blo = bor[0] | bor[2] | bor[4] | bor[6], bhi = bor[1] | bor[3] | bor[5] | bor[7];
  {
    u64 clo = cur >= 63 ? ~0ull : ((1ull << (cur + 1)) - 1);
    u64 chi = cur < 64 ? 0ull : (cur >= 127 ? ~0ull : ((1ull << (cur - 63)) - 1));
    blo &= clo; bhi &= chi;
  }
  {
    NsaPol<1> pol; pol.t = t; pol.tmin = q0 + qg * 16; pol.kb = 0; pol.sc = sc; pol.selq = selm + fr * 2; pol.worq = bor + wid * 2; pol.selbit = false;
#pragma unroll
    for (int qt = 0; qt < 2; qt++) { m[qt] = NEGF; l[qt] = 0.f; }
    zero_o<2>(o);
    const bf16_t* Vt = (const bf16_t*)(gws(p) + OFF_Y + 288 * MiB) + ((size_t)b * 128 + g * 64) * S_;
    attn_core<0, 2>(pol, smem, qf, Y + 768 + g * 64, YO_LD, Vt, S_, nullptr, blo, bhi, o, m, l, nullptr);
#pragma unroll
    for (int qt = 0; qt < 2; qt++) {
      float lt = l[qt]; lt += __shfl_xor(lt, 16); lt += __shfl_xor(lt, 32);
      float sc2 = sigmoidf_(ysm[(g * 4 + hp * 2 + qt) * 3 + 1]) / lt;
#pragma unroll
      for (int dt = 0; dt < 4; dt++) {
        f32x4 v = o[dt][qt];
        unsigned a = __float_as_uint(otot[((dt * 2 + qt) * 2 + 0) * 64 + lane]), bq = __float_as_uint(otot[((dt * 2 + qt) * 2 + 1) * 64 + lane]);
        otot[((dt * 2 + qt) * 2 + 0) * 64 + lane] = __uint_as_float(pack2(lo2f(a) + v[0] * sc2, hi2f(a) + v[1] * sc2));
        otot[((dt * 2 + qt) * 2 + 1) * 64 + lane] = __uint_as_float(pack2(lo2f(bq) + v[2] * sc2, hi2f(bq) + v[3] * sc2));
      }
    }
  }
  {
    NsaPol<2> pol; pol.t = t; pol.tmin = q0 + qg * 16; pol.kb = 0; pol.sc = sc; pol.selq = nullptr; pol.worq = nullptr; pol.selbit = false;
#pragma unroll
    for (int qt = 0; qt < 2; qt++) { m[qt] = NEGF; l[qt] = 0.f; }
    zero_o<2>(o);
    int k0 = (q0 - 511) < 0 ? 0 : ((q0 - 511) >> 6);
    u64 wl = 0, wh = 0;
    for (int k = k0; k <= cur; k++) { if (k < 64) wl |= 1ull << k; else wh |= 1ull << (k - 64); }
    const bf16_t* Vt = (const bf16_t*)(gws(p) + OFF_Y + 304 * MiB) + ((size_t)b * 128 + g * 64) * S_;
    attn_core<0, 2>(pol, smem, qf, Y + 1024 + g * 64, YO_LD, Vt, S_, nullptr, wl, wh, o, m, l, nullptr);
    bf16_t* mix = (bf16_t*)(gws(p) + OFF_MIX) + mrow * 1024;
#pragma unroll
    for (int qt = 0; qt < 2; qt++) {
      float lt = l[qt]; lt += __shfl_xor(lt, 16); lt += __shfl_xor(lt, 32);
      float sc2 = sigmoidf_(ysm[(g * 4 + hp * 2 + qt) * 3 + 2]) / lt;
#pragma unroll
      for (int dt = 0; dt < 4; dt++) {
        f32x4 v = o[dt][qt];
        unsigned a = __float_as_uint(otot[((dt * 2 + qt) * 2 + 0) * 64 + lane]), bq = __float_as_uint(otot[((dt * 2 + qt) * 2 + 1) * 64 + lane]);
        *(uint2*)(mix + (g * 4 + hp * 2 + qt) * 64 + dt * 16 + fq * 4) =
            make_uint2(pack2(lo2f(a) + v[0] * sc2, hi2f(a) + v[1] * sc2), pack2(lo2f(bq) + v[2] * sc2, hi2f(bq) + v[3] * sc2));
      }
    }
  }
  __syncthreads();
}

DEVI int next_item(int* ctr, char* smem) {
  int* slot = (int*)(smem + SM_SLOT);
  __syncthreads();
  if (opaque_tid() == 0) *slot = atomicAdd(ctr, 1);
  __syncthreads();
  return *slot;
}

constexpr int NPHASE = 17;
DEVI void grid_bar(unsigned* ctr, unsigned target) {
  __syncthreads();
  if (threadIdx.x == 0) {
    __threadfence();
    __hip_atomic_fetch_add(ctr, 1u, __ATOMIC_RELAXED, __HIP_MEMORY_SCOPE_AGENT);
    while (__hip_atomic_load(ctr, __ATOMIC_RELAXED, __HIP_MEMORY_SCOPE_AGENT) < target) __builtin_amdgcn_s_sleep(8);
    __threadfence();
  }
  __syncthreads();
}
__global__ void __launch_bounds__(256, 2) mega(Params p, int ph0, int ph1) {
  extern __shared__ __attribute__((aligned(16))) char smem[];
  cg::grid_group grid = cg::this_grid();
  char* ws0 = p.ws;
#define PH(n, ...) if ((n) >= ph0 && (n) <= ph1) { \
    char* ws = ws0; asm volatile("" : "+s"(ws)); ws = as_global(ws); \
    const bf16_t* WT = (const bf16_t*)(ws + OFF_WT); bf16_t* hn = (bf16_t*)(ws + OFF_HN); bf16_t* Yb = (bf16_t*)(ws + OFF_Y); \
    bf16_t* mix = (bf16_t*)(ws + OFF_MIX); bf16_t* pbf = (bf16_t*)(ws + OFF_X); bf16_t* ppb = (bf16_t*)(ws + OFF_X + 32 * MiB); (void)ppb; int* ctr = (int*)(ws + OFF_MISC + MS_CTR); \
    Params* gp = (Params*)(ws + OFF_MISC + MS_PTAB); float* h = as_global(gp->out); \
    float* ss = (float*)(ws + OFF_MISC + MS_SS); bf16_t* hn2 = (bf16_t*)(ws + OFF_MIX); (void)ss; (void)hn2; (void)WT; (void)hn; (void)Yb; (void)mix; (void)pbf; (void)ctr; (void)h; \
    __VA_ARGS__ } if ((n) >= ph0 && (n) < ph1) grid.sync();
  PH(0, if (blockIdx.x == 0 && threadIdx.x < 34) gp->in[threadIdx.x] = p.in[threadIdx.x];
        if (blockIdx.x == 0 && threadIdx.x == 0) { gp->out = p.out; gp->ws = p.ws; gp->positions = p.positions; }
        phase_prep(p, smem); phase_xprep(p.in[0], hn, ss);)
  PH(1, phase_gemm_in<true>(*gp, hn, ss, smem);)
  PH(2, phase_fox_f(*gp, smem); for (int t = blockIdx.x; t < 4096; t += gridDim.x) gdn_pre_tile(*gp, t, smem);)
  PH(3, for (;;) { int it = next_item(ctr + 0, smem); if (it >= 64 + 4096) break; if (it < 64) gdn_scan_item(*gp, it, smem); else fox_tile(*gp, it - 64, smem); })
  PH(4, phase_gdn_post(*gp); phase_cvt_p(as_global(gp->in[1]), pbf);)
  PH(5, phase_gemm<EP_RESID>(mix, 1024, WT + WT_OUT_E, 1024, 8, nullptr, 0, as_global(gp->in[0]), h, hn, nullptr, ss + 1 * M_, smem);)
  PH(6, phase_gemm<EP_RELU2>(hn, 1024, WT + WT_UP, 1024, 32, Yb, 4096, nullptr, nullptr, nullptr, ss + 1 * M_, nullptr, smem); phase_pp(pbf, WT + WT_PROJ, ppb, smem);)
  PH(7, phase_gemm<EP_RESID>(Yb, 4096, WT + WT_DOWN, 4096, 8, nullptr, 0, h, h, hn, nullptr, ss + 2 * M_, smem);)
  PH(8, phase_ple(hn, WT + WT_GATE, ppb, h, hn2, ss + 2 * M_, ss + 3 * M_, smem);)
  PH(9, phase_gemm_in<false>(*gp, hn2, ss + 3 * M_, smem);)
  PH(10, for (int t = blockIdx.x; t < 128; t += gridDim.x) cmp_tile(*gp, t, smem); for (int t = blockIdx.x; t < 8192; t += gridDim.x) rglru_tile<false>(*gp, t, smem); phase_cvt_p(as_global(gp->in[1]) + (size_t)M_ * 256, pbf);)
  PH(11, for (;;) { int it = next_item(ctr + 1, smem); if (it >= 4096 + 8192) break; if (it < 4096) nsa_tile(*gp, it, smem); else rglru_tile<true>(*gp, it - 4096, smem); })
  PH(12, phase_gemm<EP_RESID>(mix, 1024, WT + WT_OUT_O, 1024, 8, nullptr, 0, h, h, hn, nullptr, ss + 4 * M_, smem);)
  PH(13, phase_gemm<EP_RELU2>(hn, 1024, WT + WT_UP + 4096 * 1024, 1024, 32, Yb, 4096, nullptr, nullptr, nullptr, ss + 4 * M_, nullptr, smem); phase_pp(pbf, WT + WT_PROJ + 1024 * 256, ppb, smem);)
  PH(14, phase_gemm<EP_RESID>(Yb, 4096, WT + WT_DOWN + 4096 * 1024, 4096, 8, nullptr, 0, h, h, hn, nullptr, ss + 5 * M_, smem);)
  PH(15, phase_ple(hn, WT + WT_GATE + 1024 * 1024, ppb, h, nullptr, ss + 5 * M_, nullptr, smem);)
  PH(16, phase_norm(h, as_global(gp->in[33]), nullptr, h);)
}

extern "C" void kernel_launch(void* const* d_in, const int* in_sizes, int n_in, void* d_out, int out_size, void* d_ws,
                              size_t ws_size, hipStream_t stream) {
  static int grid_blocks = 0;
  if (!grid_blocks) {
    hipFuncSetAttribute((const void*)mega, hipFuncAttributeMaxDynamicSharedMemorySize, LDS_BYTES);
    int dev = 0, cus = 0, per_cu = 0;
    hipGetDevice(&dev);
    hipDeviceGetAttribute(&cus, hipDeviceAttributeMultiprocessorCount, dev);
    hipOccupancyMaxActiveBlocksPerMultiprocessor(&per_cu, mega, 256, LDS_BYTES);
    if (per_cu > 2) per_cu = 2;
    if (per_cu < 1) per_cu = 1;
    grid_blocks = cus * per_cu;
  }
  Params p;
  memset((void*)&p, 0, sizeof(p));
  for (int i = 0; i < 34; i++) p.in[i] = (const float*)d_in[i];
  p.positions = (const int*)d_in[2];
  p.out = (float*)d_out;
  p.ws = (char*)d_ws;
  bf16_t* WT = (bf16_t*)((char*)d_ws + OFF_WT);
  auto F = [&](int i) { return (const float*)d_in[i]; };
  int nd = 0, t0 = 0;
  auto add = [&](const float* src, bf16_t* dst, int K, int N, int Nd, int kind, int nb, const float* scale) {
    p.wd[nd].src = src; p.wd[nd].dst = dst; p.wd[nd].scale = scale; p.wd[nd].K = K; p.wd[nd].N = N; p.wd[nd].Nd = Nd; p.wd[nd].kind = kind; p.wd[nd].nb = nb; p.wd[nd].tile0 = t0;
    t0 += nb * (K / 64) * (Nd / 64);
    nd++;
  };
  add(F(4), WT + WT_IN_E, 1024, 3600, 3712, 1, 1, F(3));
  add(F(10), WT + WT_OUT_E, 1024, 1024, 1024, 0, 1, nullptr);
  add(F(12), WT + WT_IN_O, 1024, 2328, 2432, 2, 1, F(11));
  add(F(26), WT + WT_OUT_O, 1024, 1024, 1024, 0, 1, nullptr);
  add(F(28), WT + WT_UP, 1024, 4096, 4096, 0, 2, F(27));
  add(F(29), WT + WT_DOWN, 4096, 1024, 1024, 0, 2, nullptr);
  add(F(31), WT + WT_GATE, 1024, 1024, 1024, 0, 2, F(30));
  add(F(32), WT + WT_PROJ, 256, 1024, 1024, 0, 2, nullptr);
  add(F(14), WT + WT_CK1, 2048, 128, 128, 0, 1, nullptr);
  add(F(17), WT + WT_CV1, 2048, 128, 128, 0, 1, nullptr);
  add(F(15), WT + WT_CK2, 128, 64, 64, 0, 1, nullptr);
  add(F(18), WT + WT_CV2, 128, 64, 64, 0, 1, nullptr);
  add(F(21), WT + WT_RGA, 64, 64, 64, 0, 8, nullptr);
  add(F(23), WT + WT_RGX, 64, 64, 64, 0, 8, nullptr);
  while (nd < NWD) { p.wd[nd].K = 64; p.wd[nd].N = 64; p.wd[nd].Nd = 64; p.wd[nd].tile0 = 0x7fffffff; nd++; }
  p.prep_tiles = t0;
  int ph0 = 0, ph1 = NPHASE - 1;
  void* args[] = {&p, &ph0, &ph1};
  hipError_t e = hipLaunchCooperativeKernel((void*)mega, dim3(grid_blocks), dim3(256), args, LDS_BYTES, stream);
  if (e != hipSuccess) fprintf(stderr, "cooperative launch failed: %s (grid %d)\n", hipGetErrorString(e), grid_blocks);
}
```
